# Optimizing an MI355X kernel written in HIP

```python
import math
import jax, jax.numpy as jnp
from jax import lax
import numpy as np


D_MODEL = 1024
BATCH = 4
SEQ = 8192
DEPTH = 1

MLSTM_HEADS = 4
MLSTM_WIDTH = D_MODEL
MLSTM_VDIM = MLSTM_WIDTH // MLSTM_HEADS
MLSTM_QKDIM = MLSTM_VDIM // 2
MLSTM_CONV = 4
MLSTM_CHUNK = 64
S5_WIDTH = D_MODEL // 2
S5_GROUP = 16
S5_GROUPS = S5_WIDTH // S5_GROUP
S5_STATE = 64
S5_DT_MIN = 1e-3
S5_DT_MAX = 1e-1
FFN_HIDDEN = ((8 * D_MODEL // 3 + 127) // 128) * 128
FFN_CONV = 3
ALPHA = (2.0 * DEPTH) ** 0.25
BETA = (8.0 * DEPTH) ** -0.25
LN_EPS = 1e-5
IN_SIZES = (MLSTM_WIDTH, MLSTM_WIDTH, MLSTM_HEADS, MLSTM_HEADS, S5_WIDTH, D_MODEL, D_MODEL)
IN_WIDTH = sum(IN_SIZES)
IN_SPLITS = tuple(int(s) for s in np.cumsum(IN_SIZES)[:-1])
F_OFF = 2 * MLSTM_WIDTH + MLSTM_HEADS

kernel_name = 'hybrid_mlstm_s5_convglu_deepnorm_adaln'


def _standardize(x):
    xf = x.astype(jnp.float32)
    mu = jnp.mean(xf, axis=-1, keepdims=True)
    var = jnp.mean(jnp.square(xf - mu), axis=-1, keepdims=True)
    return ((xf - mu) * lax.rsqrt(var + LN_EPS)).astype(x.dtype)


def _layer_norm(x, gain, bias):
    return _standardize(x) * gain + bias


def _causal_dwconv(x, w, b):
    K = w.shape[0]
    S = x.shape[1]
    xp = jnp.pad(x, ((0, 0), (K - 1, 0), (0, 0)))
    y = b
    for j in range(K):
        y = y + w[j] * xp[:, j:j + S]
    return y


def _mlstm_chunkwise(q, k, v, i_pre, f_pre):
    Bsz, H, S, dk = q.shape
    dv = v.shape[-1]
    L = MLSTM_CHUNK
    nc = S // L
    f32 = jnp.float32
    q = q.astype(f32) * (MLSTM_QKDIM ** -0.5)
    k = k.astype(f32)
    v = v.astype(f32)
    ig = i_pre.astype(f32)
    logf = jax.nn.log_sigmoid(f_pre.astype(f32))

    def to_chunks(a):
        return jnp.moveaxis(a.reshape((Bsz, H, nc, L) + a.shape[3:]), 2, 0)

    causal = jnp.tril(jnp.ones((L, L), dtype=bool))

    def step(carry, xs):
        C, n, m = carry
        qb, kb, vb, ib, fb = xs
        b = jnp.cumsum(fb, axis=-1)
        D = b[..., :, None] - b[..., None, :] + ib[..., None, :]
        D = jnp.where(causal, D, -jnp.inf)
        inter = b + m[..., None]
        m_t = jnp.maximum(inter, jnp.max(D, axis=-1))
        wmat = jnp.exp(D - m_t[..., None])
        sc_inter = jnp.exp(inter - m_t)
        s = jnp.einsum('bhtd,bhsd->bhts', qb, kb) * wmat
        num = jnp.einsum('bhts,bhsv->bhtv', s, vb) + sc_inter[..., None] * jnp.einsum('bhtd,bhdv->bhtv', qb, C)
        den = jnp.sum(s, axis=-1) + sc_inter * jnp.einsum('bhtd,bhd->bht', qb, n)
        h = num / jnp.maximum(jnp.abs(den), jnp.exp(-m_t))[..., None]
        b_last = b[..., -1]
        g = b_last[..., None] - b + ib
        m_new = jnp.maximum(b_last + m, jnp.max(g, axis=-1))
        wk = jnp.exp(g - m_new[..., None])
        decay = jnp.exp(b_last + m - m_new)
        kw = kb * wk[..., None]
        C_new = decay[..., None, None] * C + jnp.einsum('bhsd,bhsv->bhdv', kw, vb)
        n_new = decay[..., None] * n + jnp.sum(kw, axis=2)
        return (C_new, n_new, m_new), h

    init = (jnp.zeros((Bsz, H, dk, dv), f32), jnp.zeros((Bsz, H, dk), f32), jnp.zeros((Bsz, H), f32))
    _, hc = lax.scan(step, init, (to_chunks(q), to_chunks(k), to_chunks(v), to_chunks(ig), to_chunks(logf)))
    return jnp.moveaxis(hc, 0, 2).reshape(Bsz, H, S, dv)


def _s5_ssm(u, lam_re, lam_im, log_dt, b_re, b_im, c_re, c_im, d):
    Bsz, S, W = u.shape
    f32 = jnp.float32
    uf = u.astype(f32)
    lam_re = lam_re.astype(f32)
    lam_im = lam_im.astype(f32)
    dt = jnp.exp(log_dt.astype(f32))[:, None]
    mag = jnp.exp(lam_re * dt)
    ar = mag * jnp.cos(lam_im * dt)
    ai = mag * jnp.sin(lam_im * dt)
    den = lam_re * lam_re + lam_im * lam_im
    zr = ((ar - 1.0) * lam_re + ai * lam_im) / den
    zi = (ai * lam_re - (ar - 1.0) * lam_im) / den
    bbr = zr[..., None] * b_re - zi[..., None] * b_im
    bbi = zr[..., None] * b_im + zi[..., None] * b_re
    ug = uf.reshape(Bsz, S, S5_GROUPS, S5_GROUP)
    bu_r = jnp.einsum('bsgc,gpc->bsgp', ug, bbr)
    bu_i = jnp.einsum('bsgc,gpc->bsgp', ug, bbi)
    a_r = jnp.broadcast_to(ar, bu_r.shape)
    a_i = jnp.broadcast_to(ai, bu_r.shape)

    def combine(e1, e2):
        a1r, a1i, b1r, b1i = e1
        a2r, a2i, b2r, b2i = e2
        return (a1r * a2r - a1i * a2i,
                a1r * a2i + a1i * a2r,
                a2r * b1r - a2i * b1i + b2r,
                a2r * b1i + a2i * b1r + b2i)

    _, _, xr, xi = lax.associative_scan(combine, (a_r, a_i, bu_r, bu_i), axis=1)
    y = jnp.einsum('gcp,bsgp->bsgc', c_re, xr) - jnp.einsum('gcp,bsgp->bsgc', c_im, xi)
    y = y.reshape(Bsz, S, W) + d * uf
    return y.astype(u.dtype)


def _hybrid_mixer(h, w_in, b_in, w_mlstm_conv, b_mlstm_conv, w_mlstm_q, w_mlstm_k, mlstm_norm_gain,
                  w_mlstm_down, s5_lam_re, s5_lam_im, s5_log_dt, s5_b_re, s5_b_im, s5_c_re, s5_c_im,
                  s5_d, w_s5_glu, w_mix_out):
    Bsz, S, _ = h.shape
    proj = h @ w_in + b_in
    xm, om, ip, fp, us, ga, gb = jnp.split(proj, IN_SPLITS, axis=-1)
    xc = jax.nn.silu(_causal_dwconv(xm, w_mlstm_conv, b_mlstm_conv)).reshape(Bsz, S, MLSTM_HEADS, MLSTM_VDIM)
    q = jnp.einsum('bshc,hcd->bhsd', xc, w_mlstm_q)
    k = jnp.einsum('bshc,hcd->bhsd', xc, w_mlstm_k)
    v = xm.reshape(Bsz, S, MLSTM_HEADS, MLSTM_VDIM).transpose(0, 2, 1, 3)
    hm = _mlstm_chunkwise(q, k, v, ip.transpose(0, 2, 1), fp.transpose(0, 2, 1))
    hm = _standardize(hm).transpose(0, 2, 1, 3).reshape(Bsz, S, MLSTM_WIDTH).astype(h.dtype)
    y_a = (hm * mlstm_norm_gain * jax.nn.sigmoid(om)) @ w_mlstm_down
    ys = jax.nn.gelu(_s5_ssm(us, s5_lam_re, s5_lam_im, s5_log_dt, s5_b_re, s5_b_im, s5_c_re, s5_c_im, s5_d))
    val, gate = jnp.split(ys @ w_s5_glu, 2, axis=-1)
    y_b = val * jax.nn.sigmoid(gate)
    y = jax.nn.sigmoid(ga) * y_a + jax.nn.sigmoid(gb) * y_b
    return y @ w_mix_out


def _conv_glu_ffn(h, w_ffn_up, w_ffn_conv, b_ffn_conv, w_ffn_down):
    val, gate = jnp.split(h @ w_ffn_up, 2, axis=-1)
    gate = jax.nn.gelu(_causal_dwconv(gate, w_ffn_conv, b_ffn_conv))
    return (gate * val) @ w_ffn_down


def setup_inputs(seed: int = 0) -> dict:
    key = jax.random.key(seed)
    ks = iter(jax.random.split(key, 40))
    f32 = jnp.float32
    L = DEPTH

    def nrm(shape, scale):
        return scale * jax.random.normal(next(ks), shape, f32)

    x = nrm((BATCH, SEQ, D_MODEL), 1.0)
    c = nrm((BATCH, D_MODEL), 1.0)
    w_ada = nrm((L, D_MODEL, 6 * D_MODEL), 0.5 * D_MODEL ** -0.5)
    b_ada = nrm((L, 6 * D_MODEL), 0.02)
    w_in = nrm((L, D_MODEL, IN_WIDTH), D_MODEL ** -0.5)
    f_bias = jnp.linspace(3.0, 6.0, MLSTM_HEADS, dtype=f32)
    b_in = nrm((L, IN_WIDTH), 0.02).at[:, F_OFF:F_OFF + MLSTM_HEADS].add(f_bias)
    w_mlstm_conv = nrm((L, MLSTM_CONV, MLSTM_WIDTH), MLSTM_CONV ** -0.5)
    b_mlstm_conv = nrm((L, MLSTM_WIDTH), 0.02)
    w_mlstm_q = nrm((L, MLSTM_HEADS, MLSTM_VDIM, MLSTM_QKDIM), MLSTM_VDIM ** -0.5)
    w_mlstm_k = nrm((L, MLSTM_HEADS, MLSTM_VDIM, MLSTM_QKDIM), MLSTM_VDIM ** -0.5)
    mlstm_norm_gain = 1.0 + nrm((L, MLSTM_WIDTH), 0.02)
    w_mlstm_down = nrm((L, MLSTM_WIDTH, D_MODEL), MLSTM_WIDTH ** -0.5)
    s5_lam_re = -0.5 + nrm((L, S5_GROUPS, S5_STATE), 0.01)
    s5_lam_im = math.pi * jnp.arange(S5_STATE, dtype=f32) + nrm((L, S5_GROUPS, S5_STATE), 0.01)
    s5_log_dt = math.log(S5_DT_MIN) + jax.random.uniform(next(ks), (L, S5_GROUPS), f32) * (math.log(S5_DT_MAX) - math.log(S5_DT_MIN))
    s5_b_re = nrm((L, S5_GROUPS, S5_STATE, S5_GROUP), (2.0 * S5_GROUP) ** -0.5)
    s5_b_im = nrm((L, S5_GROUPS, S5_STATE, S5_GROUP), (2.0 * S5_GROUP) ** -0.5)
    s5_c_re = nrm((L, S5_GROUPS, S5_GROUP, S5_STATE), (2.0 * S5_STATE) ** -0.5)
    s5_c_im = nrm((L, S5_GROUPS, S5_GROUP, S5_STATE), (2.0 * S5_STATE) ** -0.5)
    s5_d = nrm((L, S5_WIDTH), 1.0)
    w_s5_glu = nrm((L, S5_WIDTH, 2 * D_MODEL), S5_WIDTH ** -0.5)
    w_mix_out = nrm((L, D_MODEL, D_MODEL), BETA * D_MODEL ** -0.5)
    ln1_gain = 1.0 + nrm((L, D_MODEL), 0.02)
    ln1_bias = nrm((L, D_MODEL), 0.02)
    w_ffn_up = nrm((L, D_MODEL, 2 * FFN_HIDDEN), D_MODEL ** -0.5)
    w_ffn_conv = nrm((L, FFN_CONV, FFN_HIDDEN), FFN_CONV ** -0.5)
    b_ffn_conv = nrm((L, FFN_HIDDEN), 0.02)
    w_ffn_down = nrm((L, FFN_HIDDEN, D_MODEL), BETA * FFN_HIDDEN ** -0.5)
    ln2_gain = 1.0 + nrm((L, D_MODEL), 0.02)
    ln2_bias = nrm((L, D_MODEL), 0.02)
    return {'x': x, 'c': c, 'w_ada': w_ada, 'b_ada': b_ada, 'w_in': w_in, 'b_in': b_in,
            'w_mlstm_conv': w_mlstm_conv, 'b_mlstm_conv': b_mlstm_conv, 'w_mlstm_q': w_mlstm_q,
            'w_mlstm_k': w_mlstm_k, 'mlstm_norm_gain': mlstm_norm_gain, 'w_mlstm_down': w_mlstm_down,
            's5_lam_re': s5_lam_re, 's5_lam_im': s5_lam_im, 's5_log_dt': s5_log_dt, 's5_b_re': s5_b_re,
            's5_b_im': s5_b_im, 's5_c_re': s5_c_re, 's5_c_im': s5_c_im, 's5_d': s5_d, 'w_s5_glu': w_s5_glu,
            'w_mix_out': w_mix_out, 'ln1_gain': ln1_gain, 'ln1_bias': ln1_bias, 'w_ffn_up': w_ffn_up,
            'w_ffn_conv': w_ffn_conv, 'b_ffn_conv': b_ffn_conv, 'w_ffn_down': w_ffn_down,
            'ln2_gain': ln2_gain, 'ln2_bias': ln2_bias}


def reference(x, c, w_ada, b_ada, w_in, b_in, w_mlstm_conv, b_mlstm_conv, w_mlstm_q, w_mlstm_k,
              mlstm_norm_gain, w_mlstm_down, s5_lam_re, s5_lam_im, s5_log_dt, s5_b_re, s5_b_im,
              s5_c_re, s5_c_im, s5_d, w_s5_glu, w_mix_out, ln1_gain, ln1_bias, w_ffn_up, w_ffn_conv,
              b_ffn_conv, w_ffn_down, ln2_gain, ln2_bias):
    c_act = jax.nn.silu(c)
    for l in range(DEPTH):
        mod = c_act @ w_ada[l] + b_ada[l]
        sh1, sc1, g1, sh2, sc2, g2 = [m[:, None, :] for m in jnp.split(mod, 6, axis=-1)]
        h = _standardize(x) * (1.0 + sc1) + sh1
        mix = _hybrid_mixer(h, w_in[l], b_in[l], w_mlstm_conv[l], b_mlstm_conv[l], w_mlstm_q[l],
                            w_mlstm_k[l], mlstm_norm_gain[l], w_mlstm_down[l], s5_lam_re[l],
                            s5_lam_im[l], s5_log_dt[l], s5_b_re[l], s5_b_im[l], s5_c_re[l],
                            s5_c_im[l], s5_d[l], w_s5_glu[l], w_mix_out[l])
        x = _layer_norm(ALPHA * x + (1.0 + g1) * mix, ln1_gain[l], ln1_bias[l])
        h = _standardize(x) * (1.0 + sc2) + sh2
        f = _conv_glu_ffn(h, w_ffn_up[l], w_ffn_conv[l], b_ffn_conv[l], w_ffn_down[l])
        x = _layer_norm(ALPHA * x + (1.0 + g2) * f, ln2_gain[l], ln2_bias[l])
    return x
```

```cpp
#include <hip/hip_runtime.h>
#include <hip/hip_cooperative_groups.h>
#include <cstdio>
#include <cstdint>
namespace cg = cooperative_groups;

#define DI __device__ __forceinline__
typedef unsigned short bf16_t;
typedef short bf16x8 __attribute__((ext_vector_type(8)));
typedef float f32x4 __attribute__((ext_vector_type(4)));

constexpr int T_ = 32768, S_ = 8192, FH = 2816;
constexpr size_t U_ = 67108864;
constexpr float ALPHA_ = 1.189207115002721f;

constexpr size_t OFF_WIN = 0;
constexpr size_t OFF_WQK = OFF_WIN + 9437184;
constexpr size_t OFF_WDN = OFF_WQK + 524288;
constexpr size_t OFF_WGL = OFF_WDN + 2097152;
constexpr size_t OFF_WMX = OFF_WGL + 2097152;
constexpr size_t OFF_WUP = OFF_WMX + 2097152;
constexpr size_t OFF_WFD = OFF_WUP + 11534336;
constexpr size_t OFF_MOD = OFF_WFD + 5767168;
constexpr size_t OFF_APOW = OFF_MOD + 98304;
constexpr size_t OFF_BBAR = OFF_APOW + 1064960;
constexpr size_t OFF_KC = OFF_BBAR + 262144;
constexpr size_t OFF_EMAT = OFF_KC + 1048576;
constexpr size_t OFF_CMAT = OFF_EMAT + 8388608;
constexpr size_t OFF_IG = OFF_CMAT + 8388608;
constexpr size_t OFF_LOGF = OFF_IG + 524288;
constexpr size_t OFF_BCUM = OFF_LOGF + 524288;
constexpr size_t OFF_AARR = OFF_BCUM + 524288;
constexpr size_t OFF_BLAST = OFF_AARR + 8192;
constexpr size_t OFF_MST = OFF_BLAST + 8192;
constexpr size_t OFF_NU = OFF_MST + 8448;
constexpr size_t OFF_BAR = OFF_NU + 1048576;
constexpr size_t OFF_STATS = OFF_BAR + 16384;
constexpr size_t OFF_END = OFF_STATS + 262144;
static_assert(OFF_END <= U_, "R0 overflow");

struct Params { const float* in[30]; float* out; unsigned char* ws; };

DI float bf2f(unsigned short h) { return __uint_as_float(((unsigned)h) << 16); }
typedef __bf16 bf16x2_t __attribute__((ext_vector_type(2)));
typedef float f32x2_t __attribute__((ext_vector_type(2)));
DI unsigned pk2(float lo, float hi) { f32x2_t v = {lo, hi}; bf16x2_t b = __builtin_convertvector(v, bf16x2_t); return __builtin_bit_cast(unsigned, b); }
DI unsigned short f2bf(float x) { return (unsigned short)(pk2(x, 0.f) & 0xffffu); }
DI uint2 pk4(f32x4 v) { return make_uint2(pk2(v[0], v[1]), pk2(v[2], v[3])); }
DI float sigm(float x) { return __builtin_amdgcn_rcpf(1.f + __expf(-x)); }
DI float gelu_t(float x) { float u = 1.5957691216057308f * (x + 0.044715f * x * x * x); return x * __builtin_amdgcn_rcpf(1.f + __expf(-u)); }
DI float logsig(float x) { return (x < 0.f) ? (x - log1pf(__expf(x))) : (-log1pf(__expf(-x))); }
DI bf16x8 ld16(const bf16_t* p) { return *reinterpret_cast<const bf16x8*>(p); }
DI f32x4 mfma16(bf16x8 a, bf16x8 b, f32x4 c) { return __builtin_amdgcn_mfma_f32_16x16x32_bf16(a, b, c, 0, 0, 0); }
DI int fresh_tid() { int t = threadIdx.x; asm volatile("" : "+v"(t)); return t; }
DI float dpp_f(float v, const int ctrl_sel) {
    int x = __builtin_bit_cast(int, v), r;
    if (ctrl_sel == 0) r = __builtin_amdgcn_update_dpp(0, x, 0xB1, 0xF, 0xF, false);
    else if (ctrl_sel == 1) r = __builtin_amdgcn_update_dpp(0, x, 0x4E, 0xF, 0xF, false);
    else if (ctrl_sel == 2) r = __builtin_amdgcn_update_dpp(0, x, 0x141, 0xF, 0xF, false);
    else r = __builtin_amdgcn_update_dpp(0, x, 0x140, 0xF, 0xF, false);
    return __builtin_bit_cast(float, r);
}
DI float wsum(float v) {
    v += dpp_f(v, 0); v += dpp_f(v, 1); v += dpp_f(v, 2); v += dpp_f(v, 3);
    const int x = __builtin_bit_cast(int, v);
    return __builtin_bit_cast(float, __builtin_amdgcn_readlane(x, 0)) + __builtin_bit_cast(float, __builtin_amdgcn_readlane(x, 16))
         + __builtin_bit_cast(float, __builtin_amdgcn_readlane(x, 32)) + __builtin_bit_cast(float, __builtin_amdgcn_readlane(x, 48));
}

template <class LA, class LB>
DI void gemm_tile(unsigned char* smem, const int tid, int nk, LA la, LB lb, f32x4 (&acc)[4][4]) {
    const int lane = tid & 63, wid = tid >> 6;
    const int wf = wid >> 1, wt = wid & 1;
    const int lr = tid >> 3, lc = tid & 7;
    unsigned char* sA = smem;
    unsigned char* sB = smem + 32768;
#pragma unroll
    for (int i = 0; i < 4; ++i)
#pragma unroll
        for (int j = 0; j < 4; ++j) acc[i][j] = f32x4{0.f, 0.f, 0.f, 0.f};
    uint4 ra[4], rb[4], na[4], nb[4];
#pragma unroll
    for (int i = 0; i < 4; ++i) { ra[i] = la(lr + 32 * i, lc * 8); rb[i] = lb(lr + 32 * i, lc * 8); }
    if (nk > 1) {
#pragma unroll
        for (int i = 0; i < 4; ++i) { na[i] = la(lr + 32 * i, 64 + lc * 8); nb[i] = lb(lr + 32 * i, 64 + lc * 8); }
    }
    const int woff = lr * 128 + ((lc ^ ((lr >> 1) & 7)) << 4);
#pragma unroll
    for (int i = 0; i < 4; ++i) { *(uint4*)(sA + woff + i * 4096) = ra[i]; *(uint4*)(sB + woff + i * 4096) = rb[i]; }
    __syncthreads();
    const int frow = lane & 15, fq = lane >> 4, fsw = (frow >> 1) & 7;
    for (int kt = 0; kt < nk; ++kt) {
        const int cur = kt & 1;
#pragma unroll
        for (int i = 0; i < 4; ++i) { ra[i] = na[i]; rb[i] = nb[i]; }
        if (kt + 2 < nk) {
#pragma unroll
            for (int i = 0; i < 4; ++i) { na[i] = la(lr + 32 * i, (kt + 2) * 64 + lc * 8); nb[i] = lb(lr + 32 * i, (kt + 2) * 64 + lc * 8); }
        }
        const unsigned char* cA = sA + cur * 16384 + (wf * 64 + frow) * 128;
        const unsigned char* cB = sB + cur * 16384 + (wt * 64 + frow) * 128;
#pragma unroll
        for (int ks = 0; ks < 2; ++ks) {
            const int ch = ((ks * 4 + fq) ^ fsw) << 4;
            bf16x8 af[4], bfr[4];
#pragma unroll
            for (int i = 0; i < 4; ++i) { af[i] = *(const bf16x8*)(cA + i * 2048 + ch); bfr[i] = *(const bf16x8*)(cB + i * 2048 + ch); }
#pragma unroll
            for (int i = 0; i < 4; ++i)
#pragma unroll
                for (int j = 0; j < 4; ++j) acc[i][j] = mfma16(af[i], bfr[j], acc[i][j]);
        }
        if (kt + 1 < nk) {
            const int nbuf = (cur ^ 1) * 16384;
#pragma unroll
            for (int i = 0; i < 4; ++i) { *(uint4*)(sA + nbuf + woff + i * 4096) = ra[i]; *(uint4*)(sB + nbuf + woff + i * 4096) = rb[i]; }
        }
        __syncthreads();
    }
}
template <class F>
DI void epi_loop(f32x4 (&acc)[4][4], const int vtid_, F f) {
    const int lane_ = vtid_ & 63, wid_ = vtid_ >> 6, wf_ = wid_ >> 1, wt_ = wid_ & 1;
#pragma unroll
    for (int fi = 0; fi < 4; ++fi)
#pragma unroll
        for (int ti = 0; ti < 4; ++ti) f(wf_ * 64 + fi * 16 + (lane_ >> 4) * 4, wt_ * 64 + ti * 16 + (lane_ & 15), acc[fi][ti]);
}


namespace pg8 {
#define PG8_LAS __attribute__((address_space(3)))
constexpr int BM = 256, BK = 64, HALF = 128, HTB = HALF * BK * 2, NXCD = 8, WGM = 8;
DI int lds_byte(int r, int c) { const int st = (r >> 4) * 2 + (c >> 5), rr = r & 15, cc = c & 31, ob = rr * 64 + cc * 2; return st * 1024 + (ob ^ (((ob >> 9) & 1) << 5)); }
DI void stage_rc(int b, int& R, int& C) { const int st = b / 1024, sb = b % 1024, swz = sb ^ (((sb >> 9) & 1) << 5); R = (st >> 1) * 16 + swz / 64; C = (st & 1) * 32 + (swz % 64) / 2; }
DI int perm32(int rho) { const int n = rho >> 4, i = rho & 15; return 8 * (i >> 2) + 4 * n + (i & 3); }
struct Unit { int pm, pn; };
struct Gemm { const bf16_t* A; const bf16_t* Bt; int lda, ldb, K, a_pn_off; };
struct StaticOrder {
    int nM, nN, nwg, G, c;
    DI void init(int M, int N, int G_, int c_) { nM = M / BM; nN = N / BM; nwg = nM * nN; G = G_; c = c_; }
    DI bool next(int i, Unit& u) const {
        const long L = (long)i * G + c; if (L >= nwg) return false;
        int wgid = (int)L; { const int q = nwg / NXCD, r = nwg % NXCD, xcd = wgid % NXCD, off = wgid / NXCD; wgid = (xcd < r ? xcd * (q + 1) : r * (q + 1) + (xcd - r) * q) + off; }
        const int nig = WGM * nN, gid = wgid / nig, fm = gid * WGM, gsz = (nM - fm) < WGM ? (nM - fm) : WGM;
        u.pm = fm + ((wgid % nig) % gsz); u.pn = (wgid % nig) / gsz; return true;
    }
};
template <class Epi>
DI void gemm_phase(PG8_LAS unsigned char* lds, const Gemm g, const StaticOrder& S, const Epi& E) {
    int tid = threadIdx.x; asm volatile("" : "+v"(tid));
    const int wid = __builtin_amdgcn_readfirstlane(tid >> 6), lane = tid & 63, wr = wid >> 2, wc = wid & 3, fr = lane & 15, fq = lane >> 4;
    const int nt = g.K / BK;
    unsigned voffA[2], voffB[2];
#pragma unroll
    for (int i = 0; i < 2; ++i) { int R, C; stage_rc(tid * 16 + i * 8192, R, C); const int Rb = (R & ~31) + perm32(R & 31);
        voffA[i] = (unsigned)(R * g.lda + C) * 2u; voffB[i] = (unsigned)(Rb * g.ldb + C) * 2u; }
    const size_t kstep = (size_t)(BK * 2);
    const size_t hstepA = (size_t)HALF * g.lda * 2, hstepB = (size_t)HALF * g.ldb * 2;
    const size_t tstepA = 2 * hstepA, tstepB = 2 * hstepB;
    const unsigned ldsw = (unsigned)wid * 1024u;
    const int aoff = lds_byte(wr * 64 + fr, fq * 8), boff = lds_byte(wc * 32 + fr, fq * 8);
#define PG8_SA(b, h) (((b) * 2 + (h)) * HTB)
#define PG8_SB(b, h) ((4 + (b) * 2 + (h)) * HTB)
#define PG8_STAGE(bufoff, gbase, voff) do { _Pragma("unroll") for (int _i = 0; _i < 2; ++_i) \
        __builtin_amdgcn_global_load_lds((const unsigned*)((const char*)(gbase) + (voff)[_i]), (PG8_LAS unsigned*)(lds + (bufoff) + ldsw + _i * 8192), 16, 0, 0); } while (0)
#define PG8_LDA(dst, b, h) do { _Pragma("unroll") for (int m = 0; m < 4; ++m) _Pragma("unroll") for (int k = 0; k < 2; ++k) dst[m][k] = *(const PG8_LAS bf16x8*)(lds + PG8_SA(b, h) + aoff + m * 2048 + k * 1024); } while (0)
#define PG8_LDB(dst, b, h) do { _Pragma("unroll") for (int n = 0; n < 2; ++n) _Pragma("unroll") for (int k = 0; k < 2; ++k) dst[n][k] = *(const PG8_LAS bf16x8*)(lds + PG8_SB(b, h) + boff + n * 2048 + k * 1024); } while (0)
#define PG8_MMA(ai, bj, At, Bt) do { __builtin_amdgcn_s_setprio(1); _Pragma("unroll") for (int m = 0; m < 4; ++m) _Pragma("unroll") for (int n = 0; n < 2; ++n) _Pragma("unroll") for (int k = 0; k < 2; ++k) \
        acc[ai][bj][m][n] = __builtin_amdgcn_mfma_f32_16x16x32_bf16(Bt[n][k], At[m][k], acc[ai][bj][m][n], 0, 0, 0); __builtin_amdgcn_s_setprio(0); } while (0)
#define PG8_WAIT_V(n) asm volatile("s_waitcnt vmcnt(" #n ")" ::: "memory")
#define PG8_WAIT_L(n) asm volatile("s_waitcnt lgkmcnt(" #n ")" ::: "memory")
#define PG8_BAR __builtin_amdgcn_s_barrier()
#define PG8_SCHED __builtin_amdgcn_sched_barrier(0)
    Unit cur, nxt; int ui = 0;
    if (!S.next(0, cur)) return;
    f32x4 acc[2][2][4][2];
#pragma unroll
    for (int a = 0; a < 2; ++a)
#pragma unroll
        for (int b = 0; b < 2; ++b)
#pragma unroll
            for (int m = 0; m < 4; ++m)
#pragma unroll
                for (int n = 0; n < 2; ++n) acc[a][b][m][n] = (f32x4){0.f, 0.f, 0.f, 0.f};
    bf16x8 At[4][2], B0[2][2], B1[2][2];
    const char* cA = (const char*)g.A + (size_t)cur.pm * tstepA + (size_t)cur.pn * g.a_pn_off; const char* cB = (const char*)g.Bt + (size_t)cur.pn * tstepB;
    PG8_STAGE(PG8_SB(0, 0), cB, voffB); PG8_STAGE(PG8_SB(0, 1), cB + hstepB, voffB); PG8_STAGE(PG8_SA(0, 0), cA, voffA); PG8_STAGE(PG8_SA(0, 1), cA + hstepA, voffA);
    if (wr == 1) PG8_BAR;
    PG8_WAIT_V(2); PG8_BAR;
    PG8_STAGE(PG8_SB(1, 0), cB + kstep, voffB); PG8_STAGE(PG8_SA(1, 0), cA + kstep, voffA); PG8_STAGE(PG8_SB(1, 1), cB + hstepB + kstep, voffB);
    PG8_WAIT_V(6); PG8_BAR;
    for (;;) {
        const bool has_next = S.next(ui + 1, nxt);
        const char* nA = has_next ? (const char*)g.A + (size_t)nxt.pm * tstepA + (size_t)nxt.pn * g.a_pn_off : cA; const char* nB = has_next ? (const char*)g.Bt + (size_t)nxt.pn * tstepB : cB;
        for (int t = 0; t < nt; t += 2) {
            const bool last = (t == nt - 2);
            const char* a1 = cA + (size_t)(t + 1) * kstep;
            const char* a2 = last ? nA : cA + (size_t)(t + 2) * kstep; const char* b2 = last ? nB : cB + (size_t)(t + 2) * kstep;
            const char* a3 = a2 + kstep; const char* b3 = b2 + kstep;
            PG8_LDB(B0, 0, 0); PG8_LDB(B1, 0, 1); PG8_SCHED; PG8_LDA(At, 0, 0); PG8_STAGE(PG8_SA(1, 1), a1 + hstepA, voffA);
            PG8_WAIT_V(8); PG8_WAIT_L(0); PG8_BAR; PG8_MMA(0, 0, At, B0); PG8_MMA(0, 1, At, B1); PG8_BAR; PG8_SCHED;
            PG8_LDA(At, 0, 1); PG8_STAGE(PG8_SB(0, 0), b2, voffB); PG8_STAGE(PG8_SB(0, 1), b2 + hstepB, voffB); PG8_STAGE(PG8_SA(0, 0), a2, voffA);
            PG8_WAIT_V(8); PG8_WAIT_L(0); PG8_BAR; PG8_MMA(1, 0, At, B0); PG8_MMA(1, 1, At, B1); PG8_BAR; PG8_SCHED;
            PG8_LDB(B0, 1, 0); PG8_LDB(B1, 1, 1); PG8_SCHED; PG8_LDA(At, 1, 0); PG8_STAGE(PG8_SA(0, 1), a2 + hstepA, voffA);
            PG8_WAIT_V(8); PG8_WAIT_L(0); PG8_BAR; PG8_MMA(0, 0, At, B0); PG8_MMA(0, 1, At, B1); PG8_BAR; PG8_SCHED;
            PG8_LDA(At, 1, 1); PG8_STAGE(PG8_SB(1, 0), b3, voffB); PG8_STAGE(PG8_SB(1, 1), b3 + hstepB, voffB); PG8_STAGE(PG8_SA(1, 0), a3, voffA);
            PG8_WAIT_V(8); PG8_WAIT_L(0); PG8_BAR; PG8_MMA(1, 0, At, B0); PG8_MMA(1, 1, At, B1); PG8_BAR; PG8_SCHED;
        }
        if (wr == 0) PG8_BAR;
        { int efr = fr, efq = fq; asm volatile("" : "+v"(efr), "+v"(efq)); E(acc, cur, wr, wc, efr, efq); }
        if (!has_next) break;
#pragma unroll
        for (int a = 0; a < 2; ++a)
#pragma unroll
            for (int b = 0; b < 2; ++b)
#pragma unroll
                for (int m = 0; m < 4; ++m)
#pragma unroll
                    for (int n = 0; n < 2; ++n) acc[a][b][m][n] = (f32x4){0.f, 0.f, 0.f, 0.f};
        cur = nxt; cA = nA; cB = nB; ++ui;
        if (wr == 1) PG8_BAR;
    }
    PG8_WAIT_V(0);
    PG8_BAR;
#undef PG8_SA
#undef PG8_SB
#undef PG8_STAGE
#undef PG8_LDA
#undef PG8_LDB
#undef PG8_MMA
#undef PG8_WAIT_V
#undef PG8_WAIT_L
#undef PG8_BAR
#undef PG8_SCHED
}
template <class F>
DI void epi8(const f32x4 (&acc)[2][2][4][2], const Unit& u, int wr, int wc, int fr, int fq, F f) {
#pragma unroll
    for (int ai = 0; ai < 2; ++ai)
#pragma unroll
        for (int m = 0; m < 4; ++m)
#pragma unroll
            for (int bj = 0; bj < 2; ++bj) f(u.pm * 256 + ai * 128 + wr * 64 + m * 16 + fr, u.pn * 256 + bj * 128 + wc * 32 + 8 * fq, acc[ai][bj][m][0], acc[ai][bj][m][1]);
}
}
#define TILE_AI(i) ((i) >> 3)
#define TILE_M(i)  (((i) >> 1) & 3)
#define TILE_BJ(i) ((i) & 1)
DI unsigned pk4u8(f32x4 v) {
    unsigned r = 0;
    r = __builtin_amdgcn_cvt_pk_u8_f32(v[0] * 255.f, 0, r); r = __builtin_amdgcn_cvt_pk_u8_f32(v[1] * 255.f, 1, r);
    r = __builtin_amdgcn_cvt_pk_u8_f32(v[2] * 255.f, 2, r); r = __builtin_amdgcn_cvt_pk_u8_f32(v[3] * 255.f, 3, r);
    return r;
}
DI f32x4 un4u8(unsigned w) {
    const float k = 1.f / 255.f;
    return (f32x4){(float)(w & 0xffu) * k, (float)((w >> 8) & 0xffu) * k, (float)((w >> 16) & 0xffu) * k, (float)(w >> 24) * k};
}
DI uint4 pk8(f32x4 a, f32x4 b) { return make_uint4(pk2(a[0], a[1]), pk2(a[2], a[3]), pk2(b[0], b[1]), pk2(b[2], b[3])); }

struct RowMajor {
    const bf16_t* base; int ld;
    DI uint4 operator()(int r, int k) const { return *(const uint4*)(base + (size_t)r * ld + k); }
};

DI void transpose_tile(unsigned char* smem, const int tid, const float* src, int K, int N, bf16_t* dst, int ldd, int permid, int kt, int nt) {
    float (*tile)[65] = (float (*)[65])smem;
    const int k0 = kt * 64, n0 = nt * 64;
    float tv[16];
#pragma unroll
    for (int i = 0; i < 16; ++i) {
        int kk = i * 4 + (tid >> 6), nn = tid & 63;
        tv[i] = (n0 + nn < N) ? src[(size_t)(k0 + kk) * N + n0 + nn] : 0.f;
    }
#pragma unroll
    for (int i = 0; i < 16; ++i) tile[tid & 63][i * 4 + (tid >> 6)] = tv[i];
    __syncthreads();
#pragma unroll 4
    for (int i = 0; i < 16; ++i) {
        int nn = i * 4 + (tid >> 6), kk = tid & 63;
        int n = n0 + nn;
        if (n < N) {
            int row = n;
            if (permid == 1) row = (n < 2048) ? n : ((n >= 2056) ? n - 8 : -1);
            else if (permid == 2) row = (n < 1024) ? ((n >> 2) * 8 + (n & 3)) : (((n - 1024) >> 2) * 8 + 4 + (n & 3));
            else if (permid == 3) row = (n < 2816) ? ((n >> 2) * 8 + (n & 3)) : (((n - 2816) >> 2) * 8 + 4 + (n & 3));
            if (row >= 0) dst[(size_t)row * ldd + k0 + kk] = f2bf(tile[nn][kk]);
        }
    }
    __syncthreads();
}

DI void phase0(const Params& p, unsigned char* smem, const int tid, const int vb, const int nvb) {
    unsigned char* ws = p.ws;
    const int NTR = 4112, NADA = 192, NS5 = 32;
    for (int it0 = vb; it0 < NTR + NADA + NS5; it0 += nvb) {
        const int it = (it0 < NADA + NS5) ? (NTR + it0) : (it0 - NADA - NS5);
        if (it < NTR) {
            int id = it;
            if (id < 1168) { transpose_tile(smem, tid, p.in[4], 1024, 4616, (bf16_t*)(ws + OFF_WIN), 1024, 1, id / 73, id % 73); continue; }
            id -= 1168;
            if (id < 64) {
                int isk = id >> 5, r = id & 31, h = r >> 3, t = r & 7;
                transpose_tile(smem, tid, (isk ? p.in[9] : p.in[8]) + (size_t)h * 256 * 128, 256, 128,
                               (bf16_t*)(ws + OFF_WQK) + (size_t)h * 65536 + (isk ? 128 * 256 : 0), 256, 0, t >> 1, t & 1);
                continue;
            }
            id -= 64;
            if (id < 256) { transpose_tile(smem, tid, p.in[11], 1024, 1024, (bf16_t*)(ws + OFF_WDN), 1024, 0, id >> 4, id & 15); continue; }
            id -= 256;
            if (id < 256) { transpose_tile(smem, tid, p.in[20], 512, 2048, (bf16_t*)(ws + OFF_WGL), 512, 2, id >> 5, id & 31); continue; }
            id -= 256;
            if (id < 256) { transpose_tile(smem, tid, p.in[21], 1024, 1024, (bf16_t*)(ws + OFF_WMX), 1024, 0, id >> 4, id & 15); continue; }
            id -= 256;
            if (id < 1408) { transpose_tile(smem, tid, p.in[24], 1024, 5632, (bf16_t*)(ws + OFF_WUP), 1024, 3, id / 88, id % 88); continue; }
            id -= 1408;
            transpose_tile(smem, tid, p.in[27], 2816, 1024, (bf16_t*)(ws + OFF_WFD), 2816, 0, id >> 4, id & 15);
        } else if (it < NTR + NADA) {
            const int a = it - NTR;
            float* sc = (float*)smem;
            float* red = (float*)(smem + 16384);
            for (int i = tid; i < 4096; i += 256) { float v = p.in[1][i]; sc[i] = v / (1.f + __expf(-v)); }
            __syncthreads();
            const int col = tid & 31, kg = tid >> 5, n0 = a * 32;
            float a0 = 0, a1 = 0, a2 = 0, a3 = 0;
            const float* wp = p.in[2] + (size_t)(kg * 128) * 6144 + n0 + col;
#pragma unroll 16
            for (int k = 0; k < 128; ++k) {
                float w = wp[(size_t)k * 6144];
                int kk = kg * 128 + k;
                a0 += sc[kk] * w; a1 += sc[1024 + kk] * w; a2 += sc[2048 + kk] * w; a3 += sc[3072 + kk] * w;
            }
            red[(kg * 4 + 0) * 32 + col] = a0; red[(kg * 4 + 1) * 32 + col] = a1; red[(kg * 4 + 2) * 32 + col] = a2; red[(kg * 4 + 3) * 32 + col] = a3;
            __syncthreads();
            if (tid < 128) {
                int b = tid >> 5, c2 = tid & 31;
                float sacc = p.in[3][n0 + c2];
                for (int g = 0; g < 8; ++g) sacc += red[(g * 4 + b) * 32 + c2];
                ((float*)(ws + OFF_MOD))[b * 6144 + n0 + c2] = sacc;
            }
            __syncthreads();
        } else {
            const int g = it - NTR - NADA;
            const float dtf = expf(p.in[14][g]);
            const double dt = (double)dtf;
            float2* apow = (float2*)(ws + OFF_APOW);
            for (int idx = tid; idx < 64 * 65; idx += 256) {
                int pp = idx / 65, tau = idx % 65;
                double lr = p.in[12][g * 64 + pp], li = p.in[13][g * 64 + pp];
                double rev = li * dt * (double)tau * 0.15915494309189535;
                rev -= rint(rev);
                float mag = expf((float)(lr * dt * (double)tau));
                apow[(size_t)(g * 64 + pp) * 65 + tau] = make_float2(mag * __builtin_amdgcn_cosf((float)rev), mag * __builtin_amdgcn_sinf((float)rev));
            }
            if (tid < 64) {
                int pp = tid;
                float lr = p.in[12][g * 64 + pp], li = p.in[13][g * 64 + pp];
                float em1 = expm1f(lr * dtf), mag = em1 + 1.f;
                double rev = (double)li * dt * 0.15915494309189535;
                double revh = 0.5 * rev;
                rev -= rint(rev); revh -= rint(revh);
                float sh = __builtin_amdgcn_sinf((float)revh);
                float arm1 = em1 - 2.f * mag * sh * sh;
                float ai = mag * __builtin_amdgcn_sinf((float)rev);
                float den = lr * lr + li * li;
                float zr = (arm1 * lr + ai * li) / den, zi = (ai * lr - arm1 * li) / den;
                float2* bb = (float2*)(ws + OFF_BBAR);
                for (int c2 = 0; c2 < 16; ++c2) {
                    float br = p.in[15][(size_t)(g * 64 + pp) * 16 + c2], bi = p.in[16][(size_t)(g * 64 + pp) * 16 + c2];
                    bb[(size_t)(g * 64 + pp) * 16 + c2] = make_float2(zr * br - zi * bi, zr * bi + zi * br);
                }
            }
            __syncthreads();
            __syncthreads();
        }
    }
}

DI void row_stats(const float (&v)[16], float& mean, float& rstd) {
    float s = 0.f;
#pragma unroll
    for (int i = 0; i < 16; ++i) s += v[i];
    mean = wsum(s) * (1.f / 1024.f);
    float q = 0.f;
#pragma unroll
    for (int i = 0; i < 16; ++i) { float d = v[i] - mean; q += d * d; }
    rstd = rsqrtf(wsum(q) * (1.f / 1024.f) + 1e-5f);
}

DI void phase1(const Params& p, unsigned char* smem) {
    unsigned char* ws = p.ws;
    int ft_ = threadIdx.x; asm volatile("" : "+v"(ft_));
    const int lane = ft_ & 63, wid = ft_ >> 6;
    const float* mod = (const float*)(ws + OFF_MOD);
    bf16_t* h1 = (bf16_t*)(ws + 1 * U_);
    float4 gw0[16], gw1[16];
#pragma unroll
    for (int i = 0; i < 4; ++i)
#pragma unroll
        for (int e = 0; e < 4; ++e) {
            const float* wp = p.in[4] + (size_t)(i * 256 + lane * 4 + e) * 4616 + 2048;
            gw0[i * 4 + e] = *(const float4*)wp; gw1[i * 4 + e] = *(const float4*)(wp + 4);
        }
    float* ig = (float*)(ws + OFF_IG);
    float* lf = (float*)(ws + OFF_LOGF);
    for (int row0 = (blockIdx.x * 8 + wid) * 4; row0 < T_; row0 += gridDim.x * 32) {
        float vv[4][16];
#pragma unroll
        for (int rr = 0; rr < 4; ++rr)
#pragma unroll
            for (int i = 0; i < 4; ++i) { float4 t = *(const float4*)(p.in[0] + (size_t)(row0 + rr) * 1024 + i * 256 + lane * 4); vv[rr][4 * i] = t.x; vv[rr][4 * i + 1] = t.y; vv[rr][4 * i + 2] = t.z; vv[rr][4 * i + 3] = t.w; }
#pragma unroll
        for (int rr = 0; rr < 4; ++rr) {
            const int row = row0 + rr;
            float mean, rstd; row_stats(vv[rr], mean, rstd);
            const float* mb = mod + (row >> 13) * 6144;
            float ga[8];
#pragma unroll
            for (int j = 0; j < 8; ++j) ga[j] = 0.f;
#pragma unroll
            for (int i = 0; i < 4; ++i) {
                int c = i * 256 + lane * 4;
                float4 sh = *(const float4*)(mb + c), sc = *(const float4*)(mb + 1024 + c);
                f32x4 o;
                o[0] = (vv[rr][4 * i] - mean) * rstd * (1.f + sc.x) + sh.x;
                o[1] = (vv[rr][4 * i + 1] - mean) * rstd * (1.f + sc.y) + sh.y;
                o[2] = (vv[rr][4 * i + 2] - mean) * rstd * (1.f + sc.z) + sh.z;
                o[3] = (vv[rr][4 * i + 3] - mean) * rstd * (1.f + sc.w) + sh.w;
                *(uint2*)(h1 + (size_t)row * 1024 + c) = pk4(o);
#pragma unroll
                for (int e = 0; e < 4; ++e) {
                    const float4 w0 = gw0[i * 4 + e], w1 = gw1[i * 4 + e];
                    ga[0] += o[e] * w0.x; ga[1] += o[e] * w0.y; ga[2] += o[e] * w0.z; ga[3] += o[e] * w0.w;
                    ga[4] += o[e] * w1.x; ga[5] += o[e] * w1.y; ga[6] += o[e] * w1.z; ga[7] += o[e] * w1.w;
                }
            }
#pragma unroll
            for (int j = 0; j < 8; ++j) ga[j] = wsum(ga[j]);
            if (lane < 8) {
                float val = ga[0];
#pragma unroll
                for (int j = 1; j < 8; ++j) val = (lane == j) ? ga[j] : val;
                val += p.in[5][2048 + lane];
                const int b = row >> 13, sidx = row & 8191;
                if (lane < 4) ig[(size_t)(b * 4 + lane) * 8192 + sidx] = val;
                else lf[(size_t)(b * 4 + lane - 4) * 8192 + sidx] = logsig(val);
            }
        }
    }
    const float2* apow = (const float2*)(ws + OFF_APOW);
    const float2* bbar = (const float2*)(ws + OFF_BBAR);
    const float* cre = p.in[17];
    const float* cim = p.in[18];
    const int gtid = blockIdx.x * 512 + fresh_tid(), gstr = gridDim.x * 512;
    bf16_t* emat = (bf16_t*)(ws + OFF_EMAT);
    for (int idx = gtid; idx < 32 * 128 * 128; idx += gstr) {
        const int g = idx >> 14, m = (idx >> 7) & 127, k8 = idx & 127;
        const int pp = m & 63, j = k8 >> 1, c20 = (k8 & 1) * 8;
        const float2 a = apow[(size_t)(g * 64 + pp) * 65 + (63 - j)];
        const float4* bp = (const float4*)(bbar + (size_t)(g * 64 + pp) * 16 + c20);
        float o[8];
#pragma unroll
        for (int e = 0; e < 4; ++e) {
            float4 b2 = bp[e];
            o[2 * e] = (m < 64) ? (a.x * b2.x - a.y * b2.y) : (a.x * b2.y + a.y * b2.x);
            o[2 * e + 1] = (m < 64) ? (a.x * b2.z - a.y * b2.w) : (a.x * b2.w + a.y * b2.z);
        }
        *(uint4*)(emat + (size_t)idx * 8) = make_uint4(pk2(o[0], o[1]), pk2(o[2], o[3]), pk2(o[4], o[5]), pk2(o[6], o[7]));
    }
}

struct EpiIn {
    const float* bin; bf16_t *xm, *xmT, *og, *sga, *sgb, *us;
    DI void operator()(const f32x4 (&acc)[2][2][4][2], const pg8::Unit& u, int wr, int wc, int fr, int fq) const {
        const int pn = u.pn;
        int boff, c0, slot;
        if (pn < 4) { boff = 0; c0 = 0; slot = 0; }
        else if (pn < 8) { boff = 1024; c0 = 1024; slot = 0; }
        else if (pn < 10) { boff = 2056; c0 = 2048; slot = 0; }
        else if (pn < 14) { boff = 2568; c0 = 2560; slot = 1; }
        else { boff = 3592; c0 = 3584; slot = 2; }
        const int colb = pn * 256 + wc * 32 + 8 * fq - c0;
        f32x4 bia[2][2];
#pragma unroll
        for (int bj = 0; bj < 2; ++bj) { bia[bj][0] = *(const f32x4*)(bin + boff + colb + bj * 128); bia[bj][1] = *(const f32x4*)(bin + boff + colb + bj * 128 + 4); }
        const int t0 = u.pm * 256 + wr * 64 + fr;
        if (pn < 4) {
#pragma unroll
            for (int i = 0; i < 16; ++i) {
                const int ai = TILE_AI(i), m = TILE_M(i), bj = TILE_BJ(i);
                const int t = t0 + ai * 128 + m * 16, col = colb + bj * 128;
                const f32x4 v0 = acc[ai][bj][m][0] + bia[bj][0], v1 = acc[ai][bj][m][1] + bia[bj][1];
                *(uint4*)(xm + (size_t)t * 1024 + col) = pk8(v0, v1);
                const int b = t >> 13, sidx = t & 8191;
                bf16_t* tp = xmT + ((((size_t)(b * 4 + (col >> 8)) * 128 + (sidx >> 6)) * 256 + (col & 255)) * 64) + (sidx & 63);
#pragma unroll
                for (int r = 0; r < 4; ++r) { *tp = f2bf(v0[r]); tp += 64; asm volatile("" : "+v"(tp)); }
#pragma unroll
                for (int r = 0; r < 4; ++r) { *tp = f2bf(v1[r]); tp += 64; asm volatile("" : "+v"(tp)); }
            }
        } else if (pn == 8 || pn == 9) {
#pragma unroll
            for (int i = 0; i < 16; ++i) {
                const int ai = TILE_AI(i), m = TILE_M(i), bj = TILE_BJ(i);
                const int t = t0 + ai * 128 + m * 16, col = colb + bj * 128;
                *(uint4*)(us + (size_t)t * 512 + col) = pk8(acc[ai][bj][m][0] + bia[bj][0], acc[ai][bj][m][1] + bia[bj][1]);
            }
        } else {
            unsigned char* dst = (unsigned char*)og + (size_t)slot * U_;
#pragma unroll
            for (int i = 0; i < 16; ++i) {
                const int ai = TILE_AI(i), m = TILE_M(i), bj = TILE_BJ(i);
                const int t = t0 + ai * 128 + m * 16, col = colb + bj * 128;
                f32x4 v0 = acc[ai][bj][m][0] + bia[bj][0], v1 = acc[ai][bj][m][1] + bia[bj][1];
#pragma unroll
                for (int r = 0; r < 4; ++r) { v0[r] = sigm(v0[r]); v1[r] = sigm(v1[r]); }
                *(uint2*)(dst + (size_t)t * 1024 + col) = make_uint2(pk4u8(v0), pk4u8(v1));
            }
        }
    }
};

DI void s5_tables_late(const Params& p, const int gtid, const int gstr) {
    unsigned char* ws = p.ws;
    const float2* apow = (const float2*)(ws + OFF_APOW);
    const float2* bbar = (const float2*)(ws + OFF_BBAR);
    const float* cre = p.in[17];
    const float* cim = p.in[18];
    bf16_t* kc = (bf16_t*)(ws + OFF_KC);
    for (int idx = gtid; idx < 32 * 64 * 16 * 2; idx += gstr) {
        const int g = idx >> 11, tau = (idx >> 5) & 63, c = (idx >> 1) & 15, c20 = (idx & 1) * 8;
        float sacc[8];
#pragma unroll
        for (int e = 0; e < 8; ++e) sacc[e] = 0.f;
#pragma unroll 4
        for (int pp = 0; pp < 64; ++pp) {
            const float cr = cre[(size_t)(g * 16 + c) * 64 + pp], ci = cim[(size_t)(g * 16 + c) * 64 + pp];
            const float2 a = apow[(size_t)(g * 64 + pp) * 65 + tau];
            const float wr_ = cr * a.x - ci * a.y, wi_ = cr * a.y + ci * a.x;
            const float4* bp = (const float4*)(bbar + (size_t)(g * 64 + pp) * 16 + c20);
#pragma unroll
            for (int e = 0; e < 4; ++e) { float4 b2 = bp[e]; sacc[2 * e] += wr_ * b2.x - wi_ * b2.y; sacc[2 * e + 1] += wr_ * b2.z - wi_ * b2.w; }
        }
        *(uint4*)(kc + (((size_t)(g * 64 + tau) * 16 + c) * 16 + c20)) = make_uint4(pk2(sacc[0], sacc[1]), pk2(sacc[2], sacc[3]), pk2(sacc[4], sacc[5]), pk2(sacc[6], sacc[7]));
    }
    bf16_t* cmat = (bf16_t*)(ws + OFF_CMAT);
    for (int idx = gtid; idx < 32 * 1024 * 16; idx += gstr) {
        const int g = idx >> 14, m = (idx >> 4) & 1023, kk0 = (idx & 15) * 8;
        const int t = m >> 4, c = m & 15, p0 = kk0 & 63;
        const float4* crp = (const float4*)(cre + (size_t)(g * 16 + c) * 64 + p0);
        const float4* cip = (const float4*)(cim + (size_t)(g * 16 + c) * 64 + p0);
        float4 cr0 = crp[0], cr1 = crp[1], ci0 = cip[0], ci1 = cip[1];
        const float crv[8] = {cr0.x, cr0.y, cr0.z, cr0.w, cr1.x, cr1.y, cr1.z, cr1.w};
        const float civ[8] = {ci0.x, ci0.y, ci0.z, ci0.w, ci1.x, ci1.y, ci1.z, ci1.w};
        float o[8];
#pragma unroll
        for (int e = 0; e < 8; ++e) {
            const float2 a = apow[(size_t)(g * 64 + p0 + e) * 65 + t + 1];
            o[e] = (kk0 < 64) ? (crv[e] * a.x - civ[e] * a.y) : -(crv[e] * a.y + civ[e] * a.x);
        }
        *(uint4*)(cmat + (size_t)idx * 8) = make_uint4(pk2(o[0], o[1]), pk2(o[2], o[3]), pk2(o[4], o[5]), pk2(o[6], o[7]));
    }
}

DI void phase3(const Params& p, unsigned char* smem, const int tid, const int vb, const int nvb) {
    unsigned char* ws = p.ws;
    const bf16_t* us = (const bf16_t*)(ws + 7 * U_);
    const bf16_t* emat = (const bf16_t*)(ws + OFF_EMAT);
    float* ebuf = (float*)((unsigned char*)p.out + (size_t)48 * 1048576);
    const bf16_t* xm = (const bf16_t*)(ws + 2 * U_);
    bf16_t* xc = (bf16_t*)(ws + 1 * U_);
    for (int it = vb; it < 256; it += nvb) {
        const int g = it >> 3, nt = (it >> 1) & 3, kh = it & 1;
        f32x4 acc[4][4];
        auto lb = [=](int r, int k) -> uint4 { return *(const uint4*)(us + ((size_t)((nt * 128 + r) * 64 + ((k + kh * 512) >> 4))) * 512 + g * 16 + (k & 15)); };
        gemm_tile(smem, tid, 8, RowMajor{emat + (size_t)g * 128 * 1024 + kh * 512, 1024}, lb, acc);
        epi_loop(acc, tid, [&](const int epi_f, const int epi_t, const f32x4 accv) __attribute__((always_inline)) {
            const int f = epi_f, n = nt * 128 + epi_t;
            *(f32x4*)(ebuf + (size_t)kh * 2097152 + ((size_t)n * 32 + g) * 128 + f) = accv;
        });
    }
    if (blockIdx.x >= 128) s5_tables_late(p, (blockIdx.x - 128) * 512 + fresh_tid(), (gridDim.x - 128) * 512);
    for (int i0 = vb; i0 < 512; i0 += nvb) {
        const int cgp = tid & 127, half = tid >> 7;
        const int t0 = i0 * 64 + half * 32, s0 = t0 & 8191;
        const int c0 = cgp * 8;
        float w[4][8], bb[8];
#pragma unroll
        for (int j = 0; j < 4; ++j)
#pragma unroll
            for (int e = 0; e < 8; ++e) w[j][e] = p.in[6][j * 1024 + c0 + e];
#pragma unroll
        for (int e = 0; e < 8; ++e) bb[e] = p.in[7][c0 + e];
        float r0[8], r1[8], r2[8];
#pragma unroll
        for (int e = 0; e < 8; ++e) { r0[e] = 0.f; r1[e] = 0.f; r2[e] = 0.f; }
        if (s0 > 0) {
            uint4 a = *(const uint4*)(xm + (size_t)(t0 - 3) * 1024 + c0), b = *(const uint4*)(xm + (size_t)(t0 - 2) * 1024 + c0), c = *(const uint4*)(xm + (size_t)(t0 - 1) * 1024 + c0);
            const unsigned* pa = (const unsigned*)&a; const unsigned* pb = (const unsigned*)&b; const unsigned* pc = (const unsigned*)&c;
#pragma unroll
            for (int e = 0; e < 4; ++e) {
                r0[2 * e] = bf2f(pa[e] & 0xffff); r0[2 * e + 1] = bf2f(pa[e] >> 16);
                r1[2 * e] = bf2f(pb[e] & 0xffff); r1[2 * e + 1] = bf2f(pb[e] >> 16);
                r2[2 * e] = bf2f(pc[e] & 0xffff); r2[2 * e + 1] = bf2f(pc[e] >> 16);
            }
        }
        for (int tb = 0; tb < 32; tb += 8) {
            uint4 av[8];
#pragma unroll
            for (int i = 0; i < 8; ++i) av[i] = *(const uint4*)(xm + (size_t)(t0 + tb + i) * 1024 + c0);
#pragma unroll
            for (int i = 0; i < 8; ++i) {
                const unsigned* pa = (const unsigned*)&av[i];
                float cur[8], y[8];
#pragma unroll
                for (int e = 0; e < 4; ++e) { cur[2 * e] = bf2f(pa[e] & 0xffff); cur[2 * e + 1] = bf2f(pa[e] >> 16); }
#pragma unroll
                for (int e = 0; e < 8; ++e) {
                    float z = bb[e] + w[0][e] * r0[e] + w[1][e] * r1[e] + w[2][e] * r2[e] + w[3][e] * cur[e];
                    y[e] = z * sigm(z);
                    r0[e] = r1[e]; r1[e] = r2[e]; r2[e] = cur[e];
                }
                *(uint4*)(xc + (size_t)(t0 + tb + i) * 1024 + c0) = make_uint4(pk2(y[0], y[1]), pk2(y[2], y[3]), pk2(y[4], y[5]), pk2(y[6], y[7]));
            }
        }
    }
    for (int u = vb * 4 + (tid >> 6); u < 2048; u += nvb * 4) {
        const int lane = tid & 63;
        const int bh = u >> 7, c = u & 127;
        const size_t o = (size_t)bh * 8192 + c * 64 + lane;
        float b = ((const float*)(ws + OFF_LOGF))[o];
        float ii = ((const float*)(ws + OFF_IG))[o];
        for (int d = 1; d < 64; d <<= 1) { float t = __shfl_up(b, d, 64); if (lane >= d) b += t; }
        float bl = __shfl(b, 63, 64);
        float g = bl - b + ii;
        for (int o2 = 32; o2 > 0; o2 >>= 1) g = fmaxf(g, __shfl_xor(g, o2, 64));
        ((float*)(ws + OFF_BCUM))[o] = b;
        if (lane == 0) { ((float*)(ws + OFF_AARR))[u] = g; ((float*)(ws + OFF_BLAST))[u] = bl; }
    }
}

DI void phase4_small(const Params& p, unsigned char* smem) {
    unsigned char* ws = p.ws;
    const int tid = fresh_tid();
    const int lane = tid & 63, wid = tid >> 6;
    if (blockIdx.x >= gridDim.x - 2) {
        const int bh = (blockIdx.x - (gridDim.x - 2)) * 8 + wid;
        const float* aa = (const float*)(ws + OFF_AARR) + bh * 128;
        const float* bl = (const float*)(ws + OFF_BLAST) + bh * 128;
        float* ms = (float*)(ws + OFF_MST) + bh * 132;
        const float p0 = bl[2 * lane], q0 = aa[2 * lane], p1 = bl[2 * lane + 1], q1 = aa[2 * lane + 1];
        float P = p0 + p1, Q = fmaxf(q0 + p1, q1);
#pragma unroll
        for (int d = 1; d < 64; d <<= 1) {
            const float Pp = __shfl_up(P, d, 64), Qp = __shfl_up(Q, d, 64);
            if (lane >= d) { Q = fmaxf(Qp + P, Q); P = Pp + P; }
        }
        float Pe = __shfl_up(P, 1, 64), Qe = __shfl_up(Q, 1, 64);
        const float m_even = (lane == 0) ? 0.f : fmaxf(Pe, Qe);
        const float m_odd = fmaxf(m_even + p0, q0);
        ms[2 * lane] = m_even; ms[2 * lane + 1] = m_odd;
        if (lane == 63) ms[128] = fmaxf(P, Q);
    }
    if (blockIdx.x < 128) {
        const int b = blockIdx.x >> 5, g = blockIdx.x & 31, pp = lane, seg = wid;
        const float2 a64 = ((const float2*)(ws + OFF_APOW))[(size_t)(g * 64 + pp) * 65 + 64];
        const float* ebuf = (const float*)((unsigned char*)p.out + (size_t)48 * 1048576);
        bf16_t* xcar = (bf16_t*)((unsigned char*)p.out + (size_t)40 * 1048576);
        float2* L = (float2*)smem;
        float erv[16], eiv[16];
#pragma unroll
        for (int i = 0; i < 16; ++i) { size_t o = ((size_t)(b * 128 + seg * 16 + i) * 32 + g) * 128 + pp; erv[i] = ebuf[o] + ebuf[o + 2097152]; eiv[i] = ebuf[o + 64] + ebuf[o + 2097152 + 64]; }
        float xr = 0.f, xi = 0.f;
#pragma unroll
        for (int i = 0; i < 16; ++i) { const float nr = a64.x * xr - a64.y * xi + erv[i], ni = a64.x * xi + a64.y * xr + eiv[i]; xr = nr; xi = ni; }
        L[seg * 64 + pp] = make_float2(xr, xi);
        float ar = a64.x, ai = a64.y;
#pragma unroll
        for (int k = 0; k < 4; ++k) { const float nr = ar * ar - ai * ai, ni = 2.f * ar * ai; ar = nr; ai = ni; }
        __syncthreads();
        xr = 0.f; xi = 0.f;
        for (int s2 = 0; s2 < seg; ++s2) { const float2 l = L[s2 * 64 + pp]; const float nr = ar * xr - ai * xi + l.x, ni = ar * xi + ai * xr + l.y; xr = nr; xi = ni; }
#pragma unroll
        for (int i = 0; i < 16; ++i) {
            size_t o = ((size_t)(b * 128 + seg * 16 + i) * 32 + g) * 128 + pp;
            xcar[o] = f2bf(xr); xcar[o + 64] = f2bf(xi);
            const float nr = a64.x * xr - a64.y * xi + erv[i], ni = a64.x * xi + a64.y * xr + eiv[i]; xr = nr; xi = ni;
        }
        __syncthreads();
    }
}
struct EpiQK {
    bf16_t *q, *k, *kT;
    DI void operator()(const f32x4 (&acc)[2][2][4][2], const pg8::Unit& u, int wr, int wc, int fr, int fq) const {
        const int h = u.pn;
        const int d = wc * 32 + 8 * fq;
        const int t0 = u.pm * 256 + wr * 64 + fr;
        const int b = t0 >> 13, bh = b * 4 + h, s0 = t0 & 8191;
        bf16_t* qp = q + ((size_t)bh * 8192 + s0) * 128 + d;
#pragma unroll
        for (int ai = 0; ai < 2; ++ai)
#pragma unroll
            for (int m = 0; m < 4; ++m) {
                f32x4 q0 = acc[ai][0][m][0] * 0.08838834764831845f, q1 = acc[ai][0][m][1] * 0.08838834764831845f;
                *(uint4*)(qp + (size_t)(ai * 128 + m * 16) * 128) = pk8(q0, q1);
            }
        bf16_t* kp = k + ((size_t)bh * 8192 + s0) * 128 + d;
#pragma unroll
        for (int ai = 0; ai < 2; ++ai)
#pragma unroll
            for (int m = 0; m < 4; ++m) *(uint4*)(kp + (size_t)(ai * 128 + m * 16) * 128) = pk8(acc[ai][1][m][0], acc[ai][1][m][1]);
        bf16_t* tp0 = kT + (((size_t)bh * 128 + (s0 >> 6)) * 128 + d) * 64 + (s0 & 63);
#pragma unroll
        for (int ai = 0; ai < 2; ++ai)
#pragma unroll
            for (int m = 0; m < 4; ++m) {
                bf16_t* tp = tp0 + (size_t)(ai * 2 + (m >> 2)) * 0 + ((ai * 128 + m * 16) >> 6) * (128 * 64) + ((ai * 128 + m * 16) & 63);
                asm volatile("" : "+v"(tp));
#pragma unroll
                for (int r = 0; r < 4; ++r) { *tp = f2bf(acc[ai][1][m][0][r]); tp += 64; asm volatile("" : "+v"(tp)); }
#pragma unroll
                for (int r = 0; r < 4; ++r) { *tp = f2bf(acc[ai][1][m][1][r]); tp += 64; asm volatile("" : "+v"(tp)); }
            }
    }
};

DI void mlstm_u_unit(const Params& p, unsigned char* smem, const int tid, int u) {
    unsigned char* ws = p.ws;
    const int lane = tid & 63, w = tid >> 6;
    const int bh = u >> 7, c = u & 127, b = bh >> 2, h = bh & 3;
    float* wk = (float*)smem;
    const bf16_t* kT = (const bf16_t*)(ws + 7 * U_ + U_ / 2);
    const bf16_t* vT = (const bf16_t*)(ws + 3 * U_);
    bf16_t* UT = (bf16_t*)(ws + 1 * U_);
    bf16x8 vfr[2][8][2];
#pragma unroll
    for (int nh = 0; nh < 2; ++nh)
#pragma unroll
        for (int ni = 0; ni < 8; ++ni) {
            const bf16_t* vr = vT + (((size_t)bh * 128 + c) * 256 + nh * 128 + ni * 16 + (lane & 15)) * 64 + (lane >> 4) * 8;
            vfr[nh][ni][0] = ld16(vr); vfr[nh][ni][1] = ld16(vr + 32);
        }
    if (tid < 64) {
        const size_t o = (size_t)bh * 8192 + c * 64 + tid;
        float bl = ((const float*)(ws + OFF_BLAST))[u];
        float mn = ((const float*)(ws + OFF_MST))[bh * 132 + c + 1];
        wk[tid] = __expf(bl - ((const float*)(ws + OFF_BCUM))[o] + ((const float*)(ws + OFF_IG))[o] - mn);
    }
    __syncthreads();
    {
        const int d = tid >> 1, hf = tid & 1;
        const bf16_t* kr = kT + (((size_t)bh * 128 + c) * 128 + d) * 64 + hf * 32;
        float s = 0.f;
#pragma unroll
        for (int i = 0; i < 4; ++i) {
            uint4 a = *(const uint4*)(kr + i * 8);
            const unsigned* pa = (const unsigned*)&a;
#pragma unroll
            for (int e = 0; e < 4; ++e) { s += bf2f(pa[e] & 0xffff) * wk[hf * 32 + i * 8 + 2 * e] + bf2f(pa[e] >> 16) * wk[hf * 32 + i * 8 + 2 * e + 1]; }
        }
        s += __shfl_xor(s, 1, 64);
        if (hf == 0) ((float*)(ws + OFF_NU))[((size_t)bh * 128 + c) * 128 + d] = s;
    }
    bf16x8 af[2][2];
#pragma unroll
    for (int mi = 0; mi < 2; ++mi)
#pragma unroll
        for (int ks = 0; ks < 2; ++ks) {
            const int j0 = ks * 32 + (lane >> 4) * 8;
            uint4 a = *(const uint4*)(kT + (((size_t)bh * 128 + c) * 128 + 32 * w + 16 * mi + (lane & 15)) * 64 + j0);
            const unsigned* pa = (const unsigned*)&a;
            uint4 o;
            unsigned* po = (unsigned*)&o;
#pragma unroll
            for (int e = 0; e < 4; ++e) po[e] = pk2(bf2f(pa[e] & 0xffff) * wk[j0 + 2 * e], bf2f(pa[e] >> 16) * wk[j0 + 2 * e + 1]);
            af[mi][ks] = __builtin_bit_cast(bf16x8, o);
        }
#pragma unroll
    for (int nh = 0; nh < 2; ++nh) {
        f32x4 acc[2][8];
#pragma unroll
        for (int mi = 0; mi < 2; ++mi)
#pragma unroll
            for (int ni = 0; ni < 8; ++ni) acc[mi][ni] = f32x4{0.f, 0.f, 0.f, 0.f};
#pragma unroll
        for (int ni = 0; ni < 8; ++ni)
#pragma unroll
            for (int ks = 0; ks < 2; ++ks)
#pragma unroll
                for (int mi = 0; mi < 2; ++mi) acc[mi][ni] = mfma16(af[mi][ks], vfr[nh][ni][ks], acc[mi][ni]);
#pragma unroll
        for (int mi = 0; mi < 2; ++mi)
#pragma unroll
            for (int ni = 0; ni < 8; ++ni) {
                const int dv = nh * 128 + ni * 16 + (lane & 15), d = 32 * w + 16 * mi + (lane >> 4) * 4;
                *(uint2*)(UT + (((size_t)bh * 128 + c) * 256 + dv) * 128 + d) = pk4(acc[mi][ni]);
            }
    }
    __syncthreads();
}

DI void phase5(const Params& p, unsigned char* smem, const int tid, const int vb, const int nvb) {
    unsigned char* ws = p.ws;
    const bf16_t* us = (const bf16_t*)(ws + 7 * U_);
    const bf16_t* kc = (const bf16_t*)(ws + OFF_KC);
    const bf16_t* cmat = (const bf16_t*)(ws + OFF_CMAT);
    const bf16_t* xcar = (const bf16_t*)((unsigned char*)p.out + (size_t)40 * 1048576);
    bf16_t* ys = (bf16_t*)p.out;
    const float* dsk = p.in[19];
    for (int it = vb; it < 1024; it += nvb) {
        const int g = it >> 5, mt = (it < 512) ? (7 - ((it >> 2) & 7)) : ((it >> 2) & 7), nt = it & 3;
        const int ktz = 128 * (mt + 1);
        const int nk = 2 * (mt + 1) + 2;
        auto la = [=](int r, int kv) -> uint4 {
            const int m = mt * 128 + r;
            if (kv < ktz) {
                const int t = m >> 4, c = m & 15, j = kv >> 4, c0 = kv & 15;
                if (j > t) return make_uint4(0, 0, 0, 0);
                return *(const uint4*)(kc + (((size_t)(g * 64 + (t - j)) * 16 + c) * 16 + c0));
            }
            return *(const uint4*)(cmat + ((size_t)(g * 1024 + m)) * 128 + (kv - ktz));
        };
        auto lb = [=](int r, int kv) -> uint4 {
            const int n = nt * 128 + r;
            if (kv < ktz) return *(const uint4*)(us + ((size_t)(n * 64 + (kv >> 4))) * 512 + g * 16 + (kv & 15));
            return *(const uint4*)(xcar + ((size_t)n * 32 + g) * 128 + (kv - ktz));
        };
        f32x4 acc[4][4];
        gemm_tile(smem, tid, nk, la, lb, acc);
        epi_loop(acc, tid, [&](const int epi_f, const int epi_t, const f32x4 accv) __attribute__((always_inline)) {
            const int m = mt * 128 + epi_f, n = nt * 128 + epi_t;
            const int t = m >> 4, c = m & 15;
            const size_t tok = (size_t)n * 64 + t;
            const int ch = g * 16 + c;
            uint2 uu = *(const uint2*)(us + tok * 512 + ch);
            float4 dd = *(const float4*)(dsk + ch);
            f32x4 v = accv;
            v[0] = gelu_t(v[0] + dd.x * bf2f(uu.x & 0xffff));
            v[1] = gelu_t(v[1] + dd.y * bf2f(uu.x >> 16));
            v[2] = gelu_t(v[2] + dd.z * bf2f(uu.y & 0xffff));
            v[3] = gelu_t(v[3] + dd.w * bf2f(uu.y >> 16));
            *(uint2*)(ys + tok * 512 + ch) = pk4(v);
        });
    }
    for (int u = vb; u < 2048; u += nvb) mlstm_u_unit(p, smem, tid, u);
}

DI void phase6_scan(const Params& p, unsigned char* smem) {
    unsigned char* ws = p.ws;
    const int tid = fresh_tid();
    for (int it = blockIdx.x; it < 256; it += gridDim.x) {
        const int e4 = it * 512 + tid;
        const int bh = e4 >> 13;
        const size_t off = (size_t)(e4 & 8191) * 4;
        bf16_t* base = (bf16_t*)(ws + 1 * U_) + (size_t)bh * 128 * 32768 + off;
        const float* bl = (const float*)(ws + OFF_BLAST) + bh * 128;
        const float* ms = (const float*)(ws + OFF_MST) + bh * 132;
        float C[4] = {0.f, 0.f, 0.f, 0.f};
        uint2 nxt[16];
#pragma unroll
        for (int i = 0; i < 16; ++i) nxt[i] = *(const uint2*)(base + (size_t)i * 32768);
        for (int c8 = 0; c8 < 128; c8 += 16) {
            float decv[16];
#pragma unroll
            for (int i = 0; i < 16; ++i) decv[i] = __expf(bl[c8 + i] + ms[c8 + i] - ms[c8 + i + 1]);
#pragma unroll
            for (int i = 0; i < 16; ++i) {
                const int c = c8 + i;
                uint2 v = nxt[i];
                if (c + 16 < 128) nxt[i] = *(const uint2*)(base + (size_t)(c + 16) * 32768);
                *(uint2*)(base + (size_t)c * 32768) = make_uint2(pk2(C[0], C[1]), pk2(C[2], C[3]));
                const float dec = decv[i];
                C[0] = dec * C[0] + bf2f(v.x & 0xffff); C[1] = dec * C[1] + bf2f(v.x >> 16);
                C[2] = dec * C[2] + bf2f(v.y & 0xffff); C[3] = dec * C[3] + bf2f(v.y >> 16);
            }
        }
    }
    if (blockIdx.x < 32) {
        const int bh = blockIdx.x >> 1, d = (blockIdx.x & 1) * 64 + (tid & 63), seg = tid >> 6;
        float* nb = (float*)(ws + OFF_NU) + (size_t)bh * 128 * 128 + d;
        const float* bl = (const float*)(ws + OFF_BLAST) + bh * 128;
        const float* ms = (const float*)(ws + OFF_MST) + bh * 132;
        float2* L = (float2*)smem;
        float vv[16], dd[16];
#pragma unroll
        for (int i = 0; i < 16; ++i) { const int c = seg * 16 + i; vv[i] = nb[c * 128]; dd[i] = __expf(bl[c] + ms[c] - ms[c + 1]); }
        float n = 0.f, D = 1.f;
#pragma unroll
        for (int i = 0; i < 16; ++i) { n = dd[i] * n + vv[i]; D *= dd[i]; }
        L[seg * 64 + (tid & 63)] = make_float2(n, D);
        __syncthreads();
        n = 0.f;
        for (int s2 = 0; s2 < seg; ++s2) { const float2 l = L[s2 * 64 + (tid & 63)]; n = l.y * n + l.x; }
#pragma unroll
        for (int i = 0; i < 16; ++i) { const int c = seg * 16 + i; nb[c * 128] = n; n = dd[i] * n + vv[i]; }
        __syncthreads();
    }
}
struct EpiGlu {
    bf16_t* yb;
    DI void operator()(const f32x4 (&acc)[2][2][4][2], const pg8::Unit& u, int wr, int wc, int fr, int fq) const {
        pg8::epi8(acc, u, wr, wc, fr, fq, [&](int t, int col8, f32x4 v0, f32x4 v1) __attribute__((always_inline)) {
            f32x4 o;
#pragma unroll
            for (int r = 0; r < 4; ++r) o[r] = v0[r] * sigm(v1[r]);
            *(uint2*)(yb + (size_t)t * 1024 + (col8 >> 1)) = pk4(o);
        });
    }
};

DI void mlstm_out_unit(const Params& p, unsigned char* smem, const int tid, int u) {
    unsigned char* ws = p.ws;
    const int lane = tid & 63, w = tid >> 6;
    const int bh = u >> 7, c = u & 127, b = bh >> 2, h = bh & 3;
    float* gk = (float*)smem;
    float* bq = gk + 64;
    float* sci = bq + 64;
    float* emt = sci + 64;
    float* qn = emt + 64;
    float* rden = qn + 64;
    float* part = rden + 64;
    float* mean_s = part + 256;
    float* rstd_s = mean_s + 64;
    uint4* xs = (uint4*)(smem + 4096);
    const bf16_t* q = (const bf16_t*)((unsigned char*)p.out + U_);
    const bf16_t* k = q + (size_t)16 * 8192 * 128;
    const bf16_t* vT = (const bf16_t*)(ws + 3 * U_);
    const bf16_t* CT = (const bf16_t*)(ws + 1 * U_);
    const bf16_t* og = (const bf16_t*)(ws + 4 * U_);
    bf16_t* hm = (bf16_t*)p.out;
    const float mc = ((const float*)(ws + OFF_MST))[bh * 132 + c];
    const size_t tok0 = (size_t)bh * 8192 + c * 64;
    bf16x8 ctf[4][4];
    {
        const bf16_t* ctb0 = CT + (((size_t)bh * 128 + c) * 256 + 64 * w + (lane & 15)) * 128 + (lane >> 4) * 8;
#pragma unroll
        for (int ks = 0; ks < 4; ++ks)
#pragma unroll
            for (int i = 0; i < 4; ++i) ctf[ks][i] = ld16(ctb0 + (size_t)i * 16 * 128 + ks * 32);
    }
    if (w == 0) {
        float bj = ((const float*)(ws + OFF_BCUM))[tok0 + lane], ij = ((const float*)(ws + OFF_IG))[tok0 + lane];
        float g = ij - bj, pm = g;
        for (int d = 1; d < 64; d <<= 1) { float o = __shfl_up(pm, d, 64); if (lane >= d) pm = fmaxf(pm, o); }
        float mt = bj + fmaxf(mc, pm);
        gk[lane] = g; bq[lane] = bj - mt; sci[lane] = __expf(bj + mc - mt); emt[lane] = __expf(-mt);
    }
    {
        const int t = tid >> 2, p4 = tid & 3;
        const bf16_t* qr = q + (tok0 + t) * 128 + p4 * 32;
        const float* nr = (const float*)(ws + OFF_NU) + ((size_t)bh * 128 + c) * 128 + p4 * 32;
        float s = 0.f;
#pragma unroll
        for (int i = 0; i < 4; ++i) {
            uint4 a = *(const uint4*)(qr + i * 8);
            const unsigned* pa = (const unsigned*)&a;
#pragma unroll
            for (int e = 0; e < 4; ++e) s += bf2f(pa[e] & 0xffff) * nr[i * 8 + 2 * e] + bf2f(pa[e] >> 16) * nr[i * 8 + 2 * e + 1];
        }
        s += __shfl_xor(s, 1, 64); s += __shfl_xor(s, 2, 64);
        if (p4 == 0) qn[t] = s;
    }
    __syncthreads();
    {
        f32x4 X[4];
#pragma unroll
        for (int jt = 0; jt < 4; ++jt) X[jt] = f32x4{0.f, 0.f, 0.f, 0.f};
        const bf16_t* qb = q + (tok0 + 16 * w + (lane & 15)) * 128 + (lane >> 4) * 8;
        bf16x8 qf[4];
#pragma unroll
        for (int ks = 0; ks < 4; ++ks) qf[ks] = ld16(qb + ks * 32);
#pragma unroll
        for (int jt = 0; jt < 4; ++jt) {
            if (jt <= w) {
                const bf16_t* kb = k + (tok0 + 16 * jt + (lane & 15)) * 128 + (lane >> 4) * 8;
#pragma unroll
                for (int ks = 0; ks < 4; ++ks) X[jt] = mfma16(ld16(kb + ks * 32), qf[ks], X[jt]);
            }
        }
        const int t = 16 * w + (lane & 15);
        const float bqt = bq[t];
        float dsum = 0.f;
#pragma unroll
        for (int jt = 0; jt < 4; ++jt)
#pragma unroll
            for (int r = 0; r < 4; ++r) {
                const int j = 16 * jt + (lane >> 4) * 4 + r;
                float v = (j <= t) ? X[jt][r] * __expf(bqt + gk[j]) : 0.f;
                X[jt][r] = v; dsum += v;
            }
        dsum += __shfl_xor(dsum, 16, 64); dsum += __shfl_xor(dsum, 32, 64);
        if (lane < 16) { float den = dsum + sci[t] * qn[t]; rden[t] = 1.f / fmaxf(fabsf(den), emt[t]); }
#pragma unroll
        for (int pr = 0; pr < 2; ++pr) {
            uint2 lo = pk4(X[2 * pr]), hi = pk4(X[2 * pr + 1]);
            xs[(w * 2 + pr) * 64 + lane] = make_uint4(lo.x, lo.y, hi.x, hi.y);
        }
    }
    __syncthreads();
    f32x4 acc[4][4];
#pragma unroll
    for (int i = 0; i < 4; ++i)
#pragma unroll
        for (int j = 0; j < 4; ++j) acc[i][j] = f32x4{0.f, 0.f, 0.f, 0.f};
    {
        const bf16_t* qb = q + (tok0 + (lane & 15)) * 128 + (lane >> 4) * 8;
#pragma unroll
        for (int ks = 0; ks < 4; ++ks) {
            bf16x8 bfr[4];
#pragma unroll
            for (int i = 0; i < 4; ++i) bfr[i] = ld16(qb + (size_t)i * 16 * 128 + ks * 32);
#pragma unroll
            for (int i = 0; i < 4; ++i)
#pragma unroll
                for (int j = 0; j < 4; ++j) acc[i][j] = mfma16(ctf[ks][i], bfr[j], acc[i][j]);
        }
    }
#pragma unroll
    for (int ni = 0; ni < 4; ++ni) {
        const float s = sci[16 * ni + (lane & 15)];
#pragma unroll
        for (int mi = 0; mi < 4; ++mi) { acc[mi][ni][0] *= s; acc[mi][ni][1] *= s; acc[mi][ni][2] *= s; acc[mi][ni][3] *= s; }
    }
    {
        const bf16_t* vb = vT + (((size_t)bh * 128 + c) * 256 + 64 * w + (lane & 15)) * 64 + (lane >> 4) * 4;
#pragma unroll
        for (int pr = 0; pr < 2; ++pr) {
            bf16x8 af[4];
#pragma unroll
            for (int mi = 0; mi < 4; ++mi) {
                uint2 lo = *(const uint2*)(vb + (size_t)mi * 16 * 64 + pr * 32);
                uint2 hi = *(const uint2*)(vb + (size_t)mi * 16 * 64 + pr * 32 + 16);
                af[mi] = __builtin_bit_cast(bf16x8, make_uint4(lo.x, lo.y, hi.x, hi.y));
            }
#pragma unroll
            for (int ni = 0; ni < 4; ++ni) {
                if (ni >= 2 * pr) {
                    bf16x8 xb = __builtin_bit_cast(bf16x8, xs[(ni * 2 + pr) * 64 + lane]);
#pragma unroll
                    for (int mi = 0; mi < 4; ++mi) acc[mi][ni] = mfma16(af[mi], xb, acc[mi][ni]);
                }
            }
        }
    }
#pragma unroll
    for (int ni = 0; ni < 4; ++ni) {
        const float rd = rden[16 * ni + (lane & 15)];
        float s = 0.f;
#pragma unroll
        for (int mi = 0; mi < 4; ++mi) { acc[mi][ni][0] *= rd; acc[mi][ni][1] *= rd; acc[mi][ni][2] *= rd; acc[mi][ni][3] *= rd;
            s += acc[mi][ni][0] + acc[mi][ni][1] + acc[mi][ni][2] + acc[mi][ni][3]; }
        s += __shfl_xor(s, 16, 64); s += __shfl_xor(s, 32, 64);
        if (lane < 16) part[w * 64 + 16 * ni + lane] = s;
    }
    __syncthreads();
    if (tid < 64) mean_s[tid] = (part[tid] + part[64 + tid] + part[128 + tid] + part[192 + tid]) * (1.f / 256.f);
    __syncthreads();
#pragma unroll
    for (int ni = 0; ni < 4; ++ni) {
        const float mu = mean_s[16 * ni + (lane & 15)];
        float s = 0.f;
#pragma unroll
        for (int mi = 0; mi < 4; ++mi)
#pragma unroll
            for (int r = 0; r < 4; ++r) { float d = acc[mi][ni][r] - mu; s += d * d; }
        s += __shfl_xor(s, 16, 64); s += __shfl_xor(s, 32, 64);
        if (lane < 16) part[w * 64 + 16 * ni + lane] = s;
    }
    __syncthreads();
    if (tid < 64) rstd_s[tid] = rsqrtf((part[tid] + part[64 + tid] + part[128 + tid] + part[192 + tid]) * (1.f / 256.f) + 1e-5f);
    __syncthreads();
    const float* gain = p.in[10];
    float4 gg[4];
    unsigned ogv[4][4];
#pragma unroll
    for (int mi = 0; mi < 4; ++mi) gg[mi] = *(const float4*)(gain + h * 256 + 64 * w + 16 * mi + (lane >> 4) * 4);
#pragma unroll
    for (int ni = 0; ni < 4; ++ni)
#pragma unroll
        for (int mi = 0; mi < 4; ++mi)
            ogv[ni][mi] = *(const unsigned*)((const unsigned char*)og + ((size_t)b * 8192 + c * 64 + 16 * ni + (lane & 15)) * 1024 + h * 256 + 64 * w + 16 * mi + (lane >> 4) * 4);
#pragma unroll
    for (int ni = 0; ni < 4; ++ni) {
        const int t = 16 * ni + (lane & 15);
        const float mu = mean_s[t], rs = rstd_s[t];
        const size_t tok = (size_t)b * 8192 + c * 64 + t;
#pragma unroll
        for (int mi = 0; mi < 4; ++mi) {
            const int ch = h * 256 + 64 * w + 16 * mi + (lane >> 4) * 4;
            const f32x4 o2 = un4u8(ogv[ni][mi]);
            f32x4 o;
            o[0] = (acc[mi][ni][0] - mu) * rs * gg[mi].x * o2[0];
            o[1] = (acc[mi][ni][1] - mu) * rs * gg[mi].y * o2[1];
            o[2] = (acc[mi][ni][2] - mu) * rs * gg[mi].z * o2[2];
            o[3] = (acc[mi][ni][3] - mu) * rs * gg[mi].w * o2[3];
            *(uint2*)(hm + tok * 1024 + ch) = pk4(o);
        }
    }
    __syncthreads();
}

struct EpiDown {
    const unsigned char *sga, *sgb; const bf16_t* yb; bf16_t* ymix;
    DI void operator()(const f32x4 (&acc)[2][2][4][2], const pg8::Unit& u, int wr, int wc, int fr, int fq) const {
        const size_t o0 = (size_t)(u.pm * 256 + wr * 64 + fr) * 1024 + u.pn * 256 + wc * 32 + 8 * fq;
#define TOFF(i) (o0 + (size_t)(TILE_AI(i) * 128 + TILE_M(i) * 16) * 1024 + TILE_BJ(i) * 128)
        uint2 A[2], B[2]; uint4 Y[2];
        A[0] = *(const uint2*)(sga + TOFF(0)); B[0] = *(const uint2*)(sgb + TOFF(0)); Y[0] = *(const uint4*)(yb + TOFF(0));
#pragma unroll
        for (int i = 0; i < 16; ++i) {
            if (i + 1 < 16) { A[(i + 1) & 1] = *(const uint2*)(sga + TOFF(i + 1)); B[(i + 1) & 1] = *(const uint2*)(sgb + TOFF(i + 1)); Y[(i + 1) & 1] = *(const uint4*)(yb + TOFF(i + 1)); }
            const uint4 y = Y[i & 1];
            const f32x4 a0 = un4u8(A[i & 1].x), a1 = un4u8(A[i & 1].y), b0 = un4u8(B[i & 1].x), b1 = un4u8(B[i & 1].y);
            const f32x4 v0 = acc[TILE_AI(i)][TILE_BJ(i)][TILE_M(i)][0], v1 = acc[TILE_AI(i)][TILE_BJ(i)][TILE_M(i)][1];
            f32x4 r0, r1;
            r0[0] = a0[0] * v0[0] + b0[0] * bf2f(y.x & 0xffff);
            r0[1] = a0[1] * v0[1] + b0[1] * bf2f(y.x >> 16);
            r0[2] = a0[2] * v0[2] + b0[2] * bf2f(y.y & 0xffff);
            r0[3] = a0[3] * v0[3] + b0[3] * bf2f(y.y >> 16);
            r1[0] = a1[0] * v1[0] + b1[0] * bf2f(y.z & 0xffff);
            r1[1] = a1[1] * v1[1] + b1[1] * bf2f(y.z >> 16);
            r1[2] = a1[2] * v1[2] + b1[2] * bf2f(y.w & 0xffff);
            r1[3] = a1[3] * v1[3] + b1[3] * bf2f(y.w >> 16);
            *(uint4*)(ymix + TOFF(i)) = pk8(r0, r1);
        }
    }
};
struct EpiRes {
    const float* res; const float* gmod; bf16_t* dst;
    DI void operator()(const f32x4 (&acc)[2][2][4][2], const pg8::Unit& u, int wr, int wc, int fr, int fq) const {
        const int t0 = u.pm * 256 + wr * 64 + fr, colb = u.pn * 256 + wc * 32 + 8 * fq;
        const size_t o0 = (size_t)t0 * 1024 + colb;
        f32x4 gg[2][2];
#pragma unroll
        for (int bj = 0; bj < 2; ++bj) { const float* gp = gmod + (t0 >> 13) * 6144 + colb + bj * 128; gg[bj][0] = *(const f32x4*)gp + 1.f; gg[bj][1] = *(const f32x4*)(gp + 4) + 1.f; }
        f32x4 X0[2], X1[2];
        X0[0] = *(const f32x4*)(res + TOFF(0)); X1[0] = *(const f32x4*)(res + TOFF(0) + 4);
#pragma unroll
        for (int i = 0; i < 16; ++i) {
            if (i + 1 < 16) { X0[(i + 1) & 1] = *(const f32x4*)(res + TOFF(i + 1)); X1[(i + 1) & 1] = *(const f32x4*)(res + TOFF(i + 1) + 4); }
            const int bj = TILE_BJ(i);
            const f32x4 r0 = X0[i & 1] * ALPHA_ + gg[bj][0] * acc[TILE_AI(i)][bj][TILE_M(i)][0];
            const f32x4 r1 = X1[i & 1] * ALPHA_ + gg[bj][1] * acc[TILE_AI(i)][bj][TILE_M(i)][1];
            *(uint4*)(dst + TOFF(i)) = pk8(r0, r1);
        }
    }
};

struct EpiRes2 {
    const bf16_t* r1; const float2* stats; const float* lg; const float* lb; const float* gmod; bf16_t* dst;
    DI void operator()(const f32x4 (&acc)[2][2][4][2], const pg8::Unit& u, int wr, int wc, int fr, int fq) const {
        const int t0 = u.pm * 256 + wr * 64 + fr, colb = u.pn * 256 + wc * 32 + 8 * fq;
        const size_t o0 = (size_t)t0 * 1024 + colb;
        f32x4 gg[2][2], la[2][2], lbv[2][2];
#pragma unroll
        for (int bj = 0; bj < 2; ++bj) {
            const float* gp = gmod + (t0 >> 13) * 6144 + colb + bj * 128;
            gg[bj][0] = *(const f32x4*)gp + 1.f; gg[bj][1] = *(const f32x4*)(gp + 4) + 1.f;
            la[bj][0] = *(const f32x4*)(lg + colb + bj * 128) * ALPHA_; la[bj][1] = *(const f32x4*)(lg + colb + bj * 128 + 4) * ALPHA_;
            lbv[bj][0] = *(const f32x4*)(lb + colb + bj * 128) * ALPHA_; lbv[bj][1] = *(const f32x4*)(lb + colb + bj * 128 + 4) * ALPHA_;
        }
        float2 st[8];
#pragma unroll
        for (int j = 0; j < 8; ++j) st[j] = stats[t0 + (j >> 2) * 128 + (j & 3) * 16];
        uint4 XR[2];
        XR[0] = *(const uint4*)(r1 + TOFF(0));
#pragma unroll
        for (int i = 0; i < 16; ++i) {
            if (i + 1 < 16) XR[(i + 1) & 1] = *(const uint4*)(r1 + TOFF(i + 1));
            const int bj = TILE_BJ(i);
            const float2 s2 = st[i >> 1];
            const uint4 xr = XR[i & 1];
            const f32x4 X0 = {bf2f(xr.x & 0xffff), bf2f(xr.x >> 16), bf2f(xr.y & 0xffff), bf2f(xr.y >> 16)};
            const f32x4 X1 = {bf2f(xr.z & 0xffff), bf2f(xr.z >> 16), bf2f(xr.w & 0xffff), bf2f(xr.w >> 16)};
            const f32x4 r0 = ((X0 - s2.x) * s2.y) * la[bj][0] + lbv[bj][0] + gg[bj][0] * acc[TILE_AI(i)][bj][TILE_M(i)][0];
            const f32x4 r1v = ((X1 - s2.x) * s2.y) * la[bj][1] + lbv[bj][1] + gg[bj][1] * acc[TILE_AI(i)][bj][TILE_M(i)][1];
            *(uint4*)(dst + TOFF(i)) = pk8(r0, r1v);
        }
    }
};
#undef TOFF

DI void phase10(const Params& p) {
    unsigned char* ws = p.ws;
    int ft_ = threadIdx.x; asm volatile("" : "+v"(ft_));
    const int lane = ft_ & 63, wid = ft_ >> 6;
    const float* mod = (const float*)(ws + OFF_MOD);
    const bf16_t* r1 = (const bf16_t*)(ws + 2 * U_);
    float2* stats = (float2*)(ws + OFF_STATS);
    bf16_t* h2 = (bf16_t*)(ws + 1 * U_);
    for (int row0 = (blockIdx.x * 8 + wid) * 4; row0 < T_; row0 += gridDim.x * 32) {
        float v[4][16];
#pragma unroll
        for (int rr = 0; rr < 4; ++rr)
#pragma unroll
            for (int i = 0; i < 4; ++i) { uint2 t = *(const uint2*)(r1 + (size_t)(row0 + rr) * 1024 + i * 256 + lane * 4); v[rr][4 * i] = bf2f(t.x & 0xffff); v[rr][4 * i + 1] = bf2f(t.x >> 16); v[rr][4 * i + 2] = bf2f(t.y & 0xffff); v[rr][4 * i + 3] = bf2f(t.y >> 16); }
#pragma unroll
        for (int rr = 0; rr < 4; ++rr) {
            const int row = row0 + rr;
            float mean, rstd; row_stats(v[rr], mean, rstd);
            if (lane == 0) stats[row] = make_float2(mean, rstd);
#pragma unroll
            for (int i = 0; i < 4; ++i) {
                int c = i * 256 + lane * 4;
                float4 g = *(const float4*)(p.in[22] + c), bb = *(const float4*)(p.in[23] + c);
                v[rr][4 * i] = (v[rr][4 * i] - mean) * rstd * g.x + bb.x;
                v[rr][4 * i + 1] = (v[rr][4 * i + 1] - mean) * rstd * g.y + bb.y;
                v[rr][4 * i + 2] = (v[rr][4 * i + 2] - mean) * rstd * g.z + bb.z;
                v[rr][4 * i + 3] = (v[rr][4 * i + 3] - mean) * rstd * g.w + bb.w;
            }
            row_stats(v[rr], mean, rstd);
            const float* mb = mod + (row >> 13) * 6144;
#pragma unroll
            for (int i = 0; i < 4; ++i) {
                int c = i * 256 + lane * 4;
                float4 sh = *(const float4*)(mb + 3072 + c), sc = *(const float4*)(mb + 4096 + c);
                f32x4 o;
                o[0] = (v[rr][4 * i] - mean) * rstd * (1.f + sc.x) + sh.x;
                o[1] = (v[rr][4 * i + 1] - mean) * rstd * (1.f + sc.y) + sh.y;
                o[2] = (v[rr][4 * i + 2] - mean) * rstd * (1.f + sc.z) + sh.z;
                o[3] = (v[rr][4 * i + 3] - mean) * rstd * (1.f + sc.w) + sh.w;
                *(uint2*)(h2 + (size_t)row * 1024 + c) = pk4(o);
            }
        }
    }
}

constexpr size_t HALO_ELEMS = (size_t)512 * 2 * FH;
struct EpiUpF {
    bf16_t* hid; const float* cw; const float* cb; float* glast; float* gfirst; float* vfirst;
    DI void operator()(const f32x4 (&acc)[2][2][4][2], const pg8::Unit& u, int wr, int wc, int fr, int fq) const {
        const int lane = fq * 16 + fr;
        const int src1 = (lane & 48) | ((fr + 15) & 15), src2 = (lane & 48) | ((fr + 14) & 15);
        float4 w0v[2], w1v[2], w2v[2], bbv[2];
#pragma unroll
        for (int bj = 0; bj < 2; ++bj) {
            const int hc = (u.pn * 256 + bj * 128 + wc * 32 + 8 * fq) >> 1;
            w0v[bj] = *(const float4*)(cw + hc); w1v[bj] = *(const float4*)(cw + FH + hc); w2v[bj] = *(const float4*)(cw + 2 * FH + hc); bbv[bj] = *(const float4*)(cb + hc);
        }
#pragma unroll
        for (int bj = 0; bj < 2; ++bj) {
            const int hc = (u.pn * 256 + bj * 128 + wc * 32 + 8 * fq) >> 1;
            const float4 w0 = w0v[bj], w1 = w1v[bj], w2 = w2v[bj], bb = bbv[bj];
#pragma unroll
            for (int ai = 0; ai < 2; ++ai) {
                f32x4 gprev = (f32x4){0.f, 0.f, 0.f, 0.f};
#pragma unroll
                for (int m = 0; m < 4; ++m) {
                    const f32x4 v = acc[ai][bj][m][0], g = acc[ai][bj][m][1];
                    f32x4 p1, p2;
#pragma unroll
                    for (int r = 0; r < 4; ++r) {
                        p1[r] = __builtin_bit_cast(float, __builtin_amdgcn_update_dpp(0, __builtin_bit_cast(int, (fr == 15) ? gprev[r] : g[r]), 0x121, 0xF, 0xF, false));
                        p2[r] = __builtin_bit_cast(float, __builtin_amdgcn_update_dpp(0, __builtin_bit_cast(int, (fr >= 14) ? gprev[r] : g[r]), 0x122, 0xF, 0xF, false));
                    }
                    const int row = u.pm * 256 + ai * 128 + wr * 64 + m * 16 + fr;
                    const int wb = row >> 6;
                    if (m == 0 && fr < 2) {
                        *(f32x4*)(gfirst + ((size_t)wb * 2 + fr) * FH + hc) = g;
                        *(f32x4*)(vfirst + ((size_t)wb * 2 + fr) * FH + hc) = v;
                    } else {
                        f32x4 o;
                        o[0] = gelu_t(bb.x + w0.x * p2[0] + w1.x * p1[0] + w2.x * g[0]) * v[0];
                        o[1] = gelu_t(bb.y + w0.y * p2[1] + w1.y * p1[1] + w2.y * g[1]) * v[1];
                        o[2] = gelu_t(bb.z + w0.z * p2[2] + w1.z * p1[2] + w2.z * g[2]) * v[2];
                        o[3] = gelu_t(bb.w + w0.w * p2[3] + w1.w * p1[3] + w2.w * g[3]) * v[3];
                        *(uint2*)(hid + (size_t)row * FH + hc) = pk4(o);
                    }
                    if (m == 3 && fr >= 14) *(f32x4*)(glast + ((size_t)wb * 2 + (fr - 14)) * FH + hc) = g;
                    gprev = g;
                }
            }
        }
    }
};

DI void phase12(const Params& p) {
    bf16_t* hid = (bf16_t*)(p.ws + 4 * U_);
    const float* glast = p.out;
    const float* gfirst = p.out + HALO_ELEMS;
    const float* vfirst = p.out + 2 * HALO_ELEMS;
    const float* cw = p.in[25];
    const float* cb = p.in[26];
    const int gtid = blockIdx.x * 512 + fresh_tid(), gstr = gridDim.x * 512;
    for (int idx = gtid; idx < 512 * 2 * (FH / 4); idx += gstr) {
        const int cgp = idx % (FH / 4), rr = (idx / (FH / 4)) & 1, wb = idx / (2 * (FH / 4));
        const int hc = cgp * 4;
        const bool seq_start = (wb & 127) == 0;
        const int pb = seq_start ? wb : wb - 1;
        const float pz = seq_start ? 0.f : 1.f;
        float4 la = *(const float4*)(glast + ((size_t)pb * 2 + 0) * FH + hc), lb = *(const float4*)(glast + ((size_t)pb * 2 + 1) * FH + hc);
        la.x *= pz; la.y *= pz; la.z *= pz; la.w *= pz; lb.x *= pz; lb.y *= pz; lb.z *= pz; lb.w *= pz;
        const float4 f0 = *(const float4*)(gfirst + ((size_t)wb * 2 + 0) * FH + hc), f1 = *(const float4*)(gfirst + ((size_t)wb * 2 + 1) * FH + hc);
        float4 gm2, gm1, g0;
        if (rr == 0) { gm2 = la; gm1 = lb; g0 = f0; } else { gm2 = lb; gm1 = f0; g0 = f1; }
        const float4 v = *(const float4*)(vfirst + ((size_t)wb * 2 + rr) * FH + hc);
        const float4 w0 = *(const float4*)(cw + hc), w1 = *(const float4*)(cw + FH + hc), w2 = *(const float4*)(cw + 2 * FH + hc), bb = *(const float4*)(cb + hc);
        f32x4 o;
        o[0] = gelu_t(bb.x + w0.x * gm2.x + w1.x * gm1.x + w2.x * g0.x) * v.x;
        o[1] = gelu_t(bb.y + w0.y * gm2.y + w1.y * gm1.y + w2.y * g0.y) * v.y;
        o[2] = gelu_t(bb.z + w0.z * gm2.z + w1.z * gm1.z + w2.z * g0.z) * v.z;
        o[3] = gelu_t(bb.w + w0.w * gm2.w + w1.w * gm1.w + w2.w * g0.w) * v.w;
        *(uint2*)(hid + ((size_t)wb * 64 + rr) * FH + hc) = pk4(o);
    }
}

DI void phase14(const Params& p) {
    int ft_ = threadIdx.x; asm volatile("" : "+v"(ft_));
    const int lane = ft_ & 63, wid = ft_ >> 6;
    for (int row0 = (blockIdx.x * 8 + wid) * 4; row0 < T_; row0 += gridDim.x * 32) {
        float v[4][16];
#pragma unroll
        for (int rr = 0; rr < 4; ++rr)
#pragma unroll
            for (int i = 0; i < 4; ++i) { uint2 t = *(const uint2*)((const bf16_t*)(p.ws + 1 * U_) + (size_t)(row0 + rr) * 1024 + i * 256 + lane * 4); v[rr][4 * i] = bf2f(t.x & 0xffff); v[rr][4 * i + 1] = bf2f(t.x >> 16); v[rr][4 * i + 2] = bf2f(t.y & 0xffff); v[rr][4 * i + 3] = bf2f(t.y >> 16); }
#pragma unroll
        for (int rr = 0; rr < 4; ++rr) {
            float* xr = p.out + (size_t)(row0 + rr) * 1024;
            float mean, rstd; row_stats(v[rr], mean, rstd);
#pragma unroll
            for (int i = 0; i < 4; ++i) {
                int c = i * 256 + lane * 4;
                float4 g = *(const float4*)(p.in[28] + c), bb = *(const float4*)(p.in[29] + c);
                *(float4*)(xr + c) = make_float4((v[rr][4 * i] - mean) * rstd * g.x + bb.x, (v[rr][4 * i + 1] - mean) * rstd * g.y + bb.y,
                                                 (v[rr][4 * i + 2] - mean) * rstd * g.z + bb.z, (v[rr][4 * i + 3] - mean) * rstd * g.w + bb.w);
            }
        }
    }
}

#define XB_TMO      128
#define XB_XCNT(j)  (256  + 64 * (j))
#define XB_XSUB(j)  (1280 + 64 * (j))
#define XB_XGEN(j)  (2304 + 64 * (j))
#define XB_TOP      3328
#define XB_TOPGEN   3392
#define XB_SPIN_CAP (1u << 22)
DI unsigned xb_ld(unsigned* p)              { return __hip_atomic_load(p, __ATOMIC_RELAXED, __HIP_MEMORY_SCOPE_AGENT); }
DI unsigned xb_add(unsigned* p, unsigned v) { return __hip_atomic_fetch_add(p, v, __ATOMIC_RELAXED, __HIP_MEMORY_SCOPE_AGENT); }
DI unsigned xb_xcc_id() { return (unsigned)__builtin_amdgcn_s_getreg((3 << 11) | 20) & 0xFu; }
#define XB_SPIN(cond, bar) do { unsigned _sp = 0; while (cond) { __builtin_amdgcn_s_sleep(1); \
    if ((++_sp & 255u) == 0u) { if (xb_ld(&(bar)[XB_TMO])) break; if (_sp > XB_SPIN_CAP) { atomicAdd(&(bar)[XB_TMO], 1u); break; } } } } while (0)
DI void xcd_barrier_complete(unsigned* bar, unsigned x, unsigned& nloc, unsigned& nx) {
    const unsigned G = gridDim.x;
    unsigned sum, cnt, mine, sp = 0u;
    for (;;) {
        sum = 0u; cnt = 0u; mine = 0u;
#pragma unroll
        for (unsigned j = 0; j < 16; ++j) { const unsigned c = xb_ld(&bar[XB_XCNT(j)]); sum += c; cnt += (c > 0u) ? 1u : 0u; mine = (j == x) ? c : mine; }
        if (sum == G) break;
        __builtin_amdgcn_s_sleep(1);
        if ((++sp & 255u) == 0u) { if (xb_ld(&bar[XB_TMO])) break; if (sp > XB_SPIN_CAP) { atomicAdd(&bar[XB_TMO], 1u); break; } }
    }
    nloc = mine > 0u ? mine : 1u; nx = cnt > 0u ? cnt : 1u;
}
DI void xcd_barrier(unsigned* bar, volatile __attribute__((address_space(3))) unsigned* st) {
    asm volatile("s_waitcnt vmcnt(0)" ::: "memory");
    __syncthreads();
    if (fresh_tid() == 0) {
        __builtin_amdgcn_s_waitcnt(0);
        const unsigned x = xb_xcc_id();
        unsigned nloc = st[0], nx = st[1];
        if (nloc == 0u) { xcd_barrier_complete(bar, x, nloc, nx); st[0] = nloc; st[1] = nx; }
        const unsigned old = xb_add(&bar[XB_XSUB(x)], 1u);
        const unsigned gen = old / nloc;
        if (old + 1u == (gen + 1u) * nloc) {
            __builtin_amdgcn_fence(__ATOMIC_RELEASE, "agent");
            asm volatile("s_waitcnt vmcnt(0)" ::: "memory");
            const unsigned og = xb_add(&bar[XB_TOP], 1u);
            const unsigned tg = og / nx;
            if (og + 1u == (tg + 1u) * nx) xb_add(&bar[XB_TOPGEN], 1u);
            else XB_SPIN(xb_ld(&bar[XB_TOPGEN]) == tg, bar);
            __builtin_amdgcn_fence(__ATOMIC_ACQUIRE, "agent");
            xb_add(&bar[XB_XGEN(x)], 1u);
            asm volatile("s_waitcnt vmcnt(0)" ::: "memory");
        } else {
            XB_SPIN(xb_ld(&bar[XB_XGEN(x)]) == gen, bar);
            __builtin_amdgcn_fence(__ATOMIC_ACQUIRE, "agent");
            asm volatile("s_waitcnt vmcnt(0)" ::: "memory");
        }
    }
    __syncthreads();
}

constexpr int LDS_BYTES = 131072;
__global__ void __launch_bounds__(512, 2) fwd_megakernel(Params p) {
    extern __shared__ __attribute__((aligned(16))) unsigned char lds[];
    cg::grid_group grid = cg::this_grid();
    unsigned* bar = (unsigned*)(p.ws + OFF_BAR);
    __shared__ __attribute__((aligned(16))) unsigned xb_st[4];
    volatile __attribute__((address_space(3))) unsigned* st = (volatile __attribute__((address_space(3))) unsigned*)xb_st;
    if (threadIdx.x < 4) xb_st[threadIdx.x] = 0u;
    __syncthreads();
    if (threadIdx.x == 0) (void)xb_add(&bar[XB_XCNT(xb_xcc_id())], 1u);
#define GSYNC() xcd_barrier(bar, st)
#define HALF_CTX int ft_ = threadIdx.x; asm volatile("" : "+v"(ft_)); const int half = ft_ >> 8, vtid = ft_ & 255; \
    const int vb = blockIdx.x * 2 + half, nvb = gridDim.x * 2; unsigned char* hsm = lds + half * 65536;
    PG8_LAS unsigned char* glds = (PG8_LAS unsigned char*)lds;
    unsigned char* ws = p.ws;
    pg8::StaticOrder S;
    if (p.out == nullptr) grid.sync();
    { HALF_CTX phase0(p, hsm, vtid, vb, nvb); }
    GSYNC();
    phase1(p, lds);
    GSYNC();
    {
        pg8::Gemm g{(const bf16_t*)(ws + 1 * U_), (const bf16_t*)(ws + OFF_WIN), 1024, 1024, 1024, 0};
        S.init(T_, 4608, gridDim.x, blockIdx.x);
        EpiIn E{p.in[5], (bf16_t*)(ws + 2 * U_), (bf16_t*)(ws + 3 * U_), (bf16_t*)(ws + 4 * U_), (bf16_t*)(ws + 5 * U_), (bf16_t*)(ws + 6 * U_), (bf16_t*)(ws + 7 * U_)};
        pg8::gemm_phase(glds, g, S, E);
    }
    GSYNC();
    { HALF_CTX phase3(p, hsm, vtid, vb, nvb); }
    GSYNC();
    phase4_small(p, lds);
    {
        bf16_t* q = (bf16_t*)((unsigned char*)p.out + U_);
        pg8::Gemm g{(const bf16_t*)(ws + 1 * U_), (const bf16_t*)(ws + OFF_WQK), 1024, 256, 256, 512};
        S.init(T_, 1024, gridDim.x, blockIdx.x);
        EpiQK E{q, q + (size_t)16 * 8192 * 128, (bf16_t*)(ws + 7 * U_ + U_ / 2)};
        pg8::gemm_phase(glds, g, S, E);
    }
    GSYNC();
    { HALF_CTX phase5(p, hsm, vtid, vb, nvb); }
    GSYNC();
    phase6_scan(p, lds);
    {
        pg8::Gemm g{(const bf16_t*)p.out, (const bf16_t*)(ws + OFF_WGL), 512, 512, 512, 0};
        S.init(T_, 2048, gridDim.x, blockIdx.x);
        EpiGlu E{(bf16_t*)(ws + 7 * U_)};
        pg8::gemm_phase(glds, g, S, E);
    }
    GSYNC();
    { HALF_CTX for (int u = vb; u < 2048; u += nvb) mlstm_out_unit(p, hsm, vtid, u); }
    GSYNC();
    {
        pg8::Gemm g{(const bf16_t*)p.out, (const bf16_t*)(ws + OFF_WDN), 1024, 1024, 1024, 0};
        S.init(T_, 1024, gridDim.x, blockIdx.x);
        EpiDown E{(const unsigned char*)(ws + 5 * U_), (const unsigned char*)(ws + 6 * U_), (const bf16_t*)(ws + 7 * U_), (bf16_t*)(ws + 1 * U_)};
        pg8::gemm_phase(glds, g, S, E);
    }
    GSYNC();
    {
        pg8::Gemm g{(const bf16_t*)(ws + 1 * U_), (const bf16_t*)(ws + OFF_WMX), 1024, 1024, 1024, 0};
        S.init(T_, 1024, gridDim.x, blockIdx.x);
        EpiRes E{p.in[0], (const float*)(ws + OFF_MOD) + 2048, (bf16_t*)(ws + 2 * U_)};
        pg8::gemm_phase(glds, g, S, E);
    }
    GSYNC();
    phase10(p);
    GSYNC();
    {
        pg8::Gemm g{(const bf16_t*)(ws + 1 * U_), (const bf16_t*)(ws + OFF_WUP), 1024, 1024, 1024, 0};
        S.init(T_, 5632, gridDim.x, blockIdx.x);
        EpiUpF E{(bf16_t*)(ws + 4 * U_), p.in[25], p.in[26], p.out, p.out + HALO_ELEMS, p.out + 2 * HALO_ELEMS};
        pg8::gemm_phase(glds, g, S, E);
    }
    GSYNC();
    phase12(p);
    GSYNC();
    {
        pg8::Gemm g{(const bf16_t*)(ws + 4 * U_), (const bf16_t*)(ws + OFF_WFD), FH, FH, FH, 0};
        S.init(T_, 1024, gridDim.x, blockIdx.x);
        EpiRes2 E{(const bf16_t*)(ws + 2 * U_), (const float2*)(ws + OFF_STATS), p.in[22], p.in[23], (const float*)(ws + OFF_MOD) + 5120, (bf16_t*)(ws + 1 * U_)};
        pg8::gemm_phase(glds, g, S, E);
    }
    GSYNC();
    phase14(p);
}

extern "C" void kernel_launch(void* const* d_in, const int* in_sizes, int n_in, void* d_out, int out_size, void* d_ws, size_t ws_size, hipStream_t stream) {
    static int grid_blocks = 0;
    if (grid_blocks == 0) {
        if (n_in != 30 || out_size != T_ * 1024 || ws_size < 8 * U_) { fprintf(stderr, "kernel_launch: unexpected shapes (n_in %d out %d ws %zu)\n", n_in, out_size, ws_size); grid_blocks = -1; return; }
        int dev = 0, cus = 0, per_cu = 0;
        (void)hipGetDevice(&dev);
        (void)hipDeviceGetAttribute(&cus, hipDeviceAttributeMultiprocessorCount, dev);
        if (hipFuncSetAttribute((const void*)fwd_megakernel, hipFuncAttributeMaxDynamicSharedMemorySize, LDS_BYTES) != hipSuccess) { fprintf(stderr, "hipFuncSetAttribute failed\n"); grid_blocks = -1; return; }
        (void)hipOccupancyMaxActiveBlocksPerMultiprocessor(&per_cu, fwd_megakernel, 512, LDS_BYTES);
        if (per_cu < 1) { fprintf(stderr, "occupancy query says 0 blocks/CU\n"); per_cu = 1; }
        grid_blocks = cus;
    }
    if (grid_blocks < 0) return;
    Params p{};
    for (int i = 0; i < 30; ++i) p.in[i] = (const float*)d_in[i];
    p.out = (float*)d_out;
    p.ws = (unsigned char*)d_ws;
    if (hipMemsetAsync((unsigned char*)d_ws + OFF_BAR, 0, 16384, stream) != hipSuccess) { fprintf(stderr, "memset failed\n"); return; }
    void* args[] = {&p};
    hipError_t e = hipLaunchCooperativeKernel((const void*)fwd_megakernel, dim3(grid_blocks), dim3(512), args, LDS_BYTES, stream);
    if (e != hipSuccess) fprintf(stderr, "cooperative launch failed: %s (grid %d)\n", hipGetErrorString(e), grid_blocks);
}
```

```cpp
#include <hip/hip_runtime.h>
#include <hip/hip_cooperative_groups.h>
#include <cstdio>
#include <cstdint>
namespace cg = cooperative_groups;

#define DI __device__ __forceinline__
typedef unsigned short bf16_t;
typedef short bf16x8 __attribute__((ext_vector_type(8)));
typedef float f32x4 __attribute__((ext_vector_type(4)));

constexpr int T_ = 32768, S_ = 8192, FH = 2816;
constexpr size_t U_ = 67108864;
constexpr float ALPHA_ = 1.189207115002721f;

constexpr size_t OFF_WIN = 0;
constexpr size_t OFF_WQK = OFF_WIN + 9437184;
constexpr size_t OFF_WDN = OFF_WQK + 524288;
constexpr size_t OFF_WGL = OFF_WDN + 2097152;
constexpr size_t OFF_WMX = OFF_WGL + 2097152;
constexpr size_t OFF_WUP = OFF_WMX + 2097152;
constexpr size_t OFF_WFD = OFF_WUP + 11534336;
constexpr size_t OFF_MOD = OFF_WFD + 5767168;
constexpr size_t OFF_APOW = OFF_MOD + 98304;
constexpr size_t OFF_BBAR = OFF_APOW + 1064960;
constexpr size_t OFF_KC = OFF_BBAR + 262144;
constexpr size_t OFF_EMAT = OFF_KC + 1048576;
constexpr size_t OFF_CMAT = OFF_EMAT + 8388608;
constexpr size_t OFF_IG = OFF_CMAT + 8388608;
constexpr size_t OFF_LOGF = OFF_IG + 524288;
constexpr size_t OFF_BCUM = OFF_LOGF + 524288;
constexpr size_t OFF_AARR = OFF_BCUM + 524288;
constexpr size_t OFF_BLAST = OFF_AARR + 8192;
constexpr size_t OFF_MST = OFF_BLAST + 8192;
constexpr size_t OFF_NU = OFF_MST + 8448;
constexpr size_t OFF_BAR = OFF_NU + 1048576;
constexpr size_t OFF_STATS = OFF_BAR + 16384;
constexpr size_t OFF_END = OFF_STATS + 262144;
static_assert(OFF_END <= U_, "R0 overflow");

struct Params { const float* in[30]; float* out; unsigned char* ws; };

DI float bf2f(unsigned short h) { return __uint_as_float(((unsigned)h) << 16); }
typedef __bf16 bf16x2_t __attribute__((ext_vector_type(2)));
typedef float f32x2_t __attribute__((ext_vector_type(2)));
DI unsigned pk2(float lo, float hi) { f32x2_t v = {lo, hi}; bf16x2_t b = __builtin_convertvector(v, bf16x2_t); return __builtin_bit_cast(unsigned, b); }
DI unsigned short f2bf(float x) { return (unsigned short)(pk2(x, 0.f) & 0xffffu); }
DI uint2 pk4(f32x4 v) { return make_uint2(pk2(v[0], v[1]), pk2(v[2], v[3])); }
DI float sigm(float x) { return __builtin_amdgcn_rcpf(1.f + __expf(-x)); }
DI float gelu_t(float x) { float u = 1.5957691216057308f * (x + 0.044715f * x * x * x); return x * __builtin_amdgcn_rcpf(1.f + __expf(-u)); }
DI float logsig(float x) { return (x < 0.f) ? (x - log1pf(__expf(x))) : (-log1pf(__expf(-x))); }
DI bf16x8 ld16(const bf16_t* p) { return *reinterpret_cast<const bf16x8*>(p); }
DI f32x4 mfma16(bf16x8 a, bf16x8 b, f32x4 c) { return __builtin_amdgcn_mfma_f32_16x16x32_bf16(a, b, c, 0, 0, 0); }
DI int fresh_tid() { int t = threadIdx.x; asm volatile("" : "+v"(t)); return t; }
DI float dpp_f(float v, const int ctrl_sel) {
    int x = __builtin_bit_cast(int, v), r;
    if (ctrl_sel == 0) r = __builtin_amdgcn_update_dpp(0, x, 0xB1, 0xF, 0xF, false);
    else if (ctrl_sel == 1) r = __builtin_amdgcn_update_dpp(0, x, 0x4E, 0xF, 0xF, false);
    else if (ctrl_sel == 2) r = __builtin_amdgcn_update_dpp(0, x, 0x141, 0xF, 0xF, false);
    else r = __builtin_amdgcn_update_dpp(0, x, 0x140, 0xF, 0xF, false);
    return __builtin_bit_cast(float, r);
}
DI float wsum(float v) {
    v += dpp_f(v, 0); v += dpp_f(v, 1); v += dpp_f(v, 2); v += dpp_f(v, 3);
    const int x = __builtin_bit_cast(int, v);
    return __builtin_bit_cast(float, __builtin_amdgcn_readlane(x, 0)) + __builtin_bit_cast(float, __builtin_amdgcn_readlane(x, 16))
         + __builtin_bit_cast(float, __builtin_amdgcn_readlane(x, 32)) + __builtin_bit_cast(float, __builtin_amdgcn_readlane(x, 48));
}

template <class LA, class LB>
DI void gemm_tile(unsigned char* smem, const int tid, int nk, LA la, LB lb, f32x4 (&acc)[4][4]) {
    const int lane = tid & 63, wid = tid >> 6;
    const int wf = wid >> 1, wt = wid & 1;
    const int lr = tid >> 3, lc = tid & 7;
    unsigned char* sA = smem;
    unsigned char* sB = smem + 32768;
#pragma unroll
    for (int i = 0; i < 4; ++i)
#pragma unroll
        for (int j = 0; j < 4; ++j) acc[i][j] = f32x4{0.f, 0.f, 0.f, 0.f};
    uint4 ra[4], rb[4], na[4], nb[4];
#pragma unroll
    for (int i = 0; i < 4; ++i) { ra[i] = la(lr + 32 * i, lc * 8); rb[i] = lb(lr + 32 * i, lc * 8); }
    if (nk > 1) {
#pragma unroll
        for (int i = 0; i < 4; ++i) { na[i] = la(lr + 32 * i, 64 + lc * 8); nb[i] = lb(lr + 32 * i, 64 + lc * 8); }
    }
    const int woff = lr * 128 + ((lc ^ ((lr >> 1) & 7)) << 4);
#pragma unroll
    for (int i = 0; i < 4; ++i) { *(uint4*)(sA + woff + i * 4096) = ra[i]; *(uint4*)(sB + woff + i * 4096) = rb[i]; }
    __syncthreads();
    const int frow = lane & 15, fq = lane >> 4, fsw = (frow >> 1) & 7;
    for (int kt = 0; kt < nk; ++kt) {
        const int cur = kt & 1;
#pragma unroll
        for (int i = 0; i < 4; ++i) { ra[i] = na[i]; rb[i] = nb[i]; }
        if (kt + 2 < nk) {
#pragma unroll
            for (int i = 0; i < 4; ++i) { na[i] = la(lr + 32 * i, (kt + 2) * 64 + lc * 8); nb[i] = lb(lr + 32 * i, (kt + 2) * 64 + lc * 8); }
        }
        const unsigned char* cA = sA + cur * 16384 + (wf * 64 + frow) * 128;
        const unsigned char* cB = sB + cur * 16384 + (wt * 64 + frow) * 128;
#pragma unroll
        for (int ks = 0; ks < 2; ++ks) {
            const int ch = ((ks * 4 + fq) ^ fsw) << 4;
            bf16x8 af[4], bfr[4];
#pragma unroll
            for (int i = 0; i < 4; ++i) { af[i] = *(const bf16x8*)(cA + i * 2048 + ch); bfr[i] = *(const bf16x8*)(cB + i * 2048 + ch); }
#pragma unroll
            for (int i = 0; i < 4; ++i)
#pragma unroll
                for (int j = 0; j < 4; ++j) acc[i][j] = mfma16(af[i], bfr[j], acc[i][j]);
        }
        if (kt + 1 < nk) {
            const int nbuf = (cur ^ 1) * 16384;
#pragma unroll
            for (int i = 0; i < 4; ++i) { *(uint4*)(sA + nbuf + woff + i * 4096) = ra[i]; *(uint4*)(sB + nbuf + woff + i * 4096) = rb[i]; }
        }
        __syncthreads();
    }
}
template <class F>
DI void epi_loop(f32x4 (&acc)[4][4], const int vtid_, F f) {
    const int lane_ = vtid_ & 63, wid_ = vtid_ >> 6, wf_ = wid_ >> 1, wt_ = wid_ & 1;
#pragma unroll
    for (int fi = 0; fi < 4; ++fi)
#pragma unroll
        for (int ti = 0; ti < 4; ++ti) f(wf_ * 64 + fi * 16 + (lane_ >> 4) * 4, wt_ * 64 + ti * 16 + (lane_ & 15), acc[fi][ti]);
}


namespace pg8 {
#define PG8_LAS __attribute__((address_space(3)))
constexpr int BM = 256, BK = 64, HALF = 128, HTB = HALF * BK * 2, NXCD = 8, WGM = 8;
DI int lds_byte(int r, int c) { const int st = (r >> 4) * 2 + (c >> 5), rr = r & 15, cc = c & 31, ob = rr * 64 + cc * 2; return st * 1024 + (ob ^ (((ob >> 9) & 1) << 5)); }
DI void stage_rc(int b, int& R, int& C) { const int st = b / 1024, sb = b % 1024, swz = sb ^ (((sb >> 9) & 1) << 5); R = (st >> 1) * 16 + swz / 64; C = (st & 1) * 32 + (swz % 64) / 2; }
DI int perm32(int rho) { const int n = rho >> 4, i = rho & 15; return 8 * (i >> 2) + 4 * n + (i & 3); }
struct Unit { int pm, pn; };
struct Gemm { const bf16_t* A; const bf16_t* Bt; int lda, ldb, K, a_pn_off; };
struct StaticOrder {
    int nM, nN, nwg, G, c;
    DI void init(int M, int N, int G_, int c_) { nM = M / BM; nN = N / BM; nwg = nM * nN; G = G_; c = c_; }
    DI bool next(int i, Unit& u) const {
        const long L = (long)i * G + c; if (L >= nwg) return false;
        int wgid = (int)L; { const int q = nwg / NXCD, r = nwg % NXCD, xcd = wgid % NXCD, off = wgid / NXCD; wgid = (xcd < r ? xcd * (q + 1) : r * (q + 1) + (xcd - r) * q) + off; }
        const int nig = WGM * nN, gid = wgid / nig, fm = gid * WGM, gsz = (nM - fm) < WGM ? (nM - fm) : WGM;
        u.pm = fm + ((wgid % nig) % gsz); u.pn = (wgid % nig) / gsz; return true;
    }
};
template <class Epi>
DI void gemm_phase(PG8_LAS unsigned char* lds, const Gemm g, const StaticOrder& S, const Epi& E) {
    int tid = threadIdx.x; asm volatile("" : "+v"(tid));
    const int wid = __builtin_amdgcn_readfirstlane(tid >> 6), lane = tid & 63, wr = wid >> 2, wc = wid & 3, fr = lane & 15, fq = lane >> 4;
    const int nt = g.K / BK;
    unsigned voffA[2], voffB[2];
#pragma unroll
    for (int i = 0; i < 2; ++i) { int R, C; stage_rc(tid * 16 + i * 8192, R, C); const int Rb = (R & ~31) + perm32(R & 31);
        voffA[i] = (unsigned)(R * g.lda + C) * 2u; voffB[i] = (unsigned)(Rb * g.ldb + C) * 2u; }
    const size_t kstep = (size_t)(BK * 2);
    const size_t hstepA = (size_t)HALF * g.lda * 2, hstepB = (size_t)HALF * g.ldb * 2;
    const size_t tstepA = 2 * hstepA, tstepB = 2 * hstepB;
    const unsigned ldsw = (unsigned)wid * 1024u;
    const int aoff = lds_byte(wr * 64 + fr, fq * 8), boff = lds_byte(wc * 32 + fr, fq * 8);
#define PG8_SA(b, h) (((b) * 2 + (h)) * HTB)
#define PG8_SB(b, h) ((4 + (b) * 2 + (h)) * HTB)
#define PG8_STAGE(bufoff, gbase, voff) do { _Pragma("unroll") for (int _i = 0; _i < 2; ++_i) \
        __builtin_amdgcn_global_load_lds((const unsigned*)((const char*)(gbase) + (voff)[_i]), (PG8_LAS unsigned*)(lds + (bufoff) + ldsw + _i * 8192), 16, 0, 0); } while (0)
#define PG8_LDA(dst, b, h) do { _Pragma("unroll") for (int m = 0; m < 4; ++m) _Pragma("unroll") for (int k = 0; k < 2; ++k) dst[m][k] = *(const PG8_LAS bf16x8*)(lds + PG8_SA(b, h) + aoff + m * 2048 + k * 1024); } while (0)
#define PG8_LDB(dst, b, h) do { _Pragma("unroll") for (int n = 0; n < 2; ++n) _Pragma("unroll") for (int k = 0; k < 2; ++k) dst[n][k] = *(const PG8_LAS bf16x8*)(lds + PG8_SB(b, h) + boff + n * 2048 + k * 1024); } while (0)
#define PG8_MMA(ai, bj, At, Bt) do { __builtin_amdgcn_s_setprio(1); _Pragma("unroll") for (int m = 0; m < 4; ++m) _Pragma("unroll") for (int n = 0; n < 2; ++n) _Pragma("unroll") for (int k = 0; k < 2; ++k) \
        acc[ai][bj][m][n] = __builtin_amdgcn_mfma_f32_16x16x32_bf16(Bt[n][k], At[m][k], acc[ai][bj][m][n], 0, 0, 0); __builtin_amdgcn_s_setprio(0); } while (0)
#define PG8_WAIT_V(n) asm volatile("s_waitcnt vmcnt(" #n ")" ::: "memory")
#define PG8_WAIT_L(n) asm volatile("s_waitcnt lgkmcnt(" #n ")" ::: "memory")
#define PG8_BAR __builtin_amdgcn_s_barrier()
#define PG8_SCHED __builtin_amdgcn_sched_barrier(0)
    Unit cur, nxt; int ui = 0;
    if (!S.next(0, cur)) return;
    f32x4 acc[2][2][4][2];
#pragma unroll
    for (int a = 0; a < 2; ++a)
#pragma unroll
        for (int b = 0; b < 2; ++b)
#pragma unroll
            for (int m = 0; m < 4; ++m)
#pragma unroll
                for (int n = 0; n < 2; ++n) acc[a][b][m][n] = (f32x4){0.f, 0.f, 0.f, 0.f};
    bf16x8 At[4][2], B0[2][2], B1[2][2];
    const char* cA = (const char*)g.A + (size_t)cur.pm * tstepA + (size_t)cur.pn * g.a_pn_off; const char* cB = (const char*)g.Bt + (size_t)cur.pn * tstepB;
    PG8_STAGE(PG8_SB(0, 0), cB, voffB); PG8_STAGE(PG8_SB(0, 1), cB + hstepB, voffB); PG8_STAGE(PG8_SA(0, 0), cA, voffA); PG8_STAGE(PG8_SA(0, 1), cA + hstepA, voffA);
    if (wr == 1) PG8_BAR;
    PG8_WAIT_V(2); PG8_BAR;
    PG8_STAGE(PG8_SB(1, 0), cB + kstep, voffB); PG8_STAGE(PG8_SA(1, 0), cA + kstep, voffA); PG8_STAGE(PG8_SB(1, 1), cB + hstepB + kstep, voffB);
    PG8_WAIT_V(6); PG8_BAR;
    for (;;) {
        const bool has_next = S.next(ui + 1, nxt);
        const char* nA = has_next ? (const char*)g.A + (size_t)nxt.pm * tstepA + (size_t)nxt.pn * g.a_pn_off : cA; const char* nB = has_next ? (const char*)g.Bt + (size_t)nxt.pn * tstepB : cB;
        for (int t = 0; t < nt; t += 2) {
            const bool last = (t == nt - 2);
            const char* a1 = cA + (size_t)(t + 1) * kstep;
            const char* a2 = last ? nA : cA + (size_t)(t + 2) * kstep; const char* b2 = last ? nB : cB + (size_t)(t + 2) * kstep;
            const char* a3 = a2 + kstep; const char* b3 = b2 + kstep;
            PG8_LDB(B0, 0, 0); PG8_LDB(B1, 0, 1); PG8_SCHED; PG8_LDA(At, 0, 0); PG8_STAGE(PG8_SA(1, 1), a1 + hstepA, voffA);
            PG8_WAIT_V(8); PG8_WAIT_L(0); PG8_BAR; PG8_MMA(0, 0, At, B0); PG8_MMA(0, 1, At, B1); PG8_BAR; PG8_SCHED;
            PG8_LDA(At, 0, 1); PG8_STAGE(PG8_SB(0, 0), b2, voffB); PG8_STAGE(PG8_SB(0, 1), b2 + hstepB, voffB); PG8_STAGE(PG8_SA(0, 0), a2, voffA);
            PG8_WAIT_V(8); PG8_WAIT_L(0); PG8_BAR; PG8_MMA(1, 0, At, B0); PG8_MMA(1, 1, At, B1); PG8_BAR; PG8_SCHED;
            PG8_LDB(B0, 1, 0); PG8_LDB(B1, 1, 1); PG8_SCHED; PG8_LDA(At, 1, 0); PG8_STAGE(PG8_SA(0, 1), a2 + hstepA, voffA);
            PG8_WAIT_V(8); PG8_WAIT_L(0); PG8_BAR; PG8_MMA(0, 0, At, B0); PG8_MMA(0, 1, At, B1); PG8_BAR; PG8_SCHED;
            PG8_LDA(At, 1, 1); PG8_STAGE(PG8_SB(1, 0), b3, voffB); PG8_STAGE(PG8_SB(1, 1), b3 + hstepB, voffB); PG8_STAGE(PG8_SA(1, 0), a3, voffA);
            PG8_WAIT_V(8); PG8_WAIT_L(0); PG8_BAR; PG8_MMA(1, 0, At, B0); PG8_MMA(1, 1, At, B1); PG8_BAR; PG8_SCHED;
        }
        if (wr == 0) PG8_BAR;
        { int efr = fr, efq = fq; asm volatile("" : "+v"(efr), "+v"(efq)); E(acc, cur, wr, wc, efr, efq); }
        if (!has_next) break;
#pragma unroll
        for (int a = 0; a < 2; ++a)
#pragma unroll
            for (int b = 0; b < 2; ++b)
#pragma unroll
                for (int m = 0; m < 4; ++m)
#pragma unroll
                    for (int n = 0; n < 2; ++n) acc[a][b][m][n] = (f32x4){0.f, 0.f, 0.f, 0.f};
        cur = nxt; cA = nA; cB = nB; ++ui;
        if (wr == 1) PG8_BAR;
    }
    PG8_WAIT_V(0);
    PG8_BAR;
#undef PG8_SA
#undef PG8_SB
#undef PG8_STAGE
#undef PG8_LDA
#undef PG8_LDB
#undef PG8_MMA
#undef PG8_WAIT_V
#undef PG8_WAIT_L
#undef PG8_BAR
#undef PG8_SCHED
}
template <class F>
DI void epi8(const f32x4 (&acc)[2][2][4][2], const Unit& u, int wr, int wc, int fr, int fq, F f) {
#pragma unroll
    for (int ai = 0; ai < 2; ++ai)
#pragma unroll
        for (int m = 0; m < 4; ++m)
#pragma unroll
            for (int bj = 0; bj < 2; ++bj) f(u.pm * 256 + ai * 128 + wr * 64 + m * 16 + fr, u.pn * 256 + bj * 128 + wc * 32 + 8 * fq, acc[ai][bj][m][0], acc[ai][bj][m][1]);
}
}
#define TILE_AI(i) ((i) >> 3)
#define TILE_M(i)  (((i) >> 1) & 3)
#define TILE_BJ(i) ((i) & 1)
DI unsigned pk4u8(f32x4 v) {
    unsigned r = 0;
    r = __builtin_amdgcn_cvt_pk_u8_f32(v[0] * 255.f, 0, r); r = __builtin_amdgcn_cvt_pk_u8_f32(v[1] * 255.f, 1, r);
    r = __builtin_amdgcn_cvt_pk_u8_f32(v[2] * 255.f, 2, r); r = __builtin_amdgcn_cvt_pk_u8_f32(v[3] * 255.f, 3, r);
    return r;
}
DI f32x4 un4u8(unsigned w) {
    const float k = 1.f / 255.f;
    return (f32x4){(float)(w & 0xffu) * k, (float)((w >> 8) & 0xffu) * k, (float)((w >> 16) & 0xffu) * k, (float)(w >> 24) * k};
}
DI uint4 pk8(f32x4 a, f32x4 b) { return make_uint4(pk2(a[0], a[1]), pk2(a[2], a[3]), pk2(b[0], b[1]), pk2(b[2], b[3])); }

struct RowMajor {
    const bf16_t* base; int ld;
    DI uint4 operator()(int r, int k) const { return *(const uint4*)(base + (size_t)r * ld + k); }
};

DI void transpose_tile(unsigned char* smem, const int tid, const float* src, int K, int N, bf16_t* dst, int ldd, int permid, int kt, int nt) {
    float (*tile)[65] = (float (*)[65])smem;
    const int k0 = kt * 64, n0 = nt * 64;
    float tv[16];
#pragma unroll
    for (int i = 0; i < 16; ++i) {
        int kk = i * 4 + (tid >> 6), nn = tid & 63;
        tv[i] = (n0 + nn < N) ? src[(size_t)(k0 + kk) * N + n0 + nn] : 0.f;
    }
#pragma unroll
    for (int i = 0; i < 16; ++i) tile[tid & 63][i * 4 + (tid >> 6)] = tv[i];
    __syncthreads();
#pragma unroll 4
    for (int i = 0; i < 16; ++i) {
        int nn = i * 4 + (tid >> 6), kk = tid & 63;
        int n = n0 + nn;
        if (n < N) {
            int row = n;
            if (permid == 1) row = (n < 2048) ? n : ((n >= 2056) ? n - 8 : -1);
            else if (permid == 2) row = (n < 1024) ? ((n >> 2) * 8 + (n & 3)) : (((n - 1024) >> 2) * 8 + 4 + (n & 3));
            else if (permid == 3) row = (n < 2816) ? ((n >> 2) * 8 + (n & 3)) : (((n - 2816) >> 2) * 8 + 4 + (n & 3));
            if (row >= 0) dst[(size_t)row * ldd + k0 + kk] = f2bf(tile[nn][kk]);
        }
    }
    __syncthreads();
}

DI void phase0(const Params& p, unsigned char* smem, const int tid, const int vb, const int nvb) {
    unsigned char* ws = p.ws;
    const int NTR = 4112, NADA = 192, NS5 = 32;
    for (int it0 = vb; it0 < NTR + NADA + NS5; it0 += nvb) {
        const int it = (it0 < NADA + NS5) ? (NTR + it0) : (it0 - NADA - NS5);
        if (it < NTR) {
            int id = it;
            if (id < 1168) { transpose_tile(smem, tid, p.in[4], 1024, 4616, (bf16_t*)(ws + OFF_WIN), 1024, 1, id / 73, id % 73); continue; }
            id -= 1168;
            if (id < 64) {
                int isk = id >> 5, r = id & 31, h = r >> 3, t = r & 7;
                transpose_tile(smem, tid, (isk ? p.in[9] : p.in[8]) + (size_t)h * 256 * 128, 256, 128,
                               (bf16_t*)(ws + OFF_WQK) + (size_t)h * 65536 + (isk ? 128 * 256 : 0), 256, 0, t >> 1, t & 1);
                continue;
            }
            id -= 64;
            if (id < 256) { transpose_tile(smem, tid, p.in[11], 1024, 1024, (bf16_t*)(ws + OFF_WDN), 1024, 0, id >> 4, id & 15); continue; }
            id -= 256;
            if (id < 256) { transpose_tile(smem, tid, p.in[20], 512, 2048, (bf16_t*)(ws + OFF_WGL), 512, 2, id >> 5, id & 31); continue; }
            id -= 256;
            if (id < 256) { transpose_tile(smem, tid, p.in[21], 1024, 1024, (bf16_t*)(ws + OFF_WMX), 1024, 0, id >> 4, id & 15); continue; }
            id -= 256;
            if (id < 1408) { transpose_tile(smem, tid, p.in[24], 1024, 5632, (bf16_t*)(ws + OFF_WUP), 1024, 3, id / 88, id % 88); continue; }
            id -= 1408;
            transpose_tile(smem, tid, p.in[27], 2816, 1024, (bf16_t*)(ws + OFF_WFD), 2816, 0, id >> 4, id & 15);
        } else if (it < NTR + NADA) {
            const int a = it - NTR;
            float* sc = (float*)smem;
            float* red = (float*)(smem + 16384);
            for (int i = tid; i < 4096; i += 256) { float v = p.in[1][i]; sc[i] = v / (1.f + __expf(-v)); }
            __syncthreads();
            const int col = tid & 31, kg = tid >> 5, n0 = a * 32;
            float a0 = 0, a1 = 0, a2 = 0, a3 = 0;
            const float* wp = p.in[2] + (size_t)(kg * 128) * 6144 + n0 + col;
#pragma unroll 16
            for (int k = 0; k < 128; ++k) {
                float w = wp[(size_t)k * 6144];
                int kk = kg * 128 + k;
                a0 += sc[kk] * w; a1 += sc[1024 + kk] * w; a2 += sc[2048 + kk] * w; a3 += sc[3072 + kk] * w;
            }
            red[(kg * 4 + 0) * 32 + col] = a0; red[(kg * 4 + 1) * 32 + col] = a1; red[(kg * 4 + 2) * 32 + col] = a2; red[(kg * 4 + 3) * 32 + col] = a3;
            __syncthreads();
            if (tid < 128) {
                int b = tid >> 5, c2 = tid & 31;
                float sacc = p.in[3][n0 + c2];
                for (int g = 0; g < 8; ++g) sacc += red[(g * 4 + b) * 32 + c2];
                ((float*)(ws + OFF_MOD))[b * 6144 + n0 + c2] = sacc;
            }
            __syncthreads();
        } else {
            const int g = it - NTR - NADA;
            const float dtf = expf(p.in[14][g]);
            const double dt = (double)dtf;
            float2* apow = (float2*)(ws + OFF_APOW);
            for (int idx = tid; idx < 64 * 65; idx += 256) {
                int pp = idx / 65, tau = idx % 65;
                double lr = p.in[12][g * 64 + pp], li = p.in[13][g * 64 + pp];
                double rev = li * dt * (double)tau * 0.15915494309189535;
                rev -= rint(rev);
                float mag = expf((float)(lr * dt * (double)tau));
                apow[(size_t)(g * 64 + pp) * 65 + tau] = make_float2(mag * __builtin_amdgcn_cosf((float)rev), mag * __builtin_amdgcn_sinf((float)rev));
            }
            if (tid < 64) {
                int pp = tid;
                float lr = p.in[12][g * 64 + pp], li = p.in[13][g * 64 + pp];
                float em1 = expm1f(lr * dtf), mag = em1 + 1.f;
                double rev = (double)li * dt * 0.15915494309189535;
                double revh = 0.5 * rev;
                rev -= rint(rev); revh -= rint(revh);
                float sh = __builtin_amdgcn_sinf((float)revh);
                float arm1 = em1 - 2.f * mag * sh * sh;
                float ai = mag * __builtin_amdgcn_sinf((float)rev);
                float den = lr * lr + li * li;
                float zr = (arm1 * lr + ai * li) / den, zi = (ai * lr - arm1 * li) / den;
                float2* bb = (float2*)(ws + OFF_BBAR);
                for (int c2 = 0; c2 < 16; ++c2) {
                    float br = p.in[15][(size_t)(g * 64 + pp) * 16 + c2], bi = p.in[16][(size_t)(g * 64 + pp) * 16 + c2];
                    bb[(size_t)(g * 64 + pp) * 16 + c2] = make_float2(zr * br - zi * bi, zr * bi + zi * br);
                }
            }
            __syncthreads();
            __syncthreads();
        }
    }
}

DI void row_stats(const float (&v)[16], float& mean, float& rstd) {
    float s = 0.f;
#pragma unroll
    for (int i = 0; i < 16; ++i) s += v[i];
    mean = wsum(s) * (1.f / 1024.f);
    float q = 0.f;
#pragma unroll
    for (int i = 0; i < 16; ++i) { float d = v[i] - mean; q += d * d; }
    rstd = rsqrtf(wsum(q) * (1.f / 1024.f) + 1e-5f);
}

DI void phase1(const Params& p, unsigned char* smem) {
    unsigned char* ws = p.ws;
    int ft_ = threadIdx.x; asm volatile("" : "+v"(ft_));
    const int lane = ft_ & 63, wid = ft_ >> 6;
    const float* mod = (const float*)(ws + OFF_MOD);
    bf16_t* h1 = (bf16_t*)(ws + 1 * U_);
    float4 gw0[16], gw1[16];
#pragma unroll
    for (int i = 0; i < 4; ++i)
#pragma unroll
        for (int e = 0; e < 4; ++e) {
            const float* wp = p.in[4] + (size_t)(i * 256 + lane * 4 + e) * 4616 + 2048;
            gw0[i * 4 + e] = *(const float4*)wp; gw1[i * 4 + e] = *(const float4*)(wp + 4);
        }
    float* ig = (float*)(ws + OFF_IG);
    float* lf = (float*)(ws + OFF_LOGF);
    for (int row0 = (blockIdx.x * 8 + wid) * 4; row0 < T_; row0 += gridDim.x * 32) {
        float vv[4][16];
#pragma unroll
        for (int rr = 0; rr < 4; ++rr)
#pragma unroll
            for (int i = 0; i < 4; ++i) { float4 t = *(const float4*)(p.in[0] + (size_t)(row0 + rr) * 1024 + i * 256 + lane * 4); vv[rr][4 * i] = t.x; vv[rr][4 * i + 1] = t.y; vv[rr][4 * i + 2] = t.z; vv[rr][4 * i + 3] = t.w; }
#pragma unroll
        for (int rr = 0; rr < 4; ++rr) {
            const int row = row0 + rr;
            float mean, rstd; row_stats(vv[rr], mean, rstd);
            const float* mb = mod + (row >> 13) * 6144;
            float ga[8];
#pragma unroll
            for (int j = 0; j < 8; ++j) ga[j] = 0.f;
#pragma unroll
            for (int i = 0; i < 4; ++i) {
                int c = i * 256 + lane * 4;
                float4 sh = *(const float4*)(mb + c), sc = *(const float4*)(mb + 1024 + c);
                f32x4 o;
                o[0] = (vv[rr][4 * i] - mean) * rstd * (1.f + sc.x) + sh.x;
                o[1] = (vv[rr][4 * i + 1] - mean) * rstd * (1.f + sc.y) + sh.y;
                o[2] = (vv[rr][4 * i + 2] - mean) * rstd * (1.f + sc.z) + sh.z;
                o[3] = (vv[rr][4 * i + 3] - mean) * rstd * (1.f + sc.w) + sh.w;
                *(uint2*)(h1 + (size_t)row * 1024 + c) = pk4(o);
#pragma unroll
                for (int e = 0; e < 4; ++e) {
                    const float4 w0 = gw0[i * 4 + e], w1 = gw1[i * 4 + e];
                    ga[0] += o[e] * w0.x; ga[1] += o[e] * w0.y; ga[2] += o[e] * w0.z; ga[3] += o[e] * w0.w;
                    ga[4] += o[e] * w1.x; ga[5] += o[e] * w1.y; ga[6] += o[e] * w1.z; ga[7] += o[e] * w1.w;
                }
            }
#pragma unroll
            for (int j = 0; j < 8; ++j) ga[j] = wsum(ga[j]);
            if (lane < 8) {
                float val = ga[0];
#pragma unroll
                for (int j = 1; j < 8; ++j) val = (lane == j) ? ga[j] : val;
                val += p.in[5][2048 + lane];
                const int b = row >> 13, sidx = row & 8191;
                if (lane < 4) ig[(size_t)(b * 4 + lane) * 8192 + sidx] = val;
                else lf[(size_t)(b * 4 + lane - 4) * 8192 + sidx] = logsig(val);
            }
        }
    }
    const float2* apow = (const float2*)(ws + OFF_APOW);
    const float2* bbar = (const float2*)(ws + OFF_BBAR);
    const float* cre = p.in[17];
    const float* cim = p.in[18];
    const int gtid = blockIdx.x * 512 + fresh_tid(), gstr = gridDim.x * 512;
    bf16_t* emat = (bf16_t*)(ws + OFF_EMAT);
    for (int idx = gtid; idx < 32 * 128 * 128; idx += gstr) {
        const int g = idx >> 14, m = (idx >> 7) & 127, k8 = idx & 127;
        const int pp = m & 63, j = k8 >> 1, c20 = (k8 & 1) * 8;
        const float2 a = apow[(size_t)(g * 64 + pp) * 65 + (63 - j)];
        const float4* bp = (const float4*)(bbar + (size_t)(g * 64 + pp) * 16 + c20);
        float o[8];
#pragma unroll
        for (int e = 0; e < 4; ++e) {
            float4 b2 = bp[e];
            o[2 * e] = (m < 64) ? (a.x * b2.x - a.y * b2.y) : (a.x * b2.y + a.y * b2.x);
            o[2 * e + 1] = (m < 64) ? (a.x * b2.z - a.y * b2.w) : (a.x * b2.w + a.y * b2.z);
        }
        *(uint4*)(emat + (size_t)idx * 8) = make_uint4(pk2(o[0], o[1]), pk2(o[2], o[3]), pk2(o[4], o[5]), pk2(o[6], o[7]));
    }
}

struct EpiIn {
    const float* bin; bf16_t *xm, *xmT, *og, *sga, *sgb, *us;
    DI void operator()(const f32x4 (&acc)[2][2][4][2], const pg8::Unit& u, int wr, int wc, int fr, int fq) const {
        const int pn = u.pn;
        int boff, c0, slot;
        if (pn < 4) { boff = 0; c0 = 0; slot = 0; }
        else if (pn < 8) { boff = 1024; c0 = 1024; slot = 0; }
        else if (pn < 10) { boff = 2056; c0 = 2048; slot = 0; }
        else if (pn < 14) { boff = 2568; c0 = 2560; slot = 1; }
        else { boff = 3592; c0 = 3584; slot = 2; }
        const int colb = pn * 256 + wc * 32 + 8 * fq - c0;
        f32x4 bia[2][2];
#pragma unroll
        for (int bj = 0; bj < 2; ++bj) { bia[bj][0] = *(const f32x4*)(bin + boff + colb + bj * 128); bia[bj][1] = *(const f32x4*)(bin + boff + colb + bj * 128 + 4); }
        const int t0 = u.pm * 256 + wr * 64 + fr;
        if (pn < 4) {
#pragma unroll
            for (int i = 0; i < 16; ++i) {
                const int ai = TILE_AI(i), m = TILE_M(i), bj = TILE_BJ(i);
                const int t = t0 + ai * 128 + m * 16, col = colb + bj * 128;
                const f32x4 v0 = acc[ai][bj][m][0] + bia[bj][0], v1 = acc[ai][bj][m][1] + bia[bj][1];
                *(uint4*)(xm + (size_t)t * 1024 + col) = pk8(v0, v1);
                const int b = t >> 13, sidx = t & 8191;
                bf16_t* tp = xmT + ((((size_t)(b * 4 + (col >> 8)) * 128 + (sidx >> 6)) * 256 + (col & 255)) * 64) + (sidx & 63);
#pragma unroll
                for (int r = 0; r < 4; ++r) { *tp = f2bf(v0[r]); tp += 64; asm volatile("" : "+v"(tp)); }
#pragma unroll
                for (int r = 0; r < 4; ++r) { *tp = f2bf(v1[r]); tp += 64; asm volatile("" : "+v"(tp)); }
            }
        } else if (pn == 8 || pn == 9) {
#pragma unroll
            for (int i = 0; i < 16; ++i) {
                const int ai = TILE_AI(i), m = TILE_M(i), bj = TILE_BJ(i);
                const int t = t0 + ai * 128 + m * 16, col = colb + bj * 128;
                *(uint4*)(us + ((((size_t)(col >> 4) * 512 + (t >> 6)) * 64 + (t & 63)) * 16 + (col & 15))) = pk8(acc[ai][bj][m][0] + bia[bj][0], acc[ai][bj][m][1] + bia[bj][1]);
            }
        } else {
            unsigned char* dst = (unsigned char*)og + (size_t)slot * U_;
#pragma unroll
            for (int i = 0; i < 16; ++i) {
                const int ai = TILE_AI(i), m = TILE_M(i), bj = TILE_BJ(i);
                const int t = t0 + ai * 128 + m * 16, col = colb + bj * 128;
                f32x4 v0 = acc[ai][bj][m][0] + bia[bj][0], v1 = acc[ai][bj][m][1] + bia[bj][1];
#pragma unroll
                for (int r = 0; r < 4; ++r) { v0[r] = sigm(v0[r]); v1[r] = sigm(v1[r]); }
                *(uint2*)(dst + (size_t)t * 1024 + col) = make_uint2(pk4u8(v0), pk4u8(v1));
            }
        }
    }
};

DI void s5_tables_late(const Params& p, const int gtid, const int gstr) {
    unsigned char* ws = p.ws;
    const float2* apow = (const float2*)(ws + OFF_APOW);
    const float2* bbar = (const float2*)(ws + OFF_BBAR);
    const float* cre = p.in[17];
    const float* cim = p.in[18];
    bf16_t* kc = (bf16_t*)(ws + OFF_KC);
    for (int idx = gtid; idx < 32 * 64 * 16 * 2; idx += gstr) {
        const int g = idx >> 11, tau = (idx >> 5) & 63, c = (idx >> 1) & 15, c20 = (idx & 1) * 8;
        float sacc[8];
#pragma unroll
        for (int e = 0; e < 8; ++e) sacc[e] = 0.f;
#pragma unroll 4
        for (int pp = 0; pp < 64; ++pp) {
            const float cr = cre[(size_t)(g * 16 + c) * 64 + pp], ci = cim[(size_t)(g * 16 + c) * 64 + pp];
            const float2 a = apow[(size_t)(g * 64 + pp) * 65 + tau];
            const float wr_ = cr * a.x - ci * a.y, wi_ = cr * a.y + ci * a.x;
            const float4* bp = (const float4*)(bbar + (size_t)(g * 64 + pp) * 16 + c20);
#pragma unroll
            for (int e = 0; e < 4; ++e) { float4 b2 = bp[e]; sacc[2 * e] += wr_ * b2.x - wi_ * b2.y; sacc[2 * e + 1] += wr_ * b2.z - wi_ * b2.w; }
        }
        *(uint4*)(kc + (((size_t)(g * 64 + tau) * 16 + c) * 16 + c20)) = make_uint4(pk2(sacc[0], sacc[1]), pk2(sacc[2], sacc[3]), pk2(sacc[4], sacc[5]), pk2(sacc[6], sacc[7]));
    }
    bf16_t* cmat = (bf16_t*)(ws + OFF_CMAT);
    for (int idx = gtid; idx < 32 * 1024 * 16; idx += gstr) {
        const int g = idx >> 14, m = (idx >> 4) & 1023, kk0 = (idx & 15) * 8;
        const int t = m >> 4, c = m & 15, p0 = kk0 & 63;
        const float4* crp = (const float4*)(cre + (size_t)(g * 16 + c) * 64 + p0);
        const float4* cip = (const float4*)(cim + (size_t)(g * 16 + c) * 64 + p0);
        float4 cr0 = crp[0], cr1 = crp[1], ci0 = cip[0], ci1 = cip[1];
        const float crv[8] = {cr0.x, cr0.y, cr0.z, cr0.w, cr1.x, cr1.y, cr1.z, cr1.w};
        const float civ[8] = {ci0.x, ci0.y, ci0.z, ci0.w, ci1.x, ci1.y, ci1.z, ci1.w};
        float o[8];
#pragma unroll
        for (int e = 0; e < 8; ++e) {
            const float2 a = apow[(size_t)(g * 64 + p0 + e) * 65 + t + 1];
            o[e] = (kk0 < 64) ? (crv[e] * a.x - civ[e] * a.y) : -(crv[e] * a.y + civ[e] * a.x);
        }
        *(uint4*)(cmat + (size_t)idx * 8) = make_uint4(pk2(o[0], o[1]), pk2(o[2], o[3]), pk2(o[4], o[5]), pk2(o[6], o[7]));
    }
}

DI void phase3(const Params& p, unsigned char* smem, const int tid, const int vb, const int nvb) {
    unsigned char* ws = p.ws;
    const bf16_t* us = (const bf16_t*)(ws + 7 * U_);
    const bf16_t* emat = (const bf16_t*)(ws + OFF_EMAT);
    float* ebuf = (float*)((unsigned char*)p.out + (size_t)48 * 1048576);
    const bf16_t* xm = (const bf16_t*)(ws + 2 * U_);
    bf16_t* xc = (bf16_t*)(ws + 1 * U_);
    for (int it = vb; it < 256; it += nvb) {
        const int g = it >> 3, nt = (it >> 1) & 3, kh = it & 1;
        f32x4 acc[4][4];
        auto lb = [=](int r, int k) -> uint4 { return *(const uint4*)(us + ((size_t)g * 512 + nt * 128 + r) * 1024 + kh * 512 + k); };
        gemm_tile(smem, tid, 8, RowMajor{emat + (size_t)g * 128 * 1024 + kh * 512, 1024}, lb, acc);
        epi_loop(acc, tid, [&](const int epi_f, const int epi_t, const f32x4 accv) __attribute__((always_inline)) {
            const int f = epi_f, n = nt * 128 + epi_t;
            *(f32x4*)(ebuf + (size_t)kh * 2097152 + ((size_t)n * 32 + g) * 128 + f) = accv;
        });
    }
    if (blockIdx.x >= 128) s5_tables_late(p, (blockIdx.x - 128) * 512 + fresh_tid(), (gridDim.x - 128) * 512);
    for (int i0 = vb; i0 < 512; i0 += nvb) {
        const int cgp = tid & 127, half = tid >> 7;
        const int t0 = i0 * 64 + half * 32, s0 = t0 & 8191;
        const int c0 = cgp * 8;
        float w[4][8], bb[8];
#pragma unroll
        for (int j = 0; j < 4; ++j)
#pragma unroll
            for (int e = 0; e < 8; ++e) w[j][e] = p.in[6][j * 1024 + c0 + e];
#pragma unroll
        for (int e = 0; e < 8; ++e) bb[e] = p.in[7][c0 + e];
        float r0[8], r1[8], r2[8];
#pragma unroll
        for (int e = 0; e < 8; ++e) { r0[e] = 0.f; r1[e] = 0.f; r2[e] = 0.f; }
        if (s0 > 0) {
            uint4 a = *(const uint4*)(xm + (size_t)(t0 - 3) * 1024 + c0), b = *(const uint4*)(xm + (size_t)(t0 - 2) * 1024 + c0), c = *(const uint4*)(xm + (size_t)(t0 - 1) * 1024 + c0);
            const unsigned* pa = (const unsigned*)&a; const unsigned* pb = (const unsigned*)&b; const unsigned* pc = (const unsigned*)&c;
#pragma unroll
            for (int e = 0; e < 4; ++e) {
                r0[2 * e] = bf2f(pa[e] & 0xffff); r0[2 * e + 1] = bf2f(pa[e] >> 16);
                r1[2 * e] = bf2f(pb[e] & 0xffff); r1[2 * e + 1] = bf2f(pb[e] >> 16);
                r2[2 * e] = bf2f(pc[e] & 0xffff); r2[2 * e + 1] = bf2f(pc[e] >> 16);
            }
        }
        for (int tb = 0; tb < 32; tb += 8) {
            uint4 av[8];
#pragma unroll
            for (int i = 0; i < 8; ++i) av[i] = *(const uint4*)(xm + (size_t)(t0 + tb + i) * 1024 + c0);
#pragma unroll
            for (int i = 0; i < 8; ++i) {
                const unsigned* pa = (const unsigned*)&av[i];
                float cur[8], y[8];
#pragma unroll
                for (int e = 0; e < 4; ++e) { cur[2 * e] = bf2f(pa[e] & 0xffff); cur[2 * e + 1] = bf2f(pa[e] >> 16); }
#pragma unroll
                for (int e = 0; e < 8; ++e) {
                    float z = bb[e] + w[0][e] * r0[e] + w[1][e] * r1[e] + w[2][e] * r2[e] + w[3][e] * cur[e];
                    y[e] = z * sigm(z);
                    r0[e] = r1[e]; r1[e] = r2[e]; r2[e] = cur[e];
                }
                *(uint4*)(xc + (size_t)(t0 + tb + i) * 1024 + c0) = make_uint4(pk2(y[0], y[1]), pk2(y[2], y[3]), pk2(y[4], y[5]), pk2(y[6], y[7]));
            }
        }
    }
    for (int u = vb * 4 + (tid >> 6); u < 2048; u += nvb * 4) {
        const int lane = tid & 63;
        const int bh = u >> 7, c = u & 127;
        const size_t o = (size_t)bh * 8192 + c * 64 + lane;
        float b = ((const float*)(ws + OFF_LOGF))[o];
        float ii = ((const float*)(ws + OFF_IG))[o];
        for (int d = 1; d < 64; d <<= 1) { float t = __shfl_up(b, d, 64); if (lane >= d) b += t; }
        float bl = __shfl(b, 63, 64);
        float g = bl - b + ii;
        for (int o2 = 32; o2 > 0; o2 >>= 1) g = fmaxf(g, __shfl_xor(g, o2, 64));
        ((float*)(ws + OFF_BCUM))[o] = b;
        if (lane == 0) { ((float*)(ws + OFF_AARR))[u] = g; ((float*)(ws + OFF_BLAST))[u] = bl; }
    }
}

DI void phase4_small(const Params& p, unsigned char* smem) {
    unsigned char* ws = p.ws;
    const int tid = fresh_tid();
    const int lane = tid & 63, wid = tid >> 6;
    if (blockIdx.x >= gridDim.x - 2) {
        const int bh = (blockIdx.x - (gridDim.x - 2)) * 8 + wid;
        const float* aa = (const float*)(ws + OFF_AARR) + bh * 128;
        const float* bl = (const float*)(ws + OFF_BLAST) + bh * 128;
        float* ms = (float*)(ws + OFF_MST) + bh * 132;
        const float p0 = bl[2 * lane], q0 = aa[2 * lane], p1 = bl[2 * lane + 1], q1 = aa[2 * lane + 1];
        float P = p0 + p1, Q = fmaxf(q0 + p1, q1);
#pragma unroll
        for (int d = 1; d < 64; d <<= 1) {
            const float Pp = __shfl_up(P, d, 64), Qp = __shfl_up(Q, d, 64);
            if (lane >= d) { Q = fmaxf(Qp + P, Q); P = Pp + P; }
        }
        float Pe = __shfl_up(P, 1, 64), Qe = __shfl_up(Q, 1, 64);
        const float m_even = (lane == 0) ? 0.f : fmaxf(Pe, Qe);
        const float m_odd = fmaxf(m_even + p0, q0);
        ms[2 * lane] = m_even; ms[2 * lane + 1] = m_odd;
        if (lane == 63) ms[128] = fmaxf(P, Q);
    }
    if (blockIdx.x < 128) {
        const int b = blockIdx.x >> 5, g = blockIdx.x & 31, pp = lane, seg = wid;
        const float2 a64 = ((const float2*)(ws + OFF_APOW))[(size_t)(g * 64 + pp) * 65 + 64];
        const float* ebuf = (const float*)((unsigned char*)p.out + (size_t)48 * 1048576);
        bf16_t* xcar = (bf16_t*)((unsigned char*)p.out + (size_t)40 * 1048576);
        float2* L = (float2*)smem;
        float erv[16], eiv[16];
#pragma unroll
        for (int i = 0; i < 16; ++i) { size_t o = ((size_t)(b * 128 + seg * 16 + i) * 32 + g) * 128 + pp; erv[i] = ebuf[o] + ebuf[o + 2097152]; eiv[i] = ebuf[o + 64] + ebuf[o + 2097152 + 64]; }
        float xr = 0.f, xi = 0.f;
#pragma unroll
        for (int i = 0; i < 16; ++i) { const float nr = a64.x * xr - a64.y * xi + erv[i], ni = a64.x * xi + a64.y * xr + eiv[i]; xr = nr; xi = ni; }
        L[seg * 64 + pp] = make_float2(xr, xi);
        float ar = a64.x, ai = a64.y;
#pragma unroll
        for (int k = 0; k < 4; ++k) { const float nr = ar * ar - ai * ai, ni = 2.f * ar * ai; ar = nr; ai = ni; }
        __syncthreads();
        xr = 0.f; xi = 0.f;
        for (int s2 = 0; s2 < seg; ++s2) { const float2 l = L[s2 * 64 + pp]; const float nr = ar * xr - ai * xi + l.x, ni = ar * xi + ai * xr + l.y; xr = nr; xi = ni; }
#pragma unroll
        for (int i = 0; i < 16; ++i) {
            size_t o = ((size_t)(b * 128 + seg * 16 + i) * 32 + g) * 128 + pp;
            xcar[o] = f2bf(xr); xcar[o + 64] = f2bf(xi);
            const float nr = a64.x * xr - a64.y * xi + erv[i], ni = a64.x * xi + a64.y * xr + eiv[i]; xr = nr; xi = ni;
        }
        __syncthreads();
    }
}
struct EpiQK {
    bf16_t *q, *k, *kT;
    DI void operator()(const f32x4 (&acc)[2][2][4][2], const pg8::Unit& u, int wr, int wc, int fr, int fq) const {
        const int h = u.pn;
        const int d = wc * 32 + 8 * fq;
        const int t0 = u.pm * 256 + wr * 64 + fr;
        const int b = t0 >> 13, bh = b * 4 + h, s0 = t0 & 8191;
        bf16_t* qp = q + ((size_t)bh * 8192 + s0) * 128 + d;
#pragma unroll
        for (int ai = 0; ai < 2; ++ai)
#pragma unroll
            for (int m = 0; m < 4; ++m) {
                f32x4 q0 = acc[ai][0][m][0] * 0.08838834764831845f, q1 = acc[ai][0][m][1] * 0.08838834764831845f;
                *(uint4*)(qp + (size_t)(ai * 128 + m * 16) * 128) = pk8(q0, q1);
            }
        bf16_t* kp = k + ((size_t)bh * 8192 + s0) * 128 + d;
#pragma unroll
        for (int ai = 0; ai < 2; ++ai)
#pragma unroll
            for (int m = 0; m < 4; ++m) *(uint4*)(kp + (size_t)(ai * 128 + m * 16) * 128) = pk8(acc[ai][1][m][0], acc[ai][1][m][1]);
        bf16_t* tp0 = kT + (((size_t)bh * 128 + (s0 >> 6)) * 128 + d) * 64 + (s0 & 63);
#pragma unroll
        for (int ai = 0; ai < 2; ++ai)
#pragma unroll
            for (int m = 0; m < 4; ++m) {
                bf16_t* tp = tp0 + (size_t)(ai * 2 + (m >> 2)) * 0 + ((ai * 128 + m * 16) >> 6) * (128 * 64) + ((ai * 128 + m * 16) & 63);
                asm volatile("" : "+v"(tp));
#pragma unroll
                for (int r = 0; r < 4; ++r) { *tp = f2bf(acc[ai][1][m][0][r]); tp += 64; asm volatile("" : "+v"(tp)); }
#pragma unroll
                for (int r = 0; r < 4; ++r) { *tp = f2bf(acc[ai][1][m][1][r]); tp += 64; asm volatile("" : "+v"(tp)); }
            }
    }
};

DI void mlstm_u_unit(const Params& p, unsigned char* smem, const int tid, int u) {
    unsigned char* ws = p.ws;
    const int lane = tid & 63, w = tid >> 6;
    const int bh = u >> 7, c = u & 127, b = bh >> 2, h = bh & 3;
    float* wk = (float*)smem;
    const bf16_t* kT = (const bf16_t*)(ws + 7 * U_ + U_ / 2);
    const bf16_t* vT = (const bf16_t*)(ws + 3 * U_);
    bf16_t* UT = (bf16_t*)(ws + 1 * U_);
    bf16x8 vfr[2][8][2];
#pragma unroll
    for (int nh = 0; nh < 2; ++nh)
#pragma unroll
        for (int ni = 0; ni < 8; ++ni) {
            const bf16_t* vr = vT + (((size_t)bh * 128 + c) * 256 + nh * 128 + ni * 16 + (lane & 15)) * 64 + (lane >> 4) * 8;
            vfr[nh][ni][0] = ld16(vr); vfr[nh][ni][1] = ld16(vr + 32);
        }
    if (tid < 64) {
        const size_t o = (size_t)bh * 8192 + c * 64 + tid;
        float bl = ((const float*)(ws + OFF_BLAST))[u];
        float mn = ((const float*)(ws + OFF_MST))[bh * 132 + c + 1];
        wk[tid] = __expf(bl - ((const float*)(ws + OFF_BCUM))[o] + ((const float*)(ws + OFF_IG))[o] - mn);
    }
    __syncthreads();
    {
        const int d = tid >> 1, hf = tid & 1;
        const bf16_t* kr = kT + (((size_t)bh * 128 + c) * 128 + d) * 64 + hf * 32;
        float s = 0.f;
#pragma unroll
        for (int i = 0; i < 4; ++i) {
            uint4 a = *(const uint4*)(kr + i * 8);
            const unsigned* pa = (const unsigned*)&a;
#pragma unroll
            for (int e = 0; e < 4; ++e) { s += bf2f(pa[e] & 0xffff) * wk[hf * 32 + i * 8 + 2 * e] + bf2f(pa[e] >> 16) * wk[hf * 32 + i * 8 + 2 * e + 1]; }
        }
        s += __shfl_xor(s, 1, 64);
        if (hf == 0) ((float*)(ws + OFF_NU))[((size_t)bh * 128 + c) * 128 + d] = s;
    }
    bf16x8 af[2][2];
#pragma unroll
    for (int mi = 0; mi < 2; ++mi)
#pragma unroll
        for (int ks = 0; ks < 2; ++ks) {
            const int j0 = ks * 32 + (lane >> 4) * 8;
            uint4 a = *(const uint4*)(kT + (((size_t)bh * 128 + c) * 128 + 32 * w + 16 * mi + (lane & 15)) * 64 + j0);
            const unsigned* pa = (const unsigned*)&a;
            uint4 o;
            unsigned* po = (unsigned*)&o;
#pragma unroll
            for (int e = 0; e < 4; ++e) po[e] = pk2(bf2f(pa[e] & 0xffff) * wk[j0 + 2 * e], bf2f(pa[e] >> 16) * wk[j0 + 2 * e + 1]);
            af[mi][ks] = __builtin_bit_cast(bf16x8, o);
        }
#pragma unroll
    for (int nh = 0; nh < 2; ++nh) {
        f32x4 acc[2][8];
#pragma unroll
        for (int mi = 0; mi < 2; ++mi)
#pragma unroll
            for (int ni = 0; ni < 8; ++ni) acc[mi][ni] = f32x4{0.f, 0.f, 0.f, 0.f};
#pragma unroll
        for (int ni = 0; ni < 8; ++ni)
#pragma unroll
            for (int ks = 0; ks < 2; ++ks)
#pragma unroll
                for (int mi = 0; mi < 2; ++mi) acc[mi][ni] = mfma16(af[mi][ks], vfr[nh][ni][ks], acc[mi][ni]);
#pragma unroll
        for (int mi = 0; mi < 2; ++mi)
#pragma unroll
            for (int ni = 0; ni < 8; ++ni) {
                const int dv = nh * 128 + ni * 16 + (lane & 15), d = 32 * w + 16 * mi + (lane >> 4) * 4;
                *(uint2*)(UT + (((size_t)bh * 128 + c) * 256 + dv) * 128 + d) = pk4(acc[mi][ni]);
            }
    }
    __syncthreads();
}

DI void phase5(const Params& p, unsigned char* smem, const int tid, const int vb, const int nvb) {
    unsigned char* ws = p.ws;
    const bf16_t* us = (const bf16_t*)(ws + 7 * U_);
    const bf16_t* kc = (const bf16_t*)(ws + OFF_KC);
    const bf16_t* cmat = (const bf16_t*)(ws + OFF_CMAT);
    const bf16_t* xcar = (const bf16_t*)((unsigned char*)p.out + (size_t)40 * 1048576);
    bf16_t* ys = (bf16_t*)p.out;
    const float* dsk = p.in[19];
    for (int it = vb; it < 1024; it += nvb) {
        const int g = it >> 5, mt = (it < 512) ? (7 - ((it >> 2) & 7)) : ((it >> 2) & 7), nt = it & 3;
        const int ktz = 128 * (mt + 1);
        const int nk = 2 * (mt + 1) + 2;
        auto la = [=](int r, int kv) -> uint4 {
            const int m = mt * 128 + r;
            if (kv < ktz) {
                const int t = m >> 4, c = m & 15, j = kv >> 4, c0 = kv & 15;
                if (j > t) return make_uint4(0, 0, 0, 0);
                return *(const uint4*)(kc + (((size_t)(g * 64 + (t - j)) * 16 + c) * 16 + c0));
            }
            return *(const uint4*)(cmat + ((size_t)(g * 1024 + m)) * 128 + (kv - ktz));
        };
        auto lb = [=](int r, int kv) -> uint4 {
            const int n = nt * 128 + r;
            if (kv < ktz) return *(const uint4*)(us + ((size_t)g * 512 + n) * 1024 + kv);
            return *(const uint4*)(xcar + ((size_t)n * 32 + g) * 128 + (kv - ktz));
        };
        f32x4 acc[4][4];
        gemm_tile(smem, tid, nk, la, lb, acc);
        epi_loop(acc, tid, [&](const int epi_f, const int epi_t, const f32x4 accv) __attribute__((always_inline)) {
            const int m = mt * 128 + epi_f, n = nt * 128 + epi_t;
            const int t = m >> 4, c = m & 15;
            const size_t tok = (size_t)n * 64 + t;
            const int ch = g * 16 + c;
            uint2 uu = *(const uint2*)(us + (((size_t)g * 512 + n) * 64 + t) * 16 + c);
            float4 dd = *(const float4*)(dsk + ch);
            f32x4 v = accv;
            v[0] = gelu_t(v[0] + dd.x * bf2f(uu.x & 0xffff));
            v[1] = gelu_t(v[1] + dd.y * bf2f(uu.x >> 16));
            v[2] = gelu_t(v[2] + dd.z * bf2f(uu.y & 0xffff));
            v[3] = gelu_t(v[3] + dd.w * bf2f(uu.y >> 16));
            *(uint2*)(ys + tok * 512 + ch) = pk4(v);
        });
    }
    for (int u = vb; u < 2048; u += nvb) mlstm_u_unit(p, smem, tid, u);
}

DI void phase6_scan(const Params& p) {
    unsigned char* ws = p.ws;
    const int tid = fresh_tid();
    for (int it = blockIdx.x; it < 256; it += gridDim.x) {
        const int e4 = it * 512 + tid;
        const int bh = e4 >> 13;
        const size_t off = (size_t)(e4 & 8191) * 4;
        bf16_t* base = (bf16_t*)(ws + 1 * U_) + (size_t)bh * 128 * 32768 + off;
        const float* bl = (const float*)(ws + OFF_BLAST) + bh * 128;
        const float* ms = (const float*)(ws + OFF_MST) + bh * 132;
        float C[4] = {0.f, 0.f, 0.f, 0.f};
        uint2 nxt[16];
#pragma unroll
        for (int i = 0; i < 16; ++i) nxt[i] = *(const uint2*)(base + (size_t)i * 32768);
        for (int c8 = 0; c8 < 128; c8 += 16) {
            float decv[16];
#pragma unroll
            for (int i = 0; i < 16; ++i) decv[i] = __expf(bl[c8 + i] + ms[c8 + i] - ms[c8 + i + 1]);
#pragma unroll
            for (int i = 0; i < 16; ++i) {
                const int c = c8 + i;
                uint2 v = nxt[i];
                if (c + 16 < 128) nxt[i] = *(const uint2*)(base + (size_t)(c + 16) * 32768);
                *(uint2*)(base + (size_t)c * 32768) = make_uint2(pk2(C[0], C[1]), pk2(C[2], C[3]));
                const float dec = decv[i];
                C[0] = dec * C[0] + bf2f(v.x & 0xffff); C[1] = dec * C[1] + bf2f(v.x >> 16);
                C[2] = dec * C[2] + bf2f(v.y & 0xffff); C[3] = dec * C[3] + bf2f(v.y >> 16);
            }
        }
    }
    if (blockIdx.x >= gridDim.x - 4) {
        const int e = (blockIdx.x - (gridDim.x - 4)) * 512 + tid;
        const int bh = e >> 7, d = e & 127;
        float* nb = (float*)(ws + OFF_NU) + (size_t)bh * 128 * 128 + d;
        const float* bl = (const float*)(ws + OFF_BLAST) + bh * 128;
        const float* ms = (const float*)(ws + OFF_MST) + bh * 132;
        float n = 0.f;
        for (int c0 = 0; c0 < 128; c0 += 16) {
            float vv[16], dd[16];
#pragma unroll
            for (int i = 0; i < 16; ++i) { vv[i] = nb[(c0 + i) * 128]; dd[i] = __expf(bl[c0 + i] + ms[c0 + i] - ms[c0 + i + 1]); }
#pragma unroll
            for (int i = 0; i < 16; ++i) { nb[(c0 + i) * 128] = n; n = dd[i] * n + vv[i]; }
        }
    }
}
struct EpiGlu {
    bf16_t* yb;
    DI void operator()(const f32x4 (&acc)[2][2][4][2], const pg8::Unit& u, int wr, int wc, int fr, int fq) const {
        pg8::epi8(acc, u, wr, wc, fr, fq, [&](int t, int col8, f32x4 v0, f32x4 v1) __attribute__((always_inline)) {
            f32x4 o;
#pragma unroll
            for (int r = 0; r < 4; ++r) o[r] = v0[r] * sigm(v1[r]);
            *(uint2*)(yb + (size_t)t * 1024 + (col8 >> 1)) = pk4(o);
        });
    }
};

DI void mlstm_out_unit(const Params& p, unsigned char* smem, const int tid, int u) {
    unsigned char* ws = p.ws;
    const int lane = tid & 63, w = tid >> 6;
    const int bh = u >> 7, c = u & 127, b = bh >> 2, h = bh & 3;
    float* gk = (float*)smem;
    float* bq = gk + 64;
    float* sci = bq + 64;
    float* emt = sci + 64;
    float* qn = emt + 64;
    float* rden = qn + 64;
    float* part = rden + 64;
    float* mean_s = part + 256;
    float* rstd_s = mean_s + 64;
    uint4* xs = (uint4*)(smem + 4096);
    const bf16_t* q = (const bf16_t*)((unsigned char*)p.out + U_);
    const bf16_t* k = q + (size_t)16 * 8192 * 128;
    const bf16_t* vT = (const bf16_t*)(ws + 3 * U_);
    const bf16_t* CT = (const bf16_t*)(ws + 1 * U_);
    const bf16_t* og = (const bf16_t*)(ws + 4 * U_);
    bf16_t* hm = (bf16_t*)p.out;
    const float mc = ((const float*)(ws + OFF_MST))[bh * 132 + c];
    const size_t tok0 = (size_t)bh * 8192 + c * 64;
    bf16x8 ctf[4][4];
    {
        const bf16_t* ctb0 = CT + (((size_t)bh * 128 + c) * 256 + 64 * w + (lane & 15)) * 128 + (lane >> 4) * 8;
#pragma unroll
        for (int ks = 0; ks < 4; ++ks)
#pragma unroll
            for (int i = 0; i < 4; ++i) ctf[ks][i] = ld16(ctb0 + (size_t)i * 16 * 128 + ks * 32);
    }
    if (w == 0) {
        float bj = ((const float*)(ws + OFF_BCUM))[tok0 + lane], ij = ((const float*)(ws + OFF_IG))[tok0 + lane];
        float g = ij - bj, pm = g;
        for (int d = 1; d < 64; d <<= 1) { float o = __shfl_up(pm, d, 64); if (lane >= d) pm = fmaxf(pm, o); }
        float mt = bj + fmaxf(mc, pm);
        gk[lane] = g; bq[lane] = bj - mt; sci[lane] = __expf(bj + mc - mt); emt[lane] = __expf(-mt);
    }
    {
        const int t = tid >> 2, p4 = tid & 3;
        const bf16_t* qr = q + (tok0 + t) * 128 + p4 * 32;
        const float* nr = (const float*)(ws + OFF_NU) + ((size_t)bh * 128 + c) * 128 + p4 * 32;
        float s = 0.f;
#pragma unroll
        for (int i = 0; i < 4; ++i) {
            uint4 a = *(const uint4*)(qr + i * 8);
            const unsigned* pa = (const unsigned*)&a;
#pragma unroll
            for (int e = 0; e < 4; ++e) s += bf2f(pa[e] & 0xffff) * nr[i * 8 + 2 * e] + bf2f(pa[e] >> 16) * nr[i * 8 + 2 * e + 1];
        }
        s += __shfl_xor(s, 1, 64); s += __shfl_xor(s, 2, 64);
        if (p4 == 0) qn[t] = s;
    }
    __syncthreads();
    {
        f32x4 X[4];
#pragma unroll
        for (int jt = 0; jt < 4; ++jt) X[jt] = f32x4{0.f, 0.f, 0.f, 0.f};
        const bf16_t* qb = q + (tok0 + 16 * w + (lane & 15)) * 128 + (lane >> 4) * 8;
        bf16x8 qf[4];
#pragma unroll
        for (int ks = 0; ks < 4; ++ks) qf[ks] = ld16(qb + ks * 32);
#pragma unroll
        for (int jt = 0; jt < 4; ++jt) {
            if (jt <= w) {
                const bf16_t* kb = k + (tok0 + 16 * jt + (lane & 15)) * 128 + (lane >> 4) * 8;
#pragma unroll
                for (int ks = 0; ks < 4; ++ks) X[jt] = mfma16(ld16(kb + ks * 32), qf[ks], X[jt]);
            }
        }
        const int t = 16 * w + (lane & 15);
        const float bqt = bq[t];
        float dsum = 0.f;
#pragma unroll
        for (int jt = 0; jt < 4; ++jt)
#pragma unroll
            for (int r = 0; r < 4; ++r) {
                const int j = 16 * jt + (lane >> 4) * 4 + r;
                float v = (j <= t) ? X[jt][r] * __expf(bqt + gk[j]) : 0.f;
                X[jt][r] = v; dsum += v;
            }
        dsum += __shfl_xor(dsum, 16, 64); dsum += __shfl_xor(dsum, 32, 64);
        if (lane < 16) { float den = dsum + sci[t] * qn[t]; rden[t] = 1.f / fmaxf(fabsf(den), emt[t]); }
#pragma unroll
        for (int pr = 0; pr < 2; ++pr) {
            uint2 lo = pk4(X[2 * pr]), hi = pk4(X[2 * pr + 1]);
            xs[(w * 2 + pr) * 64 + lane] = make_uint4(lo.x, lo.y, hi.x, hi.y);
        }
    }
    __syncthreads();
    f32x4 acc[4][4];
#pragma unroll
    for (int i = 0; i < 4; ++i)
#pragma unroll
        for (int j = 0; j < 4; ++j) acc[i][j] = f32x4{0.f, 0.f, 0.f, 0.f};
    {
        const bf16_t* qb = q + (tok0 + (lane & 15)) * 128 + (lane >> 4) * 8;
#pragma unroll
        for (int ks = 0; ks < 4; ++ks) {
            bf16x8 bfr[4];
#pragma unroll
            for (int i = 0; i < 4; ++i) bfr[i] = ld16(qb + (size_t)i * 16 * 128 + ks * 32);
#pragma unroll
            for (int i = 0; i < 4; ++i)
#pragma unroll
                for (int j = 0; j < 4; ++j) acc[i][j] = mfma16(ctf[ks][i], bfr[j], acc[i][j]);
        }
    }
#pragma unroll
    for (int ni = 0; ni < 4; ++ni) {
        const float s = sci[16 * ni + (lane & 15)];
#pragma unroll
        for (int mi = 0; mi < 4; ++mi) { acc[mi][ni][0] *= s; acc[mi][ni][1] *= s; acc[mi][ni][2] *= s; acc[mi][ni][3] *= s; }
    }
    {
        const bf16_t* vb = vT + (((size_t)bh * 128 + c) * 256 + 64 * w + (lane & 15)) * 64 + (lane >> 4) * 4;
#pragma unroll
        for (int pr = 0; pr < 2; ++pr) {
            bf16x8 af[4];
#pragma unroll
            for (int mi = 0; mi < 4; ++mi) {
                uint2 lo = *(const uint2*)(vb + (size_t)mi * 16 * 64 + pr * 32);
                uint2 hi = *(const uint2*)(vb + (size_t)mi * 16 * 64 + pr * 32 + 16);
                af[mi] = __builtin_bit_cast(bf16x8, make_uint4(lo.x, lo.y, hi.x, hi.y));
            }
#pragma unroll
            for (int ni = 0; ni < 4; ++ni) {
                if (ni >= 2 * pr) {
                    bf16x8 xb = __builtin_bit_cast(bf16x8, xs[(ni * 2 + pr) * 64 + lane]);
#pragma unroll
                    for (int mi = 0; mi < 4; ++mi) acc[mi][ni] = mfma16(af[mi], xb, acc[mi][ni]);
                }
            }
        }
    }
#pragma unroll
    for (int ni = 0; ni < 4; ++ni) {
        const float rd = rden[16 * ni + (lane & 15)];
        float s = 0.f;
#pragma unroll
        for (int mi = 0; mi < 4; ++mi) { acc[mi][ni][0] *= rd; acc[mi][ni][1] *= rd; acc[mi][ni][2] *= rd; acc[mi][ni][3] *= rd;
            s += acc[mi][ni][0] + acc[mi][ni][1] + acc[mi][ni][2] + acc[mi][ni][3]; }
        s += __shfl_xor(s, 16, 64); s += __shfl_xor(s, 32, 64);
        if (lane < 16) part[w * 64 + 16 * ni + lane] = s;
    }
    __syncthreads();
    if (tid < 64) mean_s[tid] = (part[tid] + part[64 + tid] + part[128 + tid] + part[192 + tid]) * (1.f / 256.f);
    __syncthreads();
#pragma unroll
    for (int ni = 0; ni < 4; ++ni) {
        const float mu = mean_s[16 * ni + (lane & 15)];
        float s = 0.f;
#pragma unroll
        for (int mi = 0; mi < 4; ++mi)
#pragma unroll
            for (int r = 0; r < 4; ++r) { float d = acc[mi][ni][r] - mu; s += d * d; }
        s += __shfl_xor(s, 16, 64); s += __shfl_xor(s, 32, 64);
        if (lane < 16) part[w * 64 + 16 * ni + lane] = s;
    }
    __syncthreads();
    if (tid < 64) rstd_s[tid] = rsqrtf((part[tid] + part[64 + tid] + part[128 + tid] + part[192 + tid]) * (1.f / 256.f) + 1e-5f);
    __syncthreads();
    const float* gain = p.in[10];
    float4 gg[4];
    unsigned ogv[4][4];
#pragma unroll
    for (int mi = 0; mi < 4; ++mi) gg[mi] = *(const float4*)(gain + h * 256 + 64 * w + 16 * mi + (lane >> 4) * 4);
#pragma unroll
    for (int ni = 0; ni < 4; ++ni)
#pragma unroll
        for (int mi = 0; mi < 4; ++mi)
            ogv[ni][mi] = *(const unsigned*)((const unsigned char*)og + ((size_t)b * 8192 + c * 64 + 16 * ni + (lane & 15)) * 1024 + h * 256 + 64 * w + 16 * mi + (lane >> 4) * 4);
#pragma unroll
    for (int ni = 0; ni < 4; ++ni) {
        const int t = 16 * ni + (lane & 15);
        const float mu = mean_s[t], rs = rstd_s[t];
        const size_t tok = (size_t)b * 8192 + c * 64 + t;
#pragma unroll
        for (int mi = 0; mi < 4; ++mi) {
            const int ch = h * 256 + 64 * w + 16 * mi + (lane >> 4) * 4;
            const f32x4 o2 = un4u8(ogv[ni][mi]);
            f32x4 o;
            o[0] = (acc[mi][ni][0] - mu) * rs * gg[mi].x * o2[0];
            o[1] = (acc[mi][ni][1] - mu) * rs * gg[mi].y * o2[1];
            o[2] = (acc[mi][ni][2] - mu) * rs * gg[mi].z * o2[2];
            o[3] = (acc[mi][ni][3] - mu) * rs * gg[mi].w * o2[3];
            *(uint2*)(hm + tok * 1024 + ch) = pk4(o);
        }
    }
    __syncthreads();
}

struct EpiDown {
    const unsigned char *sga, *sgb; const bf16_t* yb; bf16_t* ymix;
    DI void operator()(const f32x4 (&acc)[2][2][4][2], const pg8::Unit& u, int wr, int wc, int fr, int fq) const {
        const size_t o0 = (size_t)(u.pm * 256 + wr * 64 + fr) * 1024 + u.pn * 256 + wc * 32 + 8 * fq;
#define TOFF(i) (o0 + (size_t)(TILE_AI(i) * 128 + TILE_M(i) * 16) * 1024 + TILE_BJ(i) * 128)
        uint2 A[2], B[2]; uint4 Y[2];
        A[0] = *(const uint2*)(sga + TOFF(0)); B[0] = *(const uint2*)(sgb + TOFF(0)); Y[0] = *(const uint4*)(yb + TOFF(0));
#pragma unroll
        for (int i = 0; i < 16; ++i) {
            if (i + 1 < 16) { A[(i + 1) & 1] = *(const uint2*)(sga + TOFF(i + 1)); B[(i + 1) & 1] = *(const uint2*)(sgb + TOFF(i + 1)); Y[(i + 1) & 1] = *(const uint4*)(yb + TOFF(i + 1)); }
            const uint4 y = Y[i & 1];
            const f32x4 a0 = un4u8(A[i & 1].x), a1 = un4u8(A[i & 1].y), b0 = un4u8(B[i & 1].x), b1 = un4u8(B[i & 1].y);
            const f32x4 v0 = acc[TILE_AI(i)][TILE_BJ(i)][TILE_M(i)][0], v1 = acc[TILE_AI(i)][TILE_BJ(i)][TILE_M(i)][1];
            f32x4 r0, r1;
            r0[0] = a0[0] * v0[0] + b0[0] * bf2f(y.x & 0xffff);
            r0[1] = a0[1] * v0[1] + b0[1] * bf2f(y.x >> 16);
            r0[2] = a0[2] * v0[2] + b0[2] * bf2f(y.y & 0xffff);
            r0[3] = a0[3] * v0[3] + b0[3] * bf2f(y.y >> 16);
            r1[0] = a1[0] * v1[0] + b1[0] * bf2f(y.z & 0xffff);
            r1[1] = a1[1] * v1[1] + b1[1] * bf2f(y.z >> 16);
            r1[2] = a1[2] * v1[2] + b1[2] * bf2f(y.w & 0xffff);
            r1[3] = a1[3] * v1[3] + b1[3] * bf2f(y.w >> 16);
            *(uint4*)(ymix + TOFF(i)) = pk8(r0, r1);
        }
    }
};
struct EpiRes {
    const float* res; const float* gmod; bf16_t* dst;
    DI void operator()(const f32x4 (&acc)[2][2][4][2], const pg8::Unit& u, int wr, int wc, int fr, int fq) const {
        const int t0 = u.pm * 256 + wr * 64 + fr, colb = u.pn * 256 + wc * 32 + 8 * fq;
        const size_t o0 = (size_t)t0 * 1024 + colb;
        f32x4 gg[2][2];
#pragma unroll
        for (int bj = 0; bj < 2; ++bj) { const float* gp = gmod + (t0 >> 13) * 6144 + colb + bj * 128; gg[bj][0] = *(const f32x4*)gp + 1.f; gg[bj][1] = *(const f32x4*)(gp + 4) + 1.f; }
        f32x4 X0[2], X1[2];
        X0[0] = *(const f32x4*)(res + TOFF(0)); X1[0] = *(const f32x4*)(res + TOFF(0) + 4);
#pragma unroll
        for (int i = 0; i < 16; ++i) {
            if (i + 1 < 16) { X0[(i + 1) & 1] = *(const f32x4*)(res + TOFF(i + 1)); X1[(i + 1) & 1] = *(const f32x4*)(res + TOFF(i + 1) + 4); }
            const int bj = TILE_BJ(i);
            const f32x4 r0 = X0[i & 1] * ALPHA_ + gg[bj][0] * acc[TILE_AI(i)][bj][TILE_M(i)][0];
            const f32x4 r1 = X1[i & 1] * ALPHA_ + gg[bj][1] * acc[TILE_AI(i)][bj][TILE_M(i)][1];
            *(uint4*)(dst + TOFF(i)) = pk8(r0, r1);
        }
    }
};

struct EpiRes2 {
    const bf16_t* r1; const float2* stats; const float* lg; const float* lb; const float* gmod; bf16_t* dst;
    DI void operator()(const f32x4 (&acc)[2][2][4][2], const pg8::Unit& u, int wr, int wc, int fr, int fq) const {
        const int t0 = u.pm * 256 + wr * 64 + fr, colb = u.pn * 256 + wc * 32 + 8 * fq;
        const size_t o0 = (size_t)t0 * 1024 + colb;
        f32x4 gg[2][2], la[2][2], lbv[2][2];
#pragma unroll
        for (int bj = 0; bj < 2; ++bj) {
            const float* gp = gmod + (t0 >> 13) * 6144 + colb + bj * 128;
            gg[bj][0] = *(const f32x4*)gp + 1.f; gg[bj][1] = *(const f32x4*)(gp + 4) + 1.f;
            la[bj][0] = *(const f32x4*)(lg + colb + bj * 128) * ALPHA_; la[bj][1] = *(const f32x4*)(lg + colb + bj * 128 + 4) * ALPHA_;
            lbv[bj][0] = *(const f32x4*)(lb + colb + bj * 128) * ALPHA_; lbv[bj][1] = *(const f32x4*)(lb + colb + bj * 128 + 4) * ALPHA_;
        }
        float2 st[8];
#pragma unroll
        for (int j = 0; j < 8; ++j) st[j] = stats[t0 + (j >> 2) * 128 + (j & 3) * 16];
        uint4 XR[2];
        XR[0] = *(const uint4*)(r1 + TOFF(0));
#pragma unroll
        for (int i = 0; i < 16; ++i) {
            if (i + 1 < 16) XR[(i + 1) & 1] = *(const uint4*)(r1 + TOFF(i + 1));
            const int bj = TILE_BJ(i);
            const float2 s2 = st[i >> 1];
            const uint4 xr = XR[i & 1];
            const f32x4 X0 = {bf2f(xr.x & 0xffff), bf2f(xr.x >> 16), bf2f(xr.y & 0xffff), bf2f(xr.y >> 16)};
            const f32x4 X1 = {bf2f(xr.z & 0xffff), bf2f(xr.z >> 16), bf2f(xr.w & 0xffff), bf2f(xr.w >> 16)};
            const f32x4 r0 = ((X0 - s2.x) * s2.y) * la[bj][0] + lbv[bj][0] + gg[bj][0] * acc[TILE_AI(i)][bj][TILE_M(i)][0];
            const f32x4 r1v = ((X1 - s2.x) * s2.y) * la[bj][1] + lbv[bj][1] + gg[bj][1] * acc[TILE_AI(i)][bj][TILE_M(i)][1];
            *(uint4*)(dst + TOFF(i)) = pk8(r0, r1v);
        }
    }
};
#undef TOFF

DI void phase10(const Params& p) {
    unsigned char* ws = p.ws;
    int ft_ = threadIdx.x; asm volatile("" : "+v"(ft_));
    const int lane = ft_ & 63, wid = ft_ >> 6;
    const float* mod = (const float*)(ws + OFF_MOD);
    const bf16_t* r1 = (const bf16_t*)(ws + 2 * U_);
    float2* stats = (float2*)(ws + OFF_STATS);
    bf16_t* h2 = (bf16_t*)(ws + 1 * U_);
    for (int row0 = (blockIdx.x * 8 + wid) * 4; row0 < T_; row0 += gridDim.x * 32) {
        float v[4][16];
#pragma unroll
        for (int rr = 0; rr < 4; ++rr)
#pragma unroll
            for (int i = 0; i < 4; ++i) { uint2 t = *(const uint2*)(r1 + (size_t)(row0 + rr) * 1024 + i * 256 + lane * 4); v[rr][4 * i] = bf2f(t.x & 0xffff); v[rr][4 * i + 1] = bf2f(t.x >> 16); v[rr][4 * i + 2] = bf2f(t.y & 0xffff); v[rr][4 * i + 3] = bf2f(t.y >> 16); }
#pragma unroll
        for (int rr = 0; rr < 4; ++rr) {
            const int row = row0 + rr;
            float mean, rstd; row_stats(v[rr], mean, rstd);
            if (lane == 0) stats[row] = make_float2(mean, rstd);
#pragma unroll
            for (int i = 0; i < 4; ++i) {
                int c = i * 256 + lane * 4;
                float4 g = *(const float4*)(p.in[22] + c), bb = *(const float4*)(p.in[23] + c);
                v[rr][4 * i] = (v[rr][4 * i] - mean) * rstd * g.x + bb.x;
                v[rr][4 * i + 1] = (v[rr][4 * i + 1] - mean) * rstd * g.y + bb.y;
                v[rr][4 * i + 2] = (v[rr][4 * i + 2] - mean) * rstd * g.z + bb.z;
                v[rr][4 * i + 3] = (v[rr][4 * i + 3] - mean) * rstd * g.w + bb.w;
            }
            row_stats(v[rr], mean, rstd);
            const float* mb = mod + (row >> 13) * 6144;
#pragma unroll
            for (int i = 0; i < 4; ++i) {
                int c = i * 256 + lane * 4;
                float4 sh = *(const float4*)(mb + 3072 + c), sc = *(const float4*)(mb + 4096 + c);
                f32x4 o;
                o[0] = (v[rr][4 * i] - mean) * rstd * (1.f + sc.x) + sh.x;
                o[1] = (v[rr][4 * i + 1] - mean) * rstd * (1.f + sc.y) + sh.y;
                o[2] = (v[rr][4 * i + 2] - mean) * rstd * (1.f + sc.z) + sh.z;
                o[3] = (v[rr][4 * i + 3] - mean) * rstd * (1.f + sc.w) + sh.w;
                *(uint2*)(h2 + (size_t)row * 1024 + c) = pk4(o);
            }
        }
    }
}

constexpr size_t HALO_ELEMS = (size_t)512 * 2 * FH;
struct EpiUpF {
    bf16_t* hid; const float* cw; const float* cb; float* glast; float* gfirst; float* vfirst;
    DI void operator()(const f32x4 (&acc)[2][2][4][2], const pg8::Unit& u, int wr, int wc, int fr, int fq) const {
        const int lane = fq * 16 + fr;
        const int src1 = (lane & 48) | ((fr + 15) & 15), src2 = (lane & 48) | ((fr + 14) & 15);
        float4 w0v[2], w1v[2], w2v[2], bbv[2];
#pragma unroll
        for (int bj = 0; bj < 2; ++bj) {
            const int hc = (u.pn * 256 + bj * 128 + wc * 32 + 8 * fq) >> 1;
            w0v[bj] = *(const float4*)(cw + hc); w1v[bj] = *(const float4*)(cw + FH + hc); w2v[bj] = *(const float4*)(cw + 2 * FH + hc); bbv[bj] = *(const float4*)(cb + hc);
        }
#pragma unroll
        for (int bj = 0; bj < 2; ++bj) {
            const int hc = (u.pn * 256 + bj * 128 + wc * 32 + 8 * fq) >> 1;
            const float4 w0 = w0v[bj], w1 = w1v[bj], w2 = w2v[bj], bb = bbv[bj];
#pragma unroll
            for (int ai = 0; ai < 2; ++ai) {
                f32x4 gprev = (f32x4){0.f, 0.f, 0.f, 0.f};
#pragma unroll
                for (int m = 0; m < 4; ++m) {
                    const f32x4 v = acc[ai][bj][m][0], g = acc[ai][bj][m][1];
                    f32x4 p1, p2;
#pragma unroll
                    for (int r = 0; r < 4; ++r) {
                        p1[r] = __builtin_bit_cast(float, __builtin_amdgcn_update_dpp(0, __builtin_bit_cast(int, (fr == 15) ? gprev[r] : g[r]), 0x121, 0xF, 0xF, false));
                        p2[r] = __builtin_bit_cast(float, __builtin_amdgcn_update_dpp(0, __builtin_bit_cast(int, (fr >= 14) ? gprev[r] : g[r]), 0x122, 0xF, 0xF, false));
                    }
                    const int row = u.pm * 256 + ai * 128 + wr * 64 + m * 16 + fr;
                    const int wb = row >> 6;
                    if (m == 0 && fr < 2) {
                        *(f32x4*)(gfirst + ((size_t)wb * 2 + fr) * FH + hc) = g;
                        *(f32x4*)(vfirst + ((size_t)wb * 2 + fr) * FH + hc) = v;
                    } else {
                        f32x4 o;
                        o[0] = gelu_t(bb.x + w0.x * p2[0] + w1.x * p1[0] + w2.x * g[0]) * v[0];
                        o[1] = gelu_t(bb.y + w0.y * p2[1] + w1.y * p1[1] + w2.y * g[1]) * v[1];
                        o[2] = gelu_t(bb.z + w0.z * p2[2] + w1.z * p1[2] + w2.z * g[2]) * v[2];
                        o[3] = gelu_t(bb.w + w0.w * p2[3] + w1.w * p1[3] + w2.w * g[3]) * v[3];
                        *(uint2*)(hid + (size_t)row * FH + hc) = pk4(o);
                    }
                    if (m == 3 && fr >= 14) *(f32x4*)(glast + ((size_t)wb * 2 + (fr - 14)) * FH + hc) = g;
                    gprev = g;
                }
            }
        }
    }
};

DI void phase12(const Params& p) {
    bf16_t* hid = (bf16_t*)(p.ws + 4 * U_);
    const float* glast = p.out;
    const float* gfirst = p.out + HALO_ELEMS;
    const float* vfirst = p.out + 2 * HALO_ELEMS;
    const float* cw = p.in[25];
    const float* cb = p.in[26];
    const int gtid = blockIdx.x * 512 + fresh_tid(), gstr = gridDim.x * 512;
    for (int idx = gtid; idx < 512 * 2 * (FH / 4); idx += gstr) {
        const int cgp = idx % (FH / 4), rr = (idx / (FH / 4)) & 1, wb = idx / (2 * (FH / 4));
        const int hc = cgp * 4;
        const bool seq_start = (wb & 127) == 0;
        const int pb = seq_start ? wb : wb - 1;
        const float pz = seq_start ? 0.f : 1.f;
        float4 la = *(const float4*)(glast + ((size_t)pb * 2 + 0) * FH + hc), lb = *(const float4*)(glast + ((size_t)pb * 2 + 1) * FH + hc);
        la.x *= pz; la.y *= pz; la.z *= pz; la.w *= pz; lb.x *= pz; lb.y *= pz; lb.z *= pz; lb.w *= pz;
        const float4 f0 = *(const float4*)(gfirst + ((size_t)wb * 2 + 0) * FH + hc), f1 = *(const float4*)(gfirst + ((size_t)wb * 2 + 1) * FH + hc);
        float4 gm2, gm1, g0;
        if (rr == 0) { gm2 = la; gm1 = lb; g0 = f0; } else { gm2 = lb; gm1 = f0; g0 = f1; }
        const float4 v = *(const float4*)(vfirst + ((size_t)wb * 2 + rr) * FH + hc);
        const float4 w0 = *(const float4*)(cw + hc), w1 = *(const float4*)(cw + FH + hc), w2 = *(const float4*)(cw + 2 * FH + hc), bb = *(const float4*)(cb + hc);
        f32x4 o;
        o[0] = gelu_t(bb.x + w0.x * gm2.x + w1.x * gm1.x + w2.x * g0.x) * v.x;
        o[1] = gelu_t(bb.y + w0.y * gm2.y + w1.y * gm1.y + w2.y * g0.y) * v.y;
        o[2] = gelu_t(bb.z + w0.z * gm2.z + w1.z * gm1.z + w2.z * g0.z) * v.z;
        o[3] = gelu_t(bb.w + w0.w * gm2.w + w1.w * gm1.w + w2.w * g0.w) * v.w;
        *(uint2*)(hid + ((size_t)wb * 64 + rr) * FH + hc) = pk4(o);
    }
}

DI void phase14(const Params& p) {
    int ft_ = threadIdx.x; asm volatile("" : "+v"(ft_));
    const int lane = ft_ & 63, wid = ft_ >> 6;
    for (int row0 = (blockIdx.x * 8 + wid) * 4; row0 < T_; row0 += gridDim.x * 32) {
        float v[4][16];
#pragma unroll
        for (int rr = 0; rr < 4; ++rr)
#pragma unroll
            for (int i = 0; i < 4; ++i) { uint2 t = *(const uint2*)((const bf16_t*)(p.ws + 1 * U_) + (size_t)(row0 + rr) * 1024 + i * 256 + lane * 4); v[rr][4 * i] = bf2f(t.x & 0xffff); v[rr][4 * i + 1] = bf2f(t.x >> 16); v[rr][4 * i + 2] = bf2f(t.y & 0xffff); v[rr][4 * i + 3] = bf2f(t.y >> 16); }
#pragma unroll
        for (int rr = 0; rr < 4; ++rr) {
            float* xr = p.out + (size_t)(row0 + rr) * 1024;
            float mean, rstd; row_stats(v[rr], mean, rstd);
#pragma unroll
            for (int i = 0; i < 4; ++i) {
                int c = i * 256 + lane * 4;
                float4 g = *(const float4*)(p.in[28] + c), bb = *(const float4*)(p.in[29] + c);
                *(float4*)(xr + c) = make_float4((v[rr][4 * i] - mean) * rstd * g.x + bb.x, (v[rr][4 * i + 1] - mean) * rstd * g.y + bb.y,
                                                 (v[rr][4 * i + 2] - mean) * rstd * g.z + bb.z, (v[rr][4 * i + 3] - mean) * rstd * g.w + bb.w);
            }
        }
    }
}

#define XB_TMO      128
#define XB_XCNT(j)  (256  + 64 * (j))
#define XB_XSUB(j)  (1280 + 64 * (j))
#define XB_XGEN(j)  (2304 + 64 * (j))
#define XB_TOP      3328
#define XB_TOPGEN   3392
#define XB_SPIN_CAP (1u << 22)
DI unsigned xb_ld(unsigned* p)              { return __hip_atomic_load(p, __ATOMIC_RELAXED, __HIP_MEMORY_SCOPE_AGENT); }
DI unsigned xb_add(unsigned* p, unsigned v) { return __hip_atomic_fetch_add(p, v, __ATOMIC_RELAXED, __HIP_MEMORY_SCOPE_AGENT); }
DI unsigned xb_xcc_id() { return (unsigned)__builtin_amdgcn_s_getreg((3 << 11) | 20) & 0xFu; }
#define XB_SPIN(cond, bar) do { unsigned _sp = 0; while (cond) { __builtin_amdgcn_s_sleep(1); \
    if ((++_sp & 255u) == 0u) { if (xb_ld(&(bar)[XB_TMO])) break; if (_sp > XB_SPIN_CAP) { atomicAdd(&(bar)[XB_TMO], 1u); break; } } } } while (0)
DI void xcd_barrier_complete(unsigned* bar, unsigned x, unsigned& nloc, unsigned& nx) {
    const unsigned G = gridDim.x;
    unsigned sum, cnt, mine, sp = 0u;
    for (;;) {
        sum = 0u; cnt = 0u; mine = 0u;
#pragma unroll
        for (unsigned j = 0; j < 16; ++j) { const unsigned c = xb_ld(&bar[XB_XCNT(j)]); sum += c; cnt += (c > 0u) ? 1u : 0u; mine = (j == x) ? c : mine; }
        if (sum == G) break;
        __builtin_amdgcn_s_sleep(1);
        if ((++sp & 255u) == 0u) { if (xb_ld(&bar[XB_TMO])) break; if (sp > XB_SPIN_CAP) { atomicAdd(&bar[XB_TMO], 1u); break; } }
    }
    nloc = mine > 0u ? mine : 1u; nx = cnt > 0u ? cnt : 1u;
}
DI void xcd_barrier(unsigned* bar, volatile __attribute__((address_space(3))) unsigned* st) {
    asm volatile("s_waitcnt vmcnt(0)" ::: "memory");
    __syncthreads();
    if (fresh_tid() == 0) {
        __builtin_amdgcn_s_waitcnt(0);
        const unsigned x = xb_xcc_id();
        unsigned nloc = st[0], nx = st[1];
        if (nloc == 0u) { xcd_barrier_complete(bar, x, nloc, nx); st[0] = nloc; st[1] = nx; }
        const unsigned old = xb_add(&bar[XB_XSUB(x)], 1u);
        const unsigned gen = old / nloc;
        if (old + 1u == (gen + 1u) * nloc) {
            __builtin_amdgcn_fence(__ATOMIC_RELEASE, "agent");
            asm volatile("s_waitcnt vmcnt(0)" ::: "memory");
            const unsigned og = xb_add(&bar[XB_TOP], 1u);
            const unsigned tg = og / nx;
            if (og + 1u == (tg + 1u) * nx) xb_add(&bar[XB_TOPGEN], 1u);
            else XB_SPIN(xb_ld(&bar[XB_TOPGEN]) == tg, bar);
            __builtin_amdgcn_fence(__ATOMIC_ACQUIRE, "agent");
            xb_add(&bar[XB_XGEN(x)], 1u);
            asm volatile("s_waitcnt vmcnt(0)" ::: "memory");
        } else {
            XB_SPIN(xb_ld(&bar[XB_XGEN(x)]) == gen, bar);
            __builtin_amdgcn_fence(__ATOMIC_ACQUIRE, "agent");
            asm volatile("s_waitcnt vmcnt(0)" ::: "memory");
        }
    }
    __syncthreads();
}

constexpr int LDS_BYTES = 131072;
__global__ void __launch_bounds__(512, 2) fwd_megakernel(Params p) {
    extern __shared__ __attribute__((aligned(16))) unsigned char lds[];
    cg::grid_group grid = cg::this_grid();
    unsigned* bar = (unsigned*)(p.ws + OFF_BAR);
    __shared__ __attribute__((aligned(16))) unsigned xb_st[4];
    volatile __attribute__((address_space(3))) unsigned* st = (volatile __attribute__((address_space(3))) unsigned*)xb_st;
    if (threadIdx.x < 4) xb_st[threadIdx.x] = 0u;
    __syncthreads();
    if (threadIdx.x == 0) (void)xb_add(&bar[XB_XCNT(xb_xcc_id())], 1u);
#define GSYNC() xcd_barrier(bar, st)
#define HALF_CTX int ft_ = threadIdx.x; asm volatile("" : "+v"(ft_)); const int half = ft_ >> 8, vtid = ft_ & 255; \
    const int vb = blockIdx.x * 2 + half, nvb = gridDim.x * 2; unsigned char* hsm = lds + half * 65536;
    PG8_LAS unsigned char* glds = (PG8_LAS unsigned char*)lds;
    unsigned char* ws = p.ws;
    pg8::StaticOrder S;
    if (p.out == nullptr) grid.sync();
    { HALF_CTX phase0(p, hsm, vtid, vb, nvb); }
    GSYNC();
    phase1(p, lds);
    GSYNC();
    {
        pg8::Gemm g{(const bf16_t*)(ws + 1 * U_), (const bf16_t*)(ws + OFF_WIN), 1024, 1024, 1024, 0};
        S.init(T_, 4608, gridDim.x, blockIdx.x);
        EpiIn E{p.in[5], (bf16_t*)(ws + 2 * U_), (bf16_t*)(ws + 3 * U_), (bf16_t*)(ws + 4 * U_), (bf16_t*)(ws + 5 * U_), (bf16_t*)(ws + 6 * U_), (bf16_t*)(ws + 7 * U_)};
        pg8::gemm_phase(glds, g, S, E);
    }
    GSYNC();
    { HALF_CTX phase3(p, hsm, vtid, vb, nvb); }
    GSYNC();
    phase4_small(p, lds);
    {
        bf16_t* q = (bf16_t*)((unsigned char*)p.out + U_);
        pg8::Gemm g{(const bf16_t*)(ws + 1 * U_), (const bf16_t*)(ws + OFF_WQK), 1024, 256, 256, 512};
        S.init(T_, 1024, gridDim.x, blockIdx.x);
        EpiQK E{q, q + (size_t)16 * 8192 * 128, (bf16_t*)(ws + 7 * U_ + U_ / 2)};
        pg8::gemm_phase(glds, g, S, E);
    }
    GSYNC();
    { HALF_CTX phase5(p, hsm, vtid, vb, nvb); }
    GSYNC();
    phase6_scan(p);
    {
        pg8::Gemm g{(const bf16_t*)p.out, (const bf16_t*)(ws + OFF_WGL), 512, 512, 512, 0};
        S.init(T_, 2048, gridDim.x, blockIdx.x);
        EpiGlu E{(bf16_t*)(ws + 7 * U_)};
        pg8::gemm_phase(glds, g, S, E);
    }
    GSYNC();
    { HALF_CTX for (int u = vb; u < 2048; u += nvb) mlstm_out_unit(p, hsm, vtid, u); }
    GSYNC();
    {
        pg8::Gemm g{(const bf16_t*)p.out, (const bf16_t*)(ws + OFF_WDN), 1024, 1024, 1024, 0};
        S.init(T_, 1024, gridDim.x, blockIdx.x);
        EpiDown E{(const unsigned char*)(ws + 5 * U_), (const unsigned char*)(ws + 6 * U_), (const bf16_t*)(ws + 7 * U_), (bf16_t*)(ws + 1 * U_)};
        pg8::gemm_phase(glds, g, S, E);
    }
    GSYNC();
    {
        pg8::Gemm g{(const bf16_t*)(ws + 1 * U_), (const bf16_t*)(ws + OFF_WMX), 1024, 1024, 1024, 0};
        S.init(T_, 1024, gridDim.x, blockIdx.x);
        EpiRes E{p.in[0], (const float*)(ws + OFF_MOD) + 2048, (bf16_t*)(ws + 2 * U_)};
        pg8::gemm_phase(glds, g, S, E);
    }
    GSYNC();
    phase10(p);
    GSYNC();
    {
        pg8::Gemm g{(const bf16_t*)(ws + 1 * U_), (const bf16_t*)(ws + OFF_WUP), 1024, 1024, 1024, 0};
        S.init(T_, 5632, gridDim.x, blockIdx.x);
        EpiUpF E{(bf16_t*)(ws + 4 * U_), p.in[25], p.in[26], p.out, p.out + HALO_ELEMS, p.out + 2 * HALO_ELEMS};
        pg8::gemm_phase(glds, g, S, E);
    }
    GSYNC();
    phase12(p);
    GSYNC();
    {
        pg8::Gemm g{(const bf16_t*)(ws + 4 * U_), (const bf16_t*)(ws + OFF_WFD), FH, FH, FH, 0};
        S.init(T_, 1024, gridDim.x, blockIdx.x);
        EpiRes2 E{(const bf16_t*)(ws + 2 * U_), (const float2*)(ws + OFF_STATS), p.in[22], p.in[23], (const float*)(ws + OFF_MOD) + 5120, (bf16_t*)(ws + 1 * U_)};
        pg8::gemm_phase(glds, g, S, E);
    }
    GSYNC();
    phase14(p);
}

extern "C" void kernel_launch(void* const* d_in, const int* in_sizes, int n_in, void* d_out, int out_size, void* d_ws, size_t ws_size, hipStream_t stream) {
    static int grid_blocks = 0;
    if (grid_blocks == 0) {
        if (n_in != 30 || out_size != T_ * 1024 || ws_size < 8 * U_) { fprintf(stderr, "kernel_launch: unexpected shapes (n_in %d out %d ws %zu)\n", n_in, out_size, ws_size); grid_blocks = -1; return; }
        int dev = 0, cus = 0, per_cu = 0;
        (void)hipGetDevice(&dev);
        (void)hipDeviceGetAttribute(&cus, hipDeviceAttributeMultiprocessorCount, dev);
        if (hipFuncSetAttribute((const void*)fwd_megakernel, hipFuncAttributeMaxDynamicSharedMemorySize, LDS_BYTES) != hipSuccess) { fprintf(stderr, "hipFuncSetAttribute failed\n"); grid_blocks = -1; return; }
        (void)hipOccupancyMaxActiveBlocksPerMultiprocessor(&per_cu, fwd_megakernel, 512, LDS_BYTES);
        if (per_cu < 1) { fprintf(stderr, "occupancy query says 0 blocks/CU\n"); per_cu = 1; }
        grid_blocks = cus;
    }
    if (grid_blocks < 0) return;
    Params p{};
    for (int i = 0; i < 30; ++i) p.in[i] = (const float*)d_in[i];
    p.out = (float*)d_out;
    p.ws = (unsigned char*)d_ws;
    if (hipMemsetAsync((unsigned char*)d_ws + OFF_BAR, 0, 16384, stream) != hipSuccess) { fprintf(stderr, "memset failed\n"); return; }
    void* args[] = {&p};
    hipError_t e = hipLaunchCooperativeKernel((const void*)fwd_megakernel, dim3(grid_blocks), dim3(512), args, LDS_BYTES, stream);
    if (e != hipSuccess) fprintf(stderr, "cooperative launch failed: %s (grid %d)\n", hipGetErrorString(e), grid_blocks);
}
```

```cpp
#include <hip/hip_runtime.h>
#include <hip/hip_cooperative_groups.h>
#include <cstdio>
#include <cstdint>
namespace cg = cooperative_groups;

#define DI __device__ __forceinline__
typedef unsigned short bf16_t;
typedef short bf16x8 __attribute__((ext_vector_type(8)));
typedef float f32x4 __attribute__((ext_vector_type(4)));

constexpr int T_ = 32768, S_ = 8192, FH = 2816;
constexpr size_t U_ = 67108864;
constexpr float ALPHA_ = 1.189207115002721f;

constexpr size_t OFF_WIN = 0;
constexpr size_t OFF_WQK = OFF_WIN + 9437184;
constexpr size_t OFF_WDN = OFF_WQK + 524288;
constexpr size_t OFF_WGL = OFF_WDN + 2097152;
constexpr size_t OFF_WMX = OFF_WGL + 2097152;
constexpr size_t OFF_WUP = OFF_WMX + 2097152;
constexpr size_t OFF_WFD = OFF_WUP + 11534336;
constexpr size_t OFF_MOD = OFF_WFD + 5767168;
constexpr size_t OFF_APOW = OFF_MOD + 98304;
constexpr size_t OFF_BBAR = OFF_APOW + 1064960;
constexpr size_t OFF_KC = OFF_BBAR + 262144;
constexpr size_t OFF_EMAT = OFF_KC + 1048576;
constexpr size_t OFF_CMAT = OFF_EMAT + 8388608;
constexpr size_t OFF_IG = OFF_CMAT + 8388608;
constexpr size_t OFF_LOGF = OFF_IG + 524288;
constexpr size_t OFF_BCUM = OFF_LOGF + 524288;
constexpr size_t OFF_AARR = OFF_BCUM + 524288;
constexpr size_t OFF_BLAST = OFF_AARR + 8192;
constexpr size_t OFF_MST = OFF_BLAST + 8192;
constexpr size_t OFF_NU = OFF_MST + 8448;
constexpr size_t OFF_BAR = OFF_NU + 1048576;
constexpr size_t OFF_STATS = OFF_BAR + 16384;
constexpr size_t OFF_END = OFF_STATS + 262144;
static_assert(OFF_END <= U_, "R0 overflow");

struct Params { const float* in[30]; float* out; unsigned char* ws; };

DI float bf2f(unsigned short h) { return __uint_as_float(((unsigned)h) << 16); }
typedef __bf16 bf16x2_t __attribute__((ext_vector_type(2)));
typedef float f32x2_t __attribute__((ext_vector_type(2)));
DI unsigned pk2(float lo, float hi) { f32x2_t v = {lo, hi}; bf16x2_t b = __builtin_convertvector(v, bf16x2_t); return __builtin_bit_cast(unsigned, b); }
DI unsigned short f2bf(float x) { return (unsigned short)(pk2(x, 0.f) & 0xffffu); }
DI uint2 pk4(f32x4 v) { return make_uint2(pk2(v[0], v[1]), pk2(v[2], v[3])); }
DI float sigm(float x) { return __builtin_amdgcn_rcpf(1.f + __expf(-x)); }
DI float gelu_t(float x) { float u = 1.5957691216057308f * (x + 0.044715f * x * x * x); return x * __builtin_amdgcn_rcpf(1.f + __expf(-u)); }
DI float logsig(float x) { return (x < 0.f) ? (x - log1pf(__expf(x))) : (-log1pf(__expf(-x))); }
DI bf16x8 ld16(const bf16_t* p) { return *reinterpret_cast<const bf16x8*>(p); }
DI f32x4 mfma16(bf16x8 a, bf16x8 b, f32x4 c) { return __builtin_amdgcn_mfma_f32_16x16x32_bf16(a, b, c, 0, 0, 0); }
DI int fresh_tid() { int t = threadIdx.x; asm volatile("" : "+v"(t)); return t; }
DI float dpp_f(float v, const int ctrl_sel) {
    int x = __builtin_bit_cast(int, v), r;
    if (ctrl_sel == 0) r = __builtin_amdgcn_update_dpp(0, x, 0xB1, 0xF, 0xF, false);
    else if (ctrl_sel == 1) r = __builtin_amdgcn_update_dpp(0, x, 0x4E, 0xF, 0xF, false);
    else if (ctrl_sel == 2) r = __builtin_amdgcn_update_dpp(0, x, 0x141, 0xF, 0xF, false);
    else r = __builtin_amdgcn_update_dpp(0, x, 0x140, 0xF, 0xF, false);
    return __builtin_bit_cast(float, r);
}
DI float wsum(float v) {
    v += dpp_f(v, 0); v += dpp_f(v, 1); v += dpp_f(v, 2); v += dpp_f(v, 3);
    const int x = __builtin_bit_cast(int, v);
    return __builtin_bit_cast(float, __builtin_amdgcn_readlane(x, 0)) + __builtin_bit_cast(float, __builtin_amdgcn_readlane(x, 16))
         + __builtin_bit_cast(float, __builtin_amdgcn_readlane(x, 32)) + __builtin_bit_cast(float, __builtin_amdgcn_readlane(x, 48));
}

template <class LA, class LB>
DI void gemm_tile(unsigned char* smem, const int tid, int nk, LA la, LB lb, f32x4 (&acc)[4][4]) {
    const int lane = tid & 63, wid = tid >> 6;
    const int wf = wid >> 1, wt = wid & 1;
    const int lr = tid >> 3, lc = tid & 7;
    unsigned char* sA = smem;
    unsigned char* sB = smem + 32768;
#pragma unroll
    for (int i = 0; i < 4; ++i)
#pragma unroll
        for (int j = 0; j < 4; ++j) acc[i][j] = f32x4{0.f, 0.f, 0.f, 0.f};
    uint4 ra[4], rb[4], na[4], nb[4];
#pragma unroll
    for (int i = 0; i < 4; ++i) { ra[i] = la(lr + 32 * i, lc * 8); rb[i] = lb(lr + 32 * i, lc * 8); }
    if (nk > 1) {
#pragma unroll
        for (int i = 0; i < 4; ++i) { na[i] = la(lr + 32 * i, 64 + lc * 8); nb[i] = lb(lr + 32 * i, 64 + lc * 8); }
    }
    const int woff = lr * 128 + ((lc ^ ((lr >> 1) & 7)) << 4);
#pragma unroll
    for (int i = 0; i < 4; ++i) { *(uint4*)(sA + woff + i * 4096) = ra[i]; *(uint4*)(sB + woff + i * 4096) = rb[i]; }
    __syncthreads();
    const int frow = lane & 15, fq = lane >> 4, fsw = (frow >> 1) & 7;
    for (int kt = 0; kt < nk; ++kt) {
        const int cur = kt & 1;
#pragma unroll
        for (int i = 0; i < 4; ++i) { ra[i] = na[i]; rb[i] = nb[i]; }
        if (kt + 2 < nk) {
#pragma unroll
            for (int i = 0; i < 4; ++i) { na[i] = la(lr + 32 * i, (kt + 2) * 64 + lc * 8); nb[i] = lb(lr + 32 * i, (kt + 2) * 64 + lc * 8); }
        }
        const unsigned char* cA = sA + cur * 16384 + (wf * 64 + frow) * 128;
        const unsigned char* cB = sB + cur * 16384 + (wt * 64 + frow) * 128;
#pragma unroll
        for (int ks = 0; ks < 2; ++ks) {
            const int ch = ((ks * 4 + fq) ^ fsw) << 4;
            bf16x8 af[4], bfr[4];
#pragma unroll
            for (int i = 0; i < 4; ++i) { af[i] = *(const bf16x8*)(cA + i * 2048 + ch); bfr[i] = *(const bf16x8*)(cB + i * 2048 + ch); }
#pragma unroll
            for (int i = 0; i < 4; ++i)
#pragma unroll
                for (int j = 0; j < 4; ++j) acc[i][j] = mfma16(af[i], bfr[j], acc[i][j]);
        }
        if (kt + 1 < nk) {
            const int nbuf = (cur ^ 1) * 16384;
#pragma unroll
            for (int i = 0; i < 4; ++i) { *(uint4*)(sA + nbuf + woff + i * 4096) = ra[i]; *(uint4*)(sB + nbuf + woff + i * 4096) = rb[i]; }
        }
        __syncthreads();
    }
}
template <class F>
DI void epi_loop(f32x4 (&acc)[4][4], const int vtid_, F f) {
    const int lane_ = vtid_ & 63, wid_ = vtid_ >> 6, wf_ = wid_ >> 1, wt_ = wid_ & 1;
#pragma unroll
    for (int fi = 0; fi < 4; ++fi)
#pragma unroll
        for (int ti = 0; ti < 4; ++ti) f(wf_ * 64 + fi * 16 + (lane_ >> 4) * 4, wt_ * 64 + ti * 16 + (lane_ & 15), acc[fi][ti]);
}


namespace pg8 {
#define PG8_LAS __attribute__((address_space(3)))
constexpr int BM = 256, BK = 64, HALF = 128, HTB = HALF * BK * 2, NXCD = 8, WGM = 8;
DI int lds_byte(int r, int c) { const int st = (r >> 4) * 2 + (c >> 5), rr = r & 15, cc = c & 31, ob = rr * 64 + cc * 2; return st * 1024 + (ob ^ (((ob >> 9) & 1) << 5)); }
DI void stage_rc(int b, int& R, int& C) { const int st = b / 1024, sb = b % 1024, swz = sb ^ (((sb >> 9) & 1) << 5); R = (st >> 1) * 16 + swz / 64; C = (st & 1) * 32 + (swz % 64) / 2; }
DI int perm32(int rho) { const int n = rho >> 4, i = rho & 15; return 8 * (i >> 2) + 4 * n + (i & 3); }
struct Unit { int pm, pn; };
struct Gemm { const bf16_t* A; const bf16_t* Bt; int lda, ldb, K, a_pn_off; };
struct StaticOrder {
    int nM, nN, nwg, G, c;
    DI void init(int M, int N, int G_, int c_) { nM = M / BM; nN = N / BM; nwg = nM * nN; G = G_; c = c_; }
    DI bool next(int i, Unit& u) const {
        const long L = (long)i * G + c; if (L >= nwg) return false;
        int wgid = (int)L; { const int q = nwg / NXCD, r = nwg % NXCD, xcd = wgid % NXCD, off = wgid / NXCD; wgid = (xcd < r ? xcd * (q + 1) : r * (q + 1) + (xcd - r) * q) + off; }
        const int nig = WGM * nN, gid = wgid / nig, fm = gid * WGM, gsz = (nM - fm) < WGM ? (nM - fm) : WGM;
        u.pm = fm + ((wgid % nig) % gsz); u.pn = (wgid % nig) / gsz; return true;
    }
};
template <class Epi>
DI void gemm_phase(PG8_LAS unsigned char* lds, const Gemm g, const StaticOrder& S, const Epi& E) {
    int tid = threadIdx.x; asm volatile("" : "+v"(tid));
    const int wid = __builtin_amdgcn_readfirstlane(tid >> 6), lane = tid & 63, wr = wid >> 2, wc = wid & 3, fr = lane & 15, fq = lane >> 4;
    const int nt = g.K / BK;
    unsigned voffA[2], voffB[2];
#pragma unroll
    for (int i = 0; i < 2; ++i) { int R, C; stage_rc(tid * 16 + i * 8192, R, C); const int Rb = (R & ~31) + perm32(R & 31);
        voffA[i] = (unsigned)(R * g.lda + C) * 2u; voffB[i] = (unsigned)(Rb * g.ldb + C) * 2u; }
    const size_t kstep = (size_t)(BK * 2);
    const size_t hstepA = (size_t)HALF * g.lda * 2, hstepB = (size_t)HALF * g.ldb * 2;
    const size_t tstepA = 2 * hstepA, tstepB = 2 * hstepB;
    const unsigned ldsw = (unsigned)wid * 1024u;
    const int aoff = lds_byte(wr * 64 + fr, fq * 8), boff = lds_byte(wc * 32 + fr, fq * 8);
#define PG8_SA(b, h) (((b) * 2 + (h)) * HTB)
#define PG8_SB(b, h) ((4 + (b) * 2 + (h)) * HTB)
#define PG8_STAGE(bufoff, gbase, voff) do { _Pragma("unroll") for (int _i = 0; _i < 2; ++_i) \
        __builtin_amdgcn_global_load_lds((const unsigned*)((const char*)(gbase) + (voff)[_i]), (PG8_LAS unsigned*)(lds + (bufoff) + ldsw + _i * 8192), 16, 0, 0); } while (0)
#define PG8_LDA(dst, b, h) do { _Pragma("unroll") for (int m = 0; m < 4; ++m) _Pragma("unroll") for (int k = 0; k < 2; ++k) dst[m][k] = *(const PG8_LAS bf16x8*)(lds + PG8_SA(b, h) + aoff + m * 2048 + k * 1024); } while (0)
#define PG8_LDB(dst, b, h) do { _Pragma("unroll") for (int n = 0; n < 2; ++n) _Pragma("unroll") for (int k = 0; k < 2; ++k) dst[n][k] = *(const PG8_LAS bf16x8*)(lds + PG8_SB(b, h) + boff + n * 2048 + k * 1024); } while (0)
#define PG8_MMA(ai, bj, At, Bt) do { __builtin_amdgcn_s_setprio(1); _Pragma("unroll") for (int m = 0; m < 4; ++m) _Pragma("unroll") for (int n = 0; n < 2; ++n) _Pragma("unroll") for (int k = 0; k < 2; ++k) \
        acc[ai][bj][m][n] = __builtin_amdgcn_mfma_f32_16x16x32_bf16(Bt[n][k], At[m][k], acc[ai][bj][m][n], 0, 0, 0); __builtin_amdgcn_s_setprio(0); } while (0)
#define PG8_WAIT_V(n) asm volatile("s_waitcnt vmcnt(" #n ")" ::: "memory")
#define PG8_WAIT_L(n) asm volatile("s_waitcnt lgkmcnt(" #n ")" ::: "memory")
#define PG8_BAR __builtin_amdgcn_s_barrier()
#define PG8_SCHED __builtin_amdgcn_sched_barrier(0)
    Unit cur, nxt; int ui = 0;
    if (!S.next(0, cur)) return;
    f32x4 acc[2][2][4][2];
#pragma unroll
    for (int a = 0; a < 2; ++a)
#pragma unroll
        for (int b = 0; b < 2; ++b)
#pragma unroll
            for (int m = 0; m < 4; ++m)
#pragma unroll
                for (int n = 0; n < 2; ++n) acc[a][b][m][n] = (f32x4){0.f, 0.f, 0.f, 0.f};
    bf16x8 At[4][2], B0[2][2], B1[2][2];
    const char* cA = (const char*)g.A + (size_t)cur.pm * tstepA + (size_t)cur.pn * g.a_pn_off; const char* cB = (const char*)g.Bt + (size_t)cur.pn * tstepB;
    PG8_STAGE(PG8_SB(0, 0), cB, voffB); PG8_STAGE(PG8_SB(0, 1), cB + hstepB, voffB); PG8_STAGE(PG8_SA(0, 0), cA, voffA); PG8_STAGE(PG8_SA(0, 1), cA + hstepA, voffA);
    if (wr == 1) PG8_BAR;
    PG8_WAIT_V(2); PG8_BAR;
    PG8_STAGE(PG8_SB(1, 0), cB + kstep, voffB); PG8_STAGE(PG8_SA(1, 0), cA + kstep, voffA); PG8_STAGE(PG8_SB(1, 1), cB + hstepB + kstep, voffB);
    PG8_WAIT_V(6); PG8_BAR;
    for (;;) {
        const bool has_next = S.next(ui + 1, nxt);
        const char* nA = has_next ? (const char*)g.A + (size_t)nxt.pm * tstepA + (size_t)nxt.pn * g.a_pn_off : cA; const char* nB = has_next ? (const char*)g.Bt + (size_t)nxt.pn * tstepB : cB;
        for (int t = 0; t < nt; t += 2) {
            const bool last = (t == nt - 2);
            const char* a1 = cA + (size_t)(t + 1) * kstep;
            const char* a2 = last ? nA : cA + (size_t)(t + 2) * kstep; const char* b2 = last ? nB : cB + (size_t)(t + 2) * kstep;
            const char* a3 = a2 + kstep; const char* b3 = b2 + kstep;
            PG8_LDB(B0, 0, 0); PG8_LDB(B1, 0, 1); PG8_SCHED; PG8_LDA(At, 0, 0); PG8_STAGE(PG8_SA(1, 1), a1 + hstepA, voffA);
            PG8_WAIT_V(8); PG8_WAIT_L(0); PG8_BAR; PG8_MMA(0, 0, At, B0); PG8_MMA(0, 1, At, B1); PG8_BAR; PG8_SCHED;
            PG8_LDA(At, 0, 1); PG8_STAGE(PG8_SB(0, 0), b2, voffB); PG8_STAGE(PG8_SB(0, 1), b2 + hstepB, voffB); PG8_STAGE(PG8_SA(0, 0), a2, voffA);
            PG8_WAIT_V(8); PG8_WAIT_L(0); PG8_BAR; PG8_MMA(1, 0, At, B0); PG8_MMA(1, 1, At, B1); PG8_BAR; PG8_SCHED;
            PG8_LDB(B0, 1, 0); PG8_LDB(B1, 1, 1); PG8_SCHED; PG8_LDA(At, 1, 0); PG8_STAGE(PG8_SA(0, 1), a2 + hstepA, voffA);
            PG8_WAIT_V(8); PG8_WAIT_L(0); PG8_BAR; PG8_MMA(0, 0, At, B0); PG8_MMA(0, 1, At, B1); PG8_BAR; PG8_SCHED;
            PG8_LDA(At, 1, 1); PG8_STAGE(PG8_SB(1, 0), b3, voffB); PG8_STAGE(PG8_SB(1, 1), b3 + hstepB, voffB); PG8_STAGE(PG8_SA(1, 0), a3, voffA);
            PG8_WAIT_V(8); PG8_WAIT_L(0); PG8_BAR; PG8_MMA(1, 0, At, B0); PG8_MMA(1, 1, At, B1); PG8_BAR; PG8_SCHED;
        }
        if (wr == 0) PG8_BAR;
        { int efr = fr, efq = fq; asm volatile("" : "+v"(efr), "+v"(efq)); E(acc, cur, wr, wc, efr, efq); }
        if (!has_next) break;
#pragma unroll
        for (int a = 0; a < 2; ++a)
#pragma unroll
            for (int b = 0; b < 2; ++b)
#pragma unroll
                for (int m = 0; m < 4; ++m)
#pragma unroll
                    for (int n = 0; n < 2; ++n) acc[a][b][m][n] = (f32x4){0.f, 0.f, 0.f, 0.f};
        cur = nxt; cA = nA; cB = nB; ++ui;
        if (wr == 1) PG8_BAR;
    }
    PG8_WAIT_V(0);
    PG8_BAR;
#undef PG8_SA
#undef PG8_SB
#undef PG8_STAGE
#undef PG8_LDA
#undef PG8_LDB
#undef PG8_MMA
#undef PG8_WAIT_V
#undef PG8_WAIT_L
#undef PG8_BAR
#undef PG8_SCHED
}
template <class F>
DI void epi8(const f32x4 (&acc)[2][2][4][2], const Unit& u, int wr, int wc, int fr, int fq, F f) {
#pragma unroll
    for (int ai = 0; ai < 2; ++ai)
#pragma unroll
        for (int m = 0; m < 4; ++m)
#pragma unroll
            for (int bj = 0; bj < 2; ++bj) f(u.pm * 256 + ai * 128 + wr * 64 + m * 16 + fr, u.pn * 256 + bj * 128 + wc * 32 + 8 * fq, acc[ai][bj][m][0], acc[ai][bj][m][1]);
}
}
#define TILE_AI(i) ((i) >> 3)
#define TILE_M(i)  (((i) >> 1) & 3)
#define TILE_BJ(i) ((i) & 1)
DI unsigned pk4u8(f32x4 v) {
    unsigned r = 0;
    r = __builtin_amdgcn_cvt_pk_u8_f32(v[0] * 255.f, 0, r); r = __builtin_amdgcn_cvt_pk_u8_f32(v[1] * 255.f, 1, r);
    r = __builtin_amdgcn_cvt_pk_u8_f32(v[2] * 255.f, 2, r); r = __builtin_amdgcn_cvt_pk_u8_f32(v[3] * 255.f, 3, r);
    return r;
}
DI f32x4 un4u8(unsigned w) {
    const float k = 1.f / 255.f;
    return (f32x4){(float)(w & 0xffu) * k, (float)((w >> 8) & 0xffu) * k, (float)((w >> 16) & 0xffu) * k, (float)(w >> 24) * k};
}
DI uint4 pk8(f32x4 a, f32x4 b) { return make_uint4(pk2(a[0], a[1]), pk2(a[2], a[3]), pk2(b[0], b[1]), pk2(b[2], b[3])); }

struct RowMajor {
    const bf16_t* base; int ld;
    DI uint4 operator()(int r, int k) const { return *(const uint4*)(base + (size_t)r * ld + k); }
};

DI void transpose_tile(unsigned char* smem, const int tid, const float* src, int K, int N, bf16_t* dst, int ldd, int permid, int kt, int nt) {
    float (*tile)[65] = (float (*)[65])smem;
    const int k0 = kt * 64, n0 = nt * 64;
    float tv[16];
#pragma unroll
    for (int i = 0; i < 16; ++i) {
        int kk = i * 4 + (tid >> 6), nn = tid & 63;
        tv[i] = (n0 + nn < N) ? src[(size_t)(k0 + kk) * N + n0 + nn] : 0.f;
    }
#pragma unroll
    for (int i = 0; i < 16; ++i) tile[tid & 63][i * 4 + (tid >> 6)] = tv[i];
    __syncthreads();
#pragma unroll 4
    for (int i = 0; i < 16; ++i) {
        int nn = i * 4 + (tid >> 6), kk = tid & 63;
        int n = n0 + nn;
        if (n < N) {
            int row = n;
            if (permid == 1) row = (n < 2048) ? n : ((n >= 2056) ? n - 8 : -1);
            else if (permid == 2) row = (n < 1024) ? ((n >> 2) * 8 + (n & 3)) : (((n - 1024) >> 2) * 8 + 4 + (n & 3));
            else if (permid == 3) row = (n < 2816) ? ((n >> 2) * 8 + (n & 3)) : (((n - 2816) >> 2) * 8 + 4 + (n & 3));
            if (row >= 0) dst[(size_t)row * ldd + k0 + kk] = f2bf(tile[nn][kk]);
        }
    }
    __syncthreads();
}

DI void phase0(const Params& p, unsigned char* smem, const int tid, const int vb, const int nvb) {
    unsigned char* ws = p.ws;
    const int NTR = 4112, NADA = 192, NS5 = 32;
    for (int it0 = vb; it0 < NTR + NADA + NS5; it0 += nvb) {
        const int it = (it0 < NADA + NS5) ? (NTR + it0) : (it0 - NADA - NS5);
        if (it < NTR) {
            int id = it;
            if (id < 1168) { transpose_tile(smem, tid, p.in[4], 1024, 4616, (bf16_t*)(ws + OFF_WIN), 1024, 1, id / 73, id % 73); continue; }
            id -= 1168;
            if (id < 64) {
                int isk = id >> 5, r = id & 31, h = r >> 3, t = r & 7;
                transpose_tile(smem, tid, (isk ? p.in[9] : p.in[8]) + (size_t)h * 256 * 128, 256, 128,
                               (bf16_t*)(ws + OFF_WQK) + (size_t)h * 65536 + (isk ? 128 * 256 : 0), 256, 0, t >> 1, t & 1);
                continue;
            }
            id -= 64;
            if (id < 256) { transpose_tile(smem, tid, p.in[11], 1024, 1024, (bf16_t*)(ws + OFF_WDN), 1024, 0, id >> 4, id & 15); continue; }
            id -= 256;
            if (id < 256) { transpose_tile(smem, tid, p.in[20], 512, 2048, (bf16_t*)(ws + OFF_WGL), 512, 2, id >> 5, id & 31); continue; }
            id -= 256;
            if (id < 256) { transpose_tile(smem, tid, p.in[21], 1024, 1024, (bf16_t*)(ws + OFF_WMX), 1024, 0, id >> 4, id & 15); continue; }
            id -= 256;
            if (id < 1408) { transpose_tile(smem, tid, p.in[24], 1024, 5632, (bf16_t*)(ws + OFF_WUP), 1024, 3, id / 88, id % 88); continue; }
            id -= 1408;
            transpose_tile(smem, tid, p.in[27], 2816, 1024, (bf16_t*)(ws + OFF_WFD), 2816, 0, id >> 4, id & 15);
        } else if (it < NTR + NADA) {
            const int a = it - NTR;
            float* sc = (float*)smem;
            float* red = (float*)(smem + 16384);
            for (int i = tid; i < 4096; i += 256) { float v = p.in[1][i]; sc[i] = v / (1.f + __expf(-v)); }
            __syncthreads();
            const int col = tid & 31, kg = tid >> 5, n0 = a * 32;
            float a0 = 0, a1 = 0, a2 = 0, a3 = 0;
            const float* wp = p.in[2] + (size_t)(kg * 128) * 6144 + n0 + col;
#pragma unroll 16
            for (int k = 0; k < 128; ++k) {
                float w = wp[(size_t)k * 6144];
                int kk = kg * 128 + k;
                a0 += sc[kk] * w; a1 += sc[1024 + kk] * w; a2 += sc[2048 + kk] * w; a3 += sc[3072 + kk] * w;
            }
            red[(kg * 4 + 0) * 32 + col] = a0; red[(kg * 4 + 1) * 32 + col] = a1; red[(kg * 4 + 2) * 32 + col] = a2; red[(kg * 4 + 3) * 32 + col] = a3;
            __syncthreads();
            if (tid < 128) {
                int b = tid >> 5, c2 = tid & 31;
                float sacc = p.in[3][n0 + c2];
                for (int g = 0; g < 8; ++g) sacc += red[(g * 4 + b) * 32 + c2];
                ((float*)(ws + OFF_MOD))[b * 6144 + n0 + c2] = sacc;
            }
            __syncthreads();
        } else {
            const int g = it - NTR - NADA;
            const float dtf = expf(p.in[14][g]);
            const double dt = (double)dtf;
            float2* apow = (float2*)(ws + OFF_APOW);
            for (int idx = tid; idx < 64 * 65; idx += 256) {
                int pp = idx / 65, tau = idx % 65;
                double lr = p.in[12][g * 64 + pp], li = p.in[13][g * 64 + pp];
                double rev = li * dt * (double)tau * 0.15915494309189535;
                rev -= rint(rev);
                float mag = expf((float)(lr * dt * (double)tau));
                apow[((size_t)g * 65 + tau) * 64 + pp] = make_float2(mag * __builtin_amdgcn_cosf((float)rev), mag * __builtin_amdgcn_sinf((float)rev));
            }
            if (tid < 64) {
                int pp = tid;
                float lr = p.in[12][g * 64 + pp], li = p.in[13][g * 64 + pp];
                float em1 = expm1f(lr * dtf), mag = em1 + 1.f;
                double rev = (double)li * dt * 0.15915494309189535;
                double revh = 0.5 * rev;
                rev -= rint(rev); revh -= rint(revh);
                float sh = __builtin_amdgcn_sinf((float)revh);
                float arm1 = em1 - 2.f * mag * sh * sh;
                float ai = mag * __builtin_amdgcn_sinf((float)rev);
                float den = lr * lr + li * li;
                float zr = (arm1 * lr + ai * li) / den, zi = (ai * lr - arm1 * li) / den;
                float2* bb = (float2*)(ws + OFF_BBAR);
                for (int c2 = 0; c2 < 16; ++c2) {
                    float br = p.in[15][(size_t)(g * 64 + pp) * 16 + c2], bi = p.in[16][(size_t)(g * 64 + pp) * 16 + c2];
                    bb[(size_t)(g * 64 + pp) * 16 + c2] = make_float2(zr * br - zi * bi, zr * bi + zi * br);
                }
            }
            __syncthreads();
            __syncthreads();
        }
    }
}

DI void row_stats(const float (&v)[16], float& mean, float& rstd) {
    float s = 0.f;
#pragma unroll
    for (int i = 0; i < 16; ++i) s += v[i];
    mean = wsum(s) * (1.f / 1024.f);
    float q = 0.f;
#pragma unroll
    for (int i = 0; i < 16; ++i) { float d = v[i] - mean; q += d * d; }
    rstd = rsqrtf(wsum(q) * (1.f / 1024.f) + 1e-5f);
}

DI void phase1(const Params& p, unsigned char* smem) {
    unsigned char* ws = p.ws;
    int ft_ = threadIdx.x; asm volatile("" : "+v"(ft_));
    const int lane = ft_ & 63, wid = ft_ >> 6;
    const float* mod = (const float*)(ws + OFF_MOD);
    bf16_t* h1 = (bf16_t*)(ws + 1 * U_);
    float4 gw0[16], gw1[16];
#pragma unroll
    for (int i = 0; i < 4; ++i)
#pragma unroll
        for (int e = 0; e < 4; ++e) {
            const float* wp = p.in[4] + (size_t)(i * 256 + lane * 4 + e) * 4616 + 2048;
            gw0[i * 4 + e] = *(const float4*)wp; gw1[i * 4 + e] = *(const float4*)(wp + 4);
        }
    float* ig = (float*)(ws + OFF_IG);
    float* lf = (float*)(ws + OFF_LOGF);
    for (int row0 = (blockIdx.x * 8 + wid) * 4; row0 < T_; row0 += gridDim.x * 32) {
        float vv[4][16];
#pragma unroll
        for (int rr = 0; rr < 4; ++rr)
#pragma unroll
            for (int i = 0; i < 4; ++i) { float4 t = *(const float4*)(p.in[0] + (size_t)(row0 + rr) * 1024 + i * 256 + lane * 4); vv[rr][4 * i] = t.x; vv[rr][4 * i + 1] = t.y; vv[rr][4 * i + 2] = t.z; vv[rr][4 * i + 3] = t.w; }
#pragma unroll
        for (int rr = 0; rr < 4; ++rr) {
            const int row = row0 + rr;
            float mean, rstd; row_stats(vv[rr], mean, rstd);
            const float* mb = mod + (row >> 13) * 6144;
            float ga[8];
#pragma unroll
            for (int j = 0; j < 8; ++j) ga[j] = 0.f;
#pragma unroll
            for (int i = 0; i < 4; ++i) {
                int c = i * 256 + lane * 4;
                float4 sh = *(const float4*)(mb + c), sc = *(const float4*)(mb + 1024 + c);
                f32x4 o;
                o[0] = (vv[rr][4 * i] - mean) * rstd * (1.f + sc.x) + sh.x;
                o[1] = (vv[rr][4 * i + 1] - mean) * rstd * (1.f + sc.y) + sh.y;
                o[2] = (vv[rr][4 * i + 2] - mean) * rstd * (1.f + sc.z) + sh.z;
                o[3] = (vv[rr][4 * i + 3] - mean) * rstd * (1.f + sc.w) + sh.w;
                *(uint2*)(h1 + (size_t)row * 1024 + c) = pk4(o);
#pragma unroll
                for (int e = 0; e < 4; ++e) {
                    const float4 w0 = gw0[i * 4 + e], w1 = gw1[i * 4 + e];
                    ga[0] += o[e] * w0.x; ga[1] += o[e] * w0.y; ga[2] += o[e] * w0.z; ga[3] += o[e] * w0.w;
                    ga[4] += o[e] * w1.x; ga[5] += o[e] * w1.y; ga[6] += o[e] * w1.z; ga[7] += o[e] * w1.w;
                }
            }
#pragma unroll
            for (int j = 0; j < 8; ++j) ga[j] = wsum(ga[j]);
            if (lane < 8) {
                float val = ga[0];
#pragma unroll
                for (int j = 1; j < 8; ++j) val = (lane == j) ? ga[j] : val;
                val += p.in[5][2048 + lane];
                const int b = row >> 13, sidx = row & 8191;
                if (lane < 4) ig[(size_t)(b * 4 + lane) * 8192 + sidx] = val;
                else lf[(size_t)(b * 4 + lane - 4) * 8192 + sidx] = logsig(val);
            }
        }
    }
    const float2* apow = (const float2*)(ws + OFF_APOW);
    const float2* bbar = (const float2*)(ws + OFF_BBAR);
    const float* cre = p.in[17];
    const float* cim = p.in[18];
    const int gtid = blockIdx.x * 512 + fresh_tid(), gstr = gridDim.x * 512;
    bf16_t* emat = (bf16_t*)(ws + OFF_EMAT);
    for (int idx = gtid; idx < 32 * 128 * 128; idx += gstr) {
        const int g = idx >> 14, m = (idx >> 7) & 127, k8 = idx & 127;
        const int pp = m & 63, j = k8 >> 1, c20 = (k8 & 1) * 8;
        const float2 a = apow[((size_t)g * 65 + (63 - j)) * 64 + pp];
        const float4* bp = (const float4*)(bbar + (size_t)(g * 64 + pp) * 16 + c20);
        float o[8];
#pragma unroll
        for (int e = 0; e < 4; ++e) {
            float4 b2 = bp[e];
            o[2 * e] = (m < 64) ? (a.x * b2.x - a.y * b2.y) : (a.x * b2.y + a.y * b2.x);
            o[2 * e + 1] = (m < 64) ? (a.x * b2.z - a.y * b2.w) : (a.x * b2.w + a.y * b2.z);
        }
        *(uint4*)(emat + (size_t)idx * 8) = make_uint4(pk2(o[0], o[1]), pk2(o[2], o[3]), pk2(o[4], o[5]), pk2(o[6], o[7]));
    }
}

struct EpiIn {
    const float* bin; bf16_t *xm, *xmT, *og, *sga, *sgb, *us;
    DI void operator()(const f32x4 (&acc)[2][2][4][2], const pg8::Unit& u, int wr, int wc, int fr, int fq) const {
        const int pn = u.pn;
        int boff, c0, slot;
        if (pn < 4) { boff = 0; c0 = 0; slot = 0; }
        else if (pn < 8) { boff = 1024; c0 = 1024; slot = 0; }
        else if (pn < 10) { boff = 2056; c0 = 2048; slot = 0; }
        else if (pn < 14) { boff = 2568; c0 = 2560; slot = 1; }
        else { boff = 3592; c0 = 3584; slot = 2; }
        const int colb = pn * 256 + wc * 32 + 8 * fq - c0;
        f32x4 bia[2][2];
#pragma unroll
        for (int bj = 0; bj < 2; ++bj) { bia[bj][0] = *(const f32x4*)(bin + boff + colb + bj * 128); bia[bj][1] = *(const f32x4*)(bin + boff + colb + bj * 128 + 4); }
        const int t0 = u.pm * 256 + wr * 64 + fr;
        if (pn < 4) {
#pragma unroll
            for (int i = 0; i < 16; ++i) {
                const int ai = TILE_AI(i), m = TILE_M(i), bj = TILE_BJ(i);
                const int t = t0 + ai * 128 + m * 16, col = colb + bj * 128;
                const f32x4 v0 = acc[ai][bj][m][0] + bia[bj][0], v1 = acc[ai][bj][m][1] + bia[bj][1];
                *(uint4*)(xm + (size_t)t * 1024 + col) = pk8(v0, v1);
                const int b = t >> 13, sidx = t & 8191;
                bf16_t* tp = xmT + ((((size_t)(b * 4 + (col >> 8)) * 128 + (sidx >> 6)) * 256 + (col & 255)) * 64) + (sidx & 63);
#pragma unroll
                for (int r = 0; r < 4; ++r) { *tp = f2bf(v0[r]); tp += 64; asm volatile("" : "+v"(tp)); }
#pragma unroll
                for (int r = 0; r < 4; ++r) { *tp = f2bf(v1[r]); tp += 64; asm volatile("" : "+v"(tp)); }
            }
        } else if (pn == 8 || pn == 9) {
#pragma unroll
            for (int i = 0; i < 16; ++i) {
                const int ai = TILE_AI(i), m = TILE_M(i), bj = TILE_BJ(i);
                const int t = t0 + ai * 128 + m * 16, col = colb + bj * 128;
                *(uint4*)(us + ((((size_t)(col >> 4) * 512 + (t >> 6)) * 64 + (t & 63)) * 16 + (col & 15))) = pk8(acc[ai][bj][m][0] + bia[bj][0], acc[ai][bj][m][1] + bia[bj][1]);
            }
        } else {
            unsigned char* dst = (unsigned char*)og + (size_t)slot * U_;
#pragma unroll
            for (int i = 0; i < 16; ++i) {
                const int ai = TILE_AI(i), m = TILE_M(i), bj = TILE_BJ(i);
                const int t = t0 + ai * 128 + m * 16, col = colb + bj * 128;
                f32x4 v0 = acc[ai][bj][m][0] + bia[bj][0], v1 = acc[ai][bj][m][1] + bia[bj][1];
#pragma unroll
                for (int r = 0; r < 4; ++r) { v0[r] = sigm(v0[r]); v1[r] = sigm(v1[r]); }
                *(uint2*)(dst + (size_t)t * 1024 + col) = make_uint2(pk4u8(v0), pk4u8(v1));
            }
        }
    }
};

DI void s5_tables_late(const Params& p, const int gtid, const int gstr) {
    unsigned char* ws = p.ws;
    const float2* apow = (const float2*)(ws + OFF_APOW);
    const float2* bbar = (const float2*)(ws + OFF_BBAR);
    const float* cre = p.in[17];
    const float* cim = p.in[18];
    bf16_t* kc = (bf16_t*)(ws + OFF_KC);
    for (int idx = gtid; idx < 32 * 64 * 16 * 2; idx += gstr) {
        const int g = idx >> 11, tau = (idx >> 5) & 63, c = (idx >> 1) & 15, c20 = (idx & 1) * 8;
        float sacc[8];
#pragma unroll
        for (int e = 0; e < 8; ++e) sacc[e] = 0.f;
#pragma unroll 4
        for (int pp = 0; pp < 64; ++pp) {
            const float cr = cre[(size_t)(g * 16 + c) * 64 + pp], ci = cim[(size_t)(g * 16 + c) * 64 + pp];
            const float2 a = apow[((size_t)g * 65 + tau) * 64 + pp];
            const float wr_ = cr * a.x - ci * a.y, wi_ = cr * a.y + ci * a.x;
            const float4* bp = (const float4*)(bbar + (size_t)(g * 64 + pp) * 16 + c20);
#pragma unroll
            for (int e = 0; e < 4; ++e) { float4 b2 = bp[e]; sacc[2 * e] += wr_ * b2.x - wi_ * b2.y; sacc[2 * e + 1] += wr_ * b2.z - wi_ * b2.w; }
        }
        *(uint4*)(kc + (((size_t)(g * 64 + tau) * 16 + c) * 16 + c20)) = make_uint4(pk2(sacc[0], sacc[1]), pk2(sacc[2], sacc[3]), pk2(sacc[4], sacc[5]), pk2(sacc[6], sacc[7]));
    }
    bf16_t* cmat = (bf16_t*)(ws + OFF_CMAT);
    for (int idx = gtid; idx < 32 * 1024 * 16; idx += gstr) {
        const int g = idx >> 14, m = (idx >> 4) & 1023, kk0 = (idx & 15) * 8;
        const int t = m >> 4, c = m & 15, p0 = kk0 & 63;
        const float4* crp = (const float4*)(cre + (size_t)(g * 16 + c) * 64 + p0);
        const float4* cip = (const float4*)(cim + (size_t)(g * 16 + c) * 64 + p0);
        float4 cr0 = crp[0], cr1 = crp[1], ci0 = cip[0], ci1 = cip[1];
        const float crv[8] = {cr0.x, cr0.y, cr0.z, cr0.w, cr1.x, cr1.y, cr1.z, cr1.w};
        const float civ[8] = {ci0.x, ci0.y, ci0.z, ci0.w, ci1.x, ci1.y, ci1.z, ci1.w};
        float o[8];
#pragma unroll
        for (int e = 0; e < 8; ++e) {
            const float2 a = apow[((size_t)g * 65 + t + 1) * 64 + p0 + e];
            o[e] = (kk0 < 64) ? (crv[e] * a.x - civ[e] * a.y) : -(crv[e] * a.y + civ[e] * a.x);
        }
        *(uint4*)(cmat + (size_t)idx * 8) = make_uint4(pk2(o[0], o[1]), pk2(o[2], o[3]), pk2(o[4], o[5]), pk2(o[6], o[7]));
    }
}

DI void phase3(const Params& p, unsigned char* smem, const int tid, const int vb, const int nvb) {
    unsigned char* ws = p.ws;
    const bf16_t* us = (const bf16_t*)(ws + 7 * U_);
    const bf16_t* emat = (const bf16_t*)(ws + OFF_EMAT);
    float* ebuf = (float*)((unsigned char*)p.out + (size_t)48 * 1048576);
    const bf16_t* xm = (const bf16_t*)(ws + 2 * U_);
    bf16_t* xc = (bf16_t*)(ws + 1 * U_);
    for (int it = vb; it < 256; it += nvb) {
        const int g = it >> 3, nt = (it >> 1) & 3, kh = it & 1;
        f32x4 acc[4][4];
        auto lb = [=](int r, int k) -> uint4 { return *(const uint4*)(us + ((size_t)g * 512 + nt * 128 + r) * 1024 + kh * 512 + k); };
        gemm_tile(smem, tid, 8, RowMajor{emat + (size_t)g * 128 * 1024 + kh * 512, 1024}, lb, acc);
        epi_loop(acc, tid, [&](const int epi_f, const int epi_t, const f32x4 accv) __attribute__((always_inline)) {
            const int f = epi_f, n = nt * 128 + epi_t;
            *(f32x4*)(ebuf + (size_t)kh * 2097152 + ((size_t)n * 32 + g) * 128 + f) = accv;
        });
    }
    if (blockIdx.x >= 128) s5_tables_late(p, (blockIdx.x - 128) * 512 + fresh_tid(), (gridDim.x - 128) * 512);
    for (int i0 = vb; i0 < 512; i0 += nvb) {
        const int cgp = tid & 127, half = tid >> 7;
        const int t0 = i0 * 64 + half * 32, s0 = t0 & 8191;
        const int c0 = cgp * 8;
        float w[4][8], bb[8];
#pragma unroll
        for (int j = 0; j < 4; ++j)
#pragma unroll
            for (int e = 0; e < 8; ++e) w[j][e] = p.in[6][j * 1024 + c0 + e];
#pragma unroll
        for (int e = 0; e < 8; ++e) bb[e] = p.in[7][c0 + e];
        float r0[8], r1[8], r2[8];
#pragma unroll
        for (int e = 0; e < 8; ++e) { r0[e] = 0.f; r1[e] = 0.f; r2[e] = 0.f; }
        if (s0 > 0) {
            uint4 a = *(const uint4*)(xm + (size_t)(t0 - 3) * 1024 + c0), b = *(const uint4*)(xm + (size_t)(t0 - 2) * 1024 + c0), c = *(const uint4*)(xm + (size_t)(t0 - 1) * 1024 + c0);
            const unsigned* pa = (const unsigned*)&a; const unsigned* pb = (const unsigned*)&b; const unsigned* pc = (const unsigned*)&c;
#pragma unroll
            for (int e = 0; e < 4; ++e) {
                r0[2 * e] = bf2f(pa[e] & 0xffff); r0[2 * e + 1] = bf2f(pa[e] >> 16);
                r1[2 * e] = bf2f(pb[e] & 0xffff); r1[2 * e + 1] = bf2f(pb[e] >> 16);
                r2[2 * e] = bf2f(pc[e] & 0xffff); r2[2 * e + 1] = bf2f(pc[e] >> 16);
            }
        }
        for (int tb = 0; tb < 32; tb += 8) {
            uint4 av[8];
#pragma unroll
            for (int i = 0; i < 8; ++i) av[i] = *(const uint4*)(xm + (size_t)(t0 + tb + i) * 1024 + c0);
#pragma unroll
            for (int i = 0; i < 8; ++i) {
                const unsigned* pa = (const unsigned*)&av[i];
                float cur[8], y[8];
#pragma unroll
                for (int e = 0; e < 4; ++e) { cur[2 * e] = bf2f(pa[e] & 0xffff); cur[2 * e + 1] = bf2f(pa[e] >> 16); }
#pragma unroll
                for (int e = 0; e < 8; ++e) {
                    float z = bb[e] + w[0][e] * r0[e] + w[1][e] * r1[e] + w[2][e] * r2[e] + w[3][e] * cur[e];
                    y[e] = z * sigm(z);
                    r0[e] = r1[e]; r1[e] = r2[e]; r2[e] = cur[e];
                }
                *(uint4*)(xc + (size_t)(t0 + tb + i) * 1024 + c0) = make_uint4(pk2(y[0], y[1]), pk2(y[2], y[3]), pk2(y[4], y[5]), pk2(y[6], y[7]));
            }
        }
    }
    for (int u = vb * 4 + (tid >> 6); u < 2048; u += nvb * 4) {
        const int lane = tid & 63;
        const int bh = u >> 7, c = u & 127;
        const size_t o = (size_t)bh * 8192 + c * 64 + lane;
        float b = ((const float*)(ws + OFF_LOGF))[o];
        float ii = ((const float*)(ws + OFF_IG))[o];
        for (int d = 1; d < 64; d <<= 1) { float t = __shfl_up(b, d, 64); if (lane >= d) b += t; }
        float bl = __shfl(b, 63, 64);
        float g = bl - b + ii;
        for (int o2 = 32; o2 > 0; o2 >>= 1) g = fmaxf(g, __shfl_xor(g, o2, 64));
        ((float*)(ws + OFF_BCUM))[o] = b;
        if (lane == 0) { ((float*)(ws + OFF_AARR))[u] = g; ((float*)(ws + OFF_BLAST))[u] = bl; }
    }
}

DI void phase4_small(const Params& p, unsigned char* smem) {
    unsigned char* ws = p.ws;
    const int tid = fresh_tid();
    const int lane = tid & 63, wid = tid >> 6;
    if (blockIdx.x >= gridDim.x - 2) {
        const int bh = (blockIdx.x - (gridDim.x - 2)) * 8 + wid;
        const float* aa = (const float*)(ws + OFF_AARR) + bh * 128;
        const float* bl = (const float*)(ws + OFF_BLAST) + bh * 128;
        float* ms = (float*)(ws + OFF_MST) + bh * 132;
        const float p0 = bl[2 * lane], q0 = aa[2 * lane], p1 = bl[2 * lane + 1], q1 = aa[2 * lane + 1];
        float P = p0 + p1, Q = fmaxf(q0 + p1, q1);
#pragma unroll
        for (int d = 1; d < 64; d <<= 1) {
            const float Pp = __shfl_up(P, d, 64), Qp = __shfl_up(Q, d, 64);
            if (lane >= d) { Q = fmaxf(Qp + P, Q); P = Pp + P; }
        }
        float Pe = __shfl_up(P, 1, 64), Qe = __shfl_up(Q, 1, 64);
        const float m_even = (lane == 0) ? 0.f : fmaxf(Pe, Qe);
        const float m_odd = fmaxf(m_even + p0, q0);
        ms[2 * lane] = m_even; ms[2 * lane + 1] = m_odd;
        if (lane == 63) ms[128] = fmaxf(P, Q);
    }
    if (blockIdx.x < 128) {
        const int b = blockIdx.x >> 5, g = blockIdx.x & 31, pp = lane, seg = wid;
        const float2 a64 = ((const float2*)(ws + OFF_APOW))[((size_t)g * 65 + 64) * 64 + pp];
        const float* ebuf = (const float*)((unsigned char*)p.out + (size_t)48 * 1048576);
        bf16_t* xcar = (bf16_t*)((unsigned char*)p.out + (size_t)40 * 1048576);
        float2* L = (float2*)smem;
        float erv[16], eiv[16];
#pragma unroll
        for (int i = 0; i < 16; ++i) { size_t o = ((size_t)(b * 128 + seg * 16 + i) * 32 + g) * 128 + pp; erv[i] = ebuf[o] + ebuf[o + 2097152]; eiv[i] = ebuf[o + 64] + ebuf[o + 2097152 + 64]; }
        float xr = 0.f, xi = 0.f;
#pragma unroll
        for (int i = 0; i < 16; ++i) { const float nr = a64.x * xr - a64.y * xi + erv[i], ni = a64.x * xi + a64.y * xr + eiv[i]; xr = nr; xi = ni; }
        L[seg * 64 + pp] = make_float2(xr, xi);
        float ar = a64.x, ai = a64.y;
#pragma unroll
        for (int k = 0; k < 4; ++k) { const float nr = ar * ar - ai * ai, ni = 2.f * ar * ai; ar = nr; ai = ni; }
        __syncthreads();
        xr = 0.f; xi = 0.f;
        for (int s2 = 0; s2 < seg; ++s2) { const float2 l = L[s2 * 64 + pp]; const float nr = ar * xr - ai * xi + l.x, ni = ar * xi + ai * xr + l.y; xr = nr; xi = ni; }
#pragma unroll
        for (int i = 0; i < 16; ++i) {
            size_t o = ((size_t)(b * 128 + seg * 16 + i) * 32 + g) * 128 + pp;
            xcar[o] = f2bf(xr); xcar[o + 64] = f2bf(xi);
            const float nr = a64.x * xr - a64.y * xi + erv[i], ni = a64.x * xi + a64.y * xr + eiv[i]; xr = nr; xi = ni;
        }
        __syncthreads();
    }
}
struct EpiQK {
    bf16_t *q, *k, *kT;
    DI void operator()(const f32x4 (&acc)[2][2][4][2], const pg8::Unit& u, int wr, int wc, int fr, int fq) const {
        const int h = u.pn;
        const int d = wc * 32 + 8 * fq;
        const int t0 = u.pm * 256 + wr * 64 + fr;
        const int b = t0 >> 13, bh = b * 4 + h, s0 = t0 & 8191;
        bf16_t* qp = q + ((size_t)bh * 8192 + s0) * 128 + d;
#pragma unroll
        for (int ai = 0; ai < 2; ++ai)
#pragma unroll
            for (int m = 0; m < 4; ++m) {
                f32x4 q0 = acc[ai][0][m][0] * 0.08838834764831845f, q1 = acc[ai][0][m][1] * 0.08838834764831845f;
                *(uint4*)(qp + (size_t)(ai * 128 + m * 16) * 128) = pk8(q0, q1);
            }
        bf16_t* kp = k + ((size_t)bh * 8192 + s0) * 128 + d;
#pragma unroll
        for (int ai = 0; ai < 2; ++ai)
#pragma unroll
            for (int m = 0; m < 4; ++m) *(uint4*)(kp + (size_t)(ai * 128 + m * 16) * 128) = pk8(acc[ai][1][m][0], acc[ai][1][m][1]);
        bf16_t* tp0 = kT + (((size_t)bh * 128 + (s0 >> 6)) * 128 + d) * 64 + (s0 & 63);
#pragma unroll
        for (int ai = 0; ai < 2; ++ai)
#pragma unroll
            for (int m = 0; m < 4; ++m) {
                bf16_t* tp = tp0 + (size_t)(ai * 2 + (m >> 2)) * 0 + ((ai * 128 + m * 16) >> 6) * (128 * 64) + ((ai * 128 + m * 16) & 63);
                asm volatile("" : "+v"(tp));
#pragma unroll
                for (int r = 0; r < 4; ++r) { *tp = f2bf(acc[ai][1][m][0][r]); tp += 64; asm volatile("" : "+v"(tp)); }
#pragma unroll
                for (int r = 0; r < 4; ++r) { *tp = f2bf(acc[ai][1][m][1][r]); tp += 64; asm volatile("" : "+v"(tp)); }
            }
    }
};

DI void mlstm_u_unit(const Params& p, unsigned char* smem, const int tid, int u) {
    unsigned char* ws = p.ws;
    const int lane = tid & 63, w = tid >> 6;
    const int bh = u >> 7, c = u & 127, b = bh >> 2, h = bh & 3;
    float* wk = (float*)smem;
    const bf16_t* kT = (const bf16_t*)(ws + 7 * U_ + U_ / 2);
    const bf16_t* vT = (const bf16_t*)(ws + 3 * U_);
    bf16_t* UT = (bf16_t*)(ws + 1 * U_);
    bf16x8 vfr[2][8][2];
#pragma unroll
    for (int nh = 0; nh < 2; ++nh)
#pragma unroll
        for (int ni = 0; ni < 8; ++ni) {
            const bf16_t* vr = vT + (((size_t)bh * 128 + c) * 256 + nh * 128 + ni * 16 + (lane & 15)) * 64 + (lane >> 4) * 8;
            vfr[nh][ni][0] = ld16(vr); vfr[nh][ni][1] = ld16(vr + 32);
        }
    if (tid < 64) {
        const size_t o = (size_t)bh * 8192 + c * 64 + tid;
        float bl = ((const float*)(ws + OFF_BLAST))[u];
        float mn = ((const float*)(ws + OFF_MST))[bh * 132 + c + 1];
        wk[tid] = __expf(bl - ((const float*)(ws + OFF_BCUM))[o] + ((const float*)(ws + OFF_IG))[o] - mn);
    }
    __syncthreads();
    {
        const int d = tid >> 1, hf = tid & 1;
        const bf16_t* kr = kT + (((size_t)bh * 128 + c) * 128 + d) * 64 + hf * 32;
        float s = 0.f;
#pragma unroll
        for (int i = 0; i < 4; ++i) {
            uint4 a = *(const uint4*)(kr + i * 8);
            const unsigned* pa = (const unsigned*)&a;
#pragma unroll
            for (int e = 0; e < 4; ++e) { s += bf2f(pa[e] & 0xffff) * wk[hf * 32 + i * 8 + 2 * e] + bf2f(pa[e] >> 16) * wk[hf * 32 + i * 8 + 2 * e + 1]; }
        }
        s += __shfl_xor(s, 1, 64);
        if (hf == 0) ((float*)(ws + OFF_NU))[((size_t)bh * 128 + c) * 128 + d] = s;
    }
    bf16x8 af[2][2];
#pragma unroll
    for (int mi = 0; mi < 2; ++mi)
#pragma unroll
        for (int ks = 0; ks < 2; ++ks) {
            const int j0 = ks * 32 + (lane >> 4) * 8;
            uint4 a = *(const uint4*)(kT + (((size_t)bh * 128 + c) * 128 + 32 * w + 16 * mi + (lane & 15)) * 64 + j0);
            const unsigned* pa = (const unsigned*)&a;
            uint4 o;
            unsigned* po = (unsigned*)&o;
#pragma unroll
            for (int e = 0; e < 4; ++e) po[e] = pk2(bf2f(pa[e] & 0xffff) * wk[j0 + 2 * e], bf2f(pa[e] >> 16) * wk[j0 + 2 * e + 1]);
            af[mi][ks] = __builtin_bit_cast(bf16x8, o);
        }
#pragma unroll
    for (int nh = 0; nh < 2; ++nh) {
        f32x4 acc[2][8];
#pragma unroll
        for (int mi = 0; mi < 2; ++mi)
#pragma unroll
            for (int ni = 0; ni < 8; ++ni) acc[mi][ni] = f32x4{0.f, 0.f, 0.f, 0.f};
#pragma unroll
        for (int ni = 0; ni < 8; ++ni)
#pragma unroll
            for (int ks = 0; ks < 2; ++ks)
#pragma unroll
                for (int mi = 0; mi < 2; ++mi) acc[mi][ni] = mfma16(af[mi][ks], vfr[nh][ni][ks], acc[mi][ni]);
#pragma unroll
        for (int mi = 0; mi < 2; ++mi)
#pragma unroll
            for (int ni = 0; ni < 8; ++ni) {
                const int dv = nh * 128 + ni * 16 + (lane & 15), d = 32 * w + 16 * mi + (lane >> 4) * 4;
                *(uint2*)(UT + (((size_t)bh * 128 + c) * 256 + dv) * 128 + d) = pk4(acc[mi][ni]);
            }
    }
    __syncthreads();
}

DI void phase5(const Params& p, unsigned char* smem, const int tid, const int vb, const int nvb) {
    unsigned char* ws = p.ws;
    const bf16_t* us = (const bf16_t*)(ws + 7 * U_);
    const bf16_t* kc = (const bf16_t*)(ws + OFF_KC);
    const bf16_t* cmat = (const bf16_t*)(ws + OFF_CMAT);
    const bf16_t* xcar = (const bf16_t*)((unsigned char*)p.out + (size_t)40 * 1048576);
    bf16_t* ys = (bf16_t*)p.out;
    const float* dsk = p.in[19];
    for (int it = vb; it < 1024; it += nvb) {
        const int g = it >> 5, mt = (it < 512) ? (7 - ((it >> 2) & 7)) : ((it >> 2) & 7), nt = it & 3;
        const int ktz = 128 * (mt + 1);
        const int nk = 2 * (mt + 1) + 2;
        auto la = [=](int r, int kv) -> uint4 {
            const int m = mt * 128 + r;
            if (kv < ktz) {
                const int t = m >> 4, c = m & 15, j = kv >> 4, c0 = kv & 15;
                if (j > t) return make_uint4(0, 0, 0, 0);
                return *(const uint4*)(kc + (((size_t)(g * 64 + (t - j)) * 16 + c) * 16 + c0));
            }
            return *(const uint4*)(cmat + ((size_t)(g * 1024 + m)) * 128 + (kv - ktz));
        };
        auto lb = [=](int r, int kv) -> uint4 {
            const int n = nt * 128 + r;
            if (kv < ktz) return *(const uint4*)(us + ((size_t)g * 512 + n) * 1024 + kv);
            return *(const uint4*)(xcar + ((size_t)n * 32 + g) * 128 + (kv - ktz));
        };
        f32x4 acc[4][4];
        gemm_tile(smem, tid, nk, la, lb, acc);
        epi_loop(acc, tid, [&](const int epi_f, const int epi_t, const f32x4 accv) __attribute__((always_inline)) {
            const int m = mt * 128 + epi_f, n = nt * 128 + epi_t;
            const int t = m >> 4, c = m & 15;
            const size_t tok = (size_t)n * 64 + t;
            const int ch = g * 16 + c;
            uint2 uu = *(const uint2*)(us + (((size_t)g * 512 + n) * 64 + t) * 16 + c);
            float4 dd = *(const float4*)(dsk + ch);
            f32x4 v = accv;
            v[0] = gelu_t(v[0] + dd.x * bf2f(uu.x & 0xffff));
            v[1] = gelu_t(v[1] + dd.y * bf2f(uu.x >> 16));
            v[2] = gelu_t(v[2] + dd.z * bf2f(uu.y & 0xffff));
            v[3] = gelu_t(v[3] + dd.w * bf2f(uu.y >> 16));
            *(uint2*)(ys + tok * 512 + ch) = pk4(v);
        });
    }
    for (int u = vb; u < 2048; u += nvb) mlstm_u_unit(p, smem, tid, u);
}

DI void phase6_scan(const Params& p) {
    unsigned char* ws = p.ws;
    const int tid = fresh_tid();
    for (int it = blockIdx.x; it < 256; it += gridDim.x) {
        const int e4 = it * 512 + tid;
        const int bh = e4 >> 13;
        const size_t off = (size_t)(e4 & 8191) * 4;
        bf16_t* base = (bf16_t*)(ws + 1 * U_) + (size_t)bh * 128 * 32768 + off;
        const float* bl = (const float*)(ws + OFF_BLAST) + bh * 128;
        const float* ms = (const float*)(ws + OFF_MST) + bh * 132;
        float C[4] = {0.f, 0.f, 0.f, 0.f};
        uint2 nxt[16];
#pragma unroll
        for (int i = 0; i < 16; ++i) nxt[i] = *(const uint2*)(base + (size_t)i * 32768);
        for (int c8 = 0; c8 < 128; c8 += 16) {
            float decv[16];
#pragma unroll
            for (int i = 0; i < 16; ++i) decv[i] = __expf(bl[c8 + i] + ms[c8 + i] - ms[c8 + i + 1]);
#pragma unroll
            for (int i = 0; i < 16; ++i) {
                const int c = c8 + i;
                uint2 v = nxt[i];
                if (c + 16 < 128) nxt[i] = *(const uint2*)(base + (size_t)(c + 16) * 32768);
                *(uint2*)(base + (size_t)c * 32768) = make_uint2(pk2(C[0], C[1]), pk2(C[2], C[3]));
                const float dec = decv[i];
                C[0] = dec * C[0] + bf2f(v.x & 0xffff); C[1] = dec * C[1] + bf2f(v.x >> 16);
                C[2] = dec * C[2] + bf2f(v.y & 0xffff); C[3] = dec * C[3] + bf2f(v.y >> 16);
            }
        }
    }
    if (blockIdx.x >= gridDim.x - 4) {
        const int e = (blockIdx.x - (gridDim.x - 4)) * 512 + tid;
        const int bh = e >> 7, d = e & 127;
        float* nb = (float*)(ws + OFF_NU) + (size_t)bh * 128 * 128 + d;
        const float* bl = (const float*)(ws + OFF_BLAST) + bh * 128;
        const float* ms = (const float*)(ws + OFF_MST) + bh * 132;
        float n = 0.f;
        for (int c0 = 0; c0 < 128; c0 += 16) {
            float vv[16], dd[16];
#pragma unroll
            for (int i = 0; i < 16; ++i) { vv[i] = nb[(c0 + i) * 128]; dd[i] = __expf(bl[c0 + i] + ms[c0 + i] - ms[c0 + i + 1]); }
#pragma unroll
            for (int i = 0; i < 16; ++i) { nb[(c0 + i) * 128] = n; n = dd[i] * n + vv[i]; }
        }
    }
}
struct EpiGlu {
    bf16_t* yb;
    DI void operator()(const f32x4 (&acc)[2][2][4][2], const pg8::Unit& u, int wr, int wc, int fr, int fq) const {
        pg8::epi8(acc, u, wr, wc, fr, fq, [&](int t, int col8, f32x4 v0, f32x4 v1) __attribute__((always_inline)) {
            f32x4 o;
#pragma unroll
            for (int r = 0; r < 4; ++r) o[r] = v0[r] * sigm(v1[r]);
            *(uint2*)(yb + (size_t)t * 1024 + (col8 >> 1)) = pk4(o);
        });
    }
};

DI void mlstm_out_unit(const Params& p, unsigned char* smem, const int tid, int u) {
    unsigned char* ws = p.ws;
    const int lane = tid & 63, w = tid >> 6;
    const int bh = u >> 7, c = u & 127, b = bh >> 2, h = bh & 3;
    float* gk = (float*)smem;
    float* bq = gk + 64;
    float* sci = bq + 64;
    float* emt = sci + 64;
    float* qn = emt + 64;
    float* rden = qn + 64;
    float* part = rden + 64;
    float* mean_s = part + 256;
    float* rstd_s = mean_s + 64;
    uint4* xs = (uint4*)(smem + 4096);
    const bf16_t* q = (const bf16_t*)((unsigned char*)p.out + U_);
    const bf16_t* k = q + (size_t)16 * 8192 * 128;
    const bf16_t* vT = (const bf16_t*)(ws + 3 * U_);
    const bf16_t* CT = (const bf16_t*)(ws + 1 * U_);
    const bf16_t* og = (const bf16_t*)(ws + 4 * U_);
    bf16_t* hm = (bf16_t*)p.out;
    const float mc = ((const float*)(ws + OFF_MST))[bh * 132 + c];
    const size_t tok0 = (size_t)bh * 8192 + c * 64;
    bf16x8 ctf[4][4];
    {
        const bf16_t* ctb0 = CT + (((size_t)bh * 128 + c) * 256 + 64 * w + (lane & 15)) * 128 + (lane >> 4) * 8;
#pragma unroll
        for (int ks = 0; ks < 4; ++ks)
#pragma unroll
            for (int i = 0; i < 4; ++i) ctf[ks][i] = ld16(ctb0 + (size_t)i * 16 * 128 + ks * 32);
    }
    if (w == 0) {
        float bj = ((const float*)(ws + OFF_BCUM))[tok0 + lane], ij = ((const float*)(ws + OFF_IG))[tok0 + lane];
        float g = ij - bj, pm = g;
        for (int d = 1; d < 64; d <<= 1) { float o = __shfl_up(pm, d, 64); if (lane >= d) pm = fmaxf(pm, o); }
        float mt = bj + fmaxf(mc, pm);
        gk[lane] = g; bq[lane] = bj - mt; sci[lane] = __expf(bj + mc - mt); emt[lane] = __expf(-mt);
    }
    {
        const int t = tid >> 2, p4 = tid & 3;
        const bf16_t* qr = q + (tok0 + t) * 128 + p4 * 32;
        const float* nr = (const float*)(ws + OFF_NU) + ((size_t)bh * 128 + c) * 128 + p4 * 32;
        float s = 0.f;
#pragma unroll
        for (int i = 0; i < 4; ++i) {
            uint4 a = *(const uint4*)(qr + i * 8);
            const unsigned* pa = (const unsigned*)&a;
#pragma unroll
            for (int e = 0; e < 4; ++e) s += bf2f(pa[e] & 0xffff) * nr[i * 8 + 2 * e] + bf2f(pa[e] >> 16) * nr[i * 8 + 2 * e + 1];
        }
        s += __shfl_xor(s, 1, 64); s += __shfl_xor(s, 2, 64);
        if (p4 == 0) qn[t] = s;
    }
    __syncthreads();
    {
        f32x4 X[4];
#pragma unroll
        for (int jt = 0; jt < 4; ++jt) X[jt] = f32x4{0.f, 0.f, 0.f, 0.f};
        const bf16_t* qb = q + (tok0 + 16 * w + (lane & 15)) * 128 + (lane >> 4) * 8;
        bf16x8 qf[4];
#pragma unroll
        for (int ks = 0; ks < 4; ++ks) qf[ks] = ld16(qb + ks * 32);
#pragma unroll
        for (int jt = 0; jt < 4; ++jt) {
            if (jt <= w) {
                const bf16_t* kb = k + (tok0 + 16 * jt + (lane & 15)) * 128 + (lane >> 4) * 8;
#pragma unroll
                for (int ks = 0; ks < 4; ++ks) X[jt] = mfma16(ld16(kb + ks * 32), qf[ks], X[jt]);
            }
        }
        const int t = 16 * w + (lane & 15);
        const float bqt = bq[t];
        float dsum = 0.f;
#pragma unroll
        for (int jt = 0; jt < 4; ++jt)
#pragma unroll
            for (int r = 0; r < 4; ++r) {
                const int j = 16 * jt + (lane >> 4) * 4 + r;
                float v = (j <= t) ? X[jt][r] * __expf(bqt + gk[j]) : 0.f;
                X[jt][r] = v; dsum += v;
            }
        dsum += __shfl_xor(dsum, 16, 64); dsum += __shfl_xor(dsum, 32, 64);
        if (lane < 16) { float den = dsum + sci[t] * qn[t]; rden[t] = 1.f / fmaxf(fabsf(den), emt[t]); }
#pragma unroll
        for (int pr = 0; pr < 2; ++pr) {
            uint2 lo = pk4(X[2 * pr]), hi = pk4(X[2 * pr + 1]);
            xs[(w * 2 + pr) * 64 + lane] = make_uint4(lo.x, lo.y, hi.x, hi.y);
        }
    }
    __syncthreads();
    f32x4 acc[4][4];
#pragma unroll
    for (int i = 0; i < 4; ++i)
#pragma unroll
        for (int j = 0; j < 4; ++j) acc[i][j] = f32x4{0.f, 0.f, 0.f, 0.f};
    {
        const bf16_t* qb = q + (tok0 + (lane & 15)) * 128 + (lane >> 4) * 8;
#pragma unroll
        for (int ks = 0; ks < 4; ++ks) {
            bf16x8 bfr[4];
#pragma unroll
            for (int i = 0; i < 4; ++i) bfr[i] = ld16(qb + (size_t)i * 16 * 128 + ks * 32);
#pragma unroll
            for (int i = 0; i < 4; ++i)
#pragma unroll
                for (int j = 0; j < 4; ++j) acc[i][j] = mfma16(ctf[ks][i], bfr[j], acc[i][j]);
        }
    }
#pragma unroll
    for (int ni = 0; ni < 4; ++ni) {
        const float s = sci[16 * ni + (lane & 15)];
#pragma unroll
        for (int mi = 0; mi < 4; ++mi) { acc[mi][ni][0] *= s; acc[mi][ni][1] *= s; acc[mi][ni][2] *= s; acc[mi][ni][3] *= s; }
    }
    {
        const bf16_t* vb = vT + (((size_t)bh * 128 + c) * 256 + 64 * w + (lane & 15)) * 64 + (lane >> 4) * 4;
#pragma unroll
        for (int pr = 0; pr < 2; ++pr) {
            bf16x8 af[4];
#pragma unroll
            for (int mi = 0; mi < 4; ++mi) {
                uint2 lo = *(const uint2*)(vb + (size_t)mi * 16 * 64 + pr * 32);
                uint2 hi = *(const uint2*)(vb + (size_t)mi * 16 * 64 + pr * 32 + 16);
                af[mi] = __builtin_bit_cast(bf16x8, make_uint4(lo.x, lo.y, hi.x, hi.y));
            }
#pragma unroll
            for (int ni = 0; ni < 4; ++ni) {
                if (ni >= 2 * pr) {
                    bf16x8 xb = __builtin_bit_cast(bf16x8, xs[(ni * 2 + pr) * 64 + lane]);
#pragma unroll
                    for (int mi = 0; mi < 4; ++mi) acc[mi][ni] = mfma16(af[mi], xb, acc[mi][ni]);
                }
            }
        }
    }
#pragma unroll
    for (int ni = 0; ni < 4; ++ni) {
        const float rd = rden[16 * ni + (lane & 15)];
        float s = 0.f;
#pragma unroll
        for (int mi = 0; mi < 4; ++mi) { acc[mi][ni][0] *= rd; acc[mi][ni][1] *= rd; acc[mi][ni][2] *= rd; acc[mi][ni][3] *= rd;
            s += acc[mi][ni][0] + acc[mi][ni][1] + acc[mi][ni][2] + acc[mi][ni][3]; }
        s += __shfl_xor(s, 16, 64); s += __shfl_xor(s, 32, 64);
        if (lane < 16) part[w * 64 + 16 * ni + lane] = s;
    }
    __syncthreads();
    if (tid < 64) mean_s[tid] = (part[tid] + part[64 + tid] + part[128 + tid] + part[192 + tid]) * (1.f / 256.f);
    __syncthreads();
#pragma unroll
    for (int ni = 0; ni < 4; ++ni) {
        const float mu = mean_s[16 * ni + (lane & 15)];
        float s = 0.f;
#pragma unroll
        for (int mi = 0; mi < 4; ++mi)
#pragma unroll
            for (int r = 0; r < 4; ++r) { float d = acc[mi][ni][r] - mu; s += d * d; }
        s += __shfl_xor(s, 16, 64); s += __shfl_xor(s, 32, 64);
        if (lane < 16) part[w * 64 + 16 * ni + lane] = s;
    }
    __syncthreads();
    if (tid < 64) rstd_s[tid] = rsqrtf((part[tid] + part[64 + tid] + part[128 + tid] + part[192 + tid]) * (1.f / 256.f) + 1e-5f);
    __syncthreads();
    const float* gain = p.in[10];
    float4 gg[4];
    unsigned ogv[4][4];
#pragma unroll
    for (int mi = 0; mi < 4; ++mi) gg[mi] = *(const float4*)(gain + h * 256 + 64 * w + 16 * mi + (lane >> 4) * 4);
#pragma unroll
    for (int ni = 0; ni < 4; ++ni)
#pragma unroll
        for (int mi = 0; mi < 4; ++mi)
            ogv[ni][mi] = *(const unsigned*)((const unsigned char*)og + ((size_t)b * 8192 + c * 64 + 16 * ni + (lane & 15)) * 1024 + h * 256 + 64 * w + 16 * mi + (lane >> 4) * 4);
#pragma unroll
    for (int ni = 0; ni < 4; ++ni) {
        const int t = 16 * ni + (lane & 15);
        const float mu = mean_s[t], rs = rstd_s[t];
        const size_t tok = (size_t)b * 8192 + c * 64 + t;
#pragma unroll
        for (int mi = 0; mi < 4; ++mi) {
            const int ch = h * 256 + 64 * w + 16 * mi + (lane >> 4) * 4;
            const f32x4 o2 = un4u8(ogv[ni][mi]);
            f32x4 o;
            o[0] = (acc[mi][ni][0] - mu) * rs * gg[mi].x * o2[0];
            o[1] = (acc[mi][ni][1] - mu) * rs * gg[mi].y * o2[1];
            o[2] = (acc[mi][ni][2] - mu) * rs * gg[mi].z * o2[2];
            o[3] = (acc[mi][ni][3] - mu) * rs * gg[mi].w * o2[3];
            *(uint2*)(hm + tok * 1024 + ch) = pk4(o);
        }
    }
    __syncthreads();
}

struct EpiDown {
    const unsigned char *sga, *sgb; const bf16_t* yb; bf16_t* ymix;
    DI void operator()(const f32x4 (&acc)[2][2][4][2], const pg8::Unit& u, int wr, int wc, int fr, int fq) const {
        const size_t o0 = (size_t)(u.pm * 256 + wr * 64 + fr) * 1024 + u.pn * 256 + wc * 32 + 8 * fq;
#define TOFF(i) (o0 + (size_t)(TILE_AI(i) * 128 + TILE_M(i) * 16) * 1024 + TILE_BJ(i) * 128)
        uint2 A[2], B[2]; uint4 Y[2];
        A[0] = *(const uint2*)(sga + TOFF(0)); B[0] = *(const uint2*)(sgb + TOFF(0)); Y[0] = *(const uint4*)(yb + TOFF(0));
#pragma unroll
        for (int i = 0; i < 16; ++i) {
            if (i + 1 < 16) { A[(i + 1) & 1] = *(const uint2*)(sga + TOFF(i + 1)); B[(i + 1) & 1] = *(const uint2*)(sgb + TOFF(i + 1)); Y[(i + 1) & 1] = *(const uint4*)(yb + TOFF(i + 1)); }
            const uint4 y = Y[i & 1];
            const f32x4 a0 = un4u8(A[i & 1].x), a1 = un4u8(A[i & 1].y), b0 = un4u8(B[i & 1].x), b1 = un4u8(B[i & 1].y);
            const f32x4 v0 = acc[TILE_AI(i)][TILE_BJ(i)][TILE_M(i)][0], v1 = acc[TILE_AI(i)][TILE_BJ(i)][TILE_M(i)][1];
            f32x4 r0, r1;
            r0[0] = a0[0] * v0[0] + b0[0] * bf2f(y.x & 0xffff);
            r0[1] = a0[1] * v0[1] + b0[1] * bf2f(y.x >> 16);
            r0[2] = a0[2] * v0[2] + b0[2] * bf2f(y.y & 0xffff);
            r0[3] = a0[3] * v0[3] + b0[3] * bf2f(y.y >> 16);
            r1[0] = a1[0] * v1[0] + b1[0] * bf2f(y.z & 0xffff);
            r1[1] = a1[1] * v1[1] + b1[1] * bf2f(y.z >> 16);
            r1[2] = a1[2] * v1[2] + b1[2] * bf2f(y.w & 0xffff);
            r1[3] = a1[3] * v1[3] + b1[3] * bf2f(y.w >> 16);
            *(uint4*)(ymix + TOFF(i)) = pk8(r0, r1);
        }
    }
};
struct EpiRes {
    const float* res; const float* gmod; bf16_t* dst;
    DI void operator()(const f32x4 (&acc)[2][2][4][2], const pg8::Unit& u, int wr, int wc, int fr, int fq) const {
        const int t0 = u.pm * 256 + wr * 64 + fr, colb = u.pn * 256 + wc * 32 + 8 * fq;
        const size_t o0 = (size_t)t0 * 1024 + colb;
        f32x4 gg[2][2];
#pragma unroll
        for (int bj = 0; bj < 2; ++bj) { const float* gp = gmod + (t0 >> 13) * 6144 + colb + bj * 128; gg[bj][0] = *(const f32x4*)gp + 1.f; gg[bj][1] = *(const f32x4*)(gp + 4) + 1.f; }
        f32x4 X0[2], X1[2];
        X0[0] = *(const f32x4*)(res + TOFF(0)); X1[0] = *(const f32x4*)(res + TOFF(0) + 4);
#pragma unroll
        for (int i = 0; i < 16; ++i) {
            if (i + 1 < 16) { X0[(i + 1) & 1] = *(const f32x4*)(res + TOFF(i + 1)); X1[(i + 1) & 1] = *(const f32x4*)(res + TOFF(i + 1) + 4); }
            const int bj = TILE_BJ(i);
            const f32x4 r0 = X0[i & 1] * ALPHA_ + gg[bj][0] * acc[TILE_AI(i)][bj][TILE_M(i)][0];
            const f32x4 r1 = X1[i & 1] * ALPHA_ + gg[bj][1] * acc[TILE_AI(i)][bj][TILE_M(i)][1];
            *(uint4*)(dst + TOFF(i)) = pk8(r0, r1);
        }
    }
};

struct EpiRes2 {
    const bf16_t* r1; const float2* stats; const float* lg; const float* lb; const float* gmod; bf16_t* dst;
    DI void operator()(const f32x4 (&acc)[2][2][4][2], const pg8::Unit& u, int wr, int wc, int fr, int fq) const {
        const int t0 = u.pm * 256 + wr * 64 + fr, colb = u.pn * 256 + wc * 32 + 8 * fq;
        const size_t o0 = (size_t)t0 * 1024 + colb;
        f32x4 gg[2][2], la[2][2], lbv[2][2];
#pragma unroll
        for (int bj = 0; bj < 2; ++bj) {
            const float* gp = gmod + (t0 >> 13) * 6144 + colb + bj * 128;
            gg[bj][0] = *(const f32x4*)gp + 1.f; gg[bj][1] = *(const f32x4*)(gp + 4) + 1.f;
            la[bj][0] = *(const f32x4*)(lg + colb + bj * 128) * ALPHA_; la[bj][1] = *(const f32x4*)(lg + colb + bj * 128 + 4) * ALPHA_;
            lbv[bj][0] = *(const f32x4*)(lb + colb + bj * 128) * ALPHA_; lbv[bj][1] = *(const f32x4*)(lb + colb + bj * 128 + 4) * ALPHA_;
        }
        float2 st[8];
#pragma unroll
        for (int j = 0; j < 8; ++j) st[j] = stats[t0 + (j >> 2) * 128 + (j & 3) * 16];
        uint4 XR[2];
        XR[0] = *(const uint4*)(r1 + TOFF(0));
#pragma unroll
        for (int i = 0; i < 16; ++i) {
            if (i + 1 < 16) XR[(i + 1) & 1] = *(const uint4*)(r1 + TOFF(i + 1));
            const int bj = TILE_BJ(i);
            const float2 s2 = st[i >> 1];
            const uint4 xr = XR[i & 1];
            const f32x4 X0 = {bf2f(xr.x & 0xffff), bf2f(xr.x >> 16), bf2f(xr.y & 0xffff), bf2f(xr.y >> 16)};
            const f32x4 X1 = {bf2f(xr.z & 0xffff), bf2f(xr.z >> 16), bf2f(xr.w & 0xffff), bf2f(xr.w >> 16)};
            const f32x4 r0 = ((X0 - s2.x) * s2.y) * la[bj][0] + lbv[bj][0] + gg[bj][0] * acc[TILE_AI(i)][bj][TILE_M(i)][0];
            const f32x4 r1v = ((X1 - s2.x) * s2.y) * la[bj][1] + lbv[bj][1] + gg[bj][1] * acc[TILE_AI(i)][bj][TILE_M(i)][1];
            *(uint4*)(dst + TOFF(i)) = pk8(r0, r1v);
        }
    }
};
#undef TOFF

DI void phase10(const Params& p) {
    unsigned char* ws = p.ws;
    int ft_ = threadIdx.x; asm volatile("" : "+v"(ft_));
    const int lane = ft_ & 63, wid = ft_ >> 6;
    const float* mod = (const float*)(ws + OFF_MOD);
    const bf16_t* r1 = (const bf16_t*)(ws + 2 * U_);
    float2* stats = (float2*)(ws + OFF_STATS);
    bf16_t* h2 = (bf16_t*)(ws + 1 * U_);
    for (int row0 = (blockIdx.x * 8 + wid) * 4; row0 < T_; row0 += gridDim.x * 32) {
        float v[4][16];
#pragma unroll
        for (int rr = 0; rr < 4; ++rr)
#pragma unroll
            for (int i = 0; i < 4; ++i) { uint2 t = *(const uint2*)(r1 + (size_t)(row0 + rr) * 1024 + i * 256 + lane * 4); v[rr][4 * i] = bf2f(t.x & 0xffff); v[rr][4 * i + 1] = bf2f(t.x >> 16); v[rr][4 * i + 2] = bf2f(t.y & 0xffff); v[rr][4 * i + 3] = bf2f(t.y >> 16); }
#pragma unroll
        for (int rr = 0; rr < 4; ++rr) {
            const int row = row0 + rr;
            float mean, rstd; row_stats(v[rr], mean, rstd);
            if (lane == 0) stats[row] = make_float2(mean, rstd);
#pragma unroll
            for (int i = 0; i < 4; ++i) {
                int c = i * 256 + lane * 4;
                float4 g = *(const float4*)(p.in[22] + c), bb = *(const float4*)(p.in[23] + c);
                v[rr][4 * i] = (v[rr][4 * i] - mean) * rstd * g.x + bb.x;
                v[rr][4 * i + 1] = (v[rr][4 * i + 1] - mean) * rstd * g.y + bb.y;
                v[rr][4 * i + 2] = (v[rr][4 * i + 2] - mean) * rstd * g.z + bb.z;
                v[rr][4 * i + 3] = (v[rr][4 * i + 3] - mean) * rstd * g.w + bb.w;
            }
            row_stats(v[rr], mean, rstd);
            const float* mb = mod + (row >> 13) * 6144;
#pragma unroll
            for (int i = 0; i < 4; ++i) {
                int c = i * 256 + lane * 4;
                float4 sh = *(const float4*)(mb + 3072 + c), sc = *(const float4*)(mb + 4096 + c);
                f32x4 o;
                o[0] = (v[rr][4 * i] - mean) * rstd * (1.f + sc.x) + sh.x;
                o[1] = (v[rr][4 * i + 1] - mean) * rstd * (1.f + sc.y) + sh.y;
                o[2] = (v[rr][4 * i + 2] - mean) * rstd * (1.f + sc.z) + sh.z;
                o[3] = (v[rr][4 * i + 3] - mean) * rstd * (1.f + sc.w) + sh.w;
                *(uint2*)(h2 + (size_t)row * 1024 + c) = pk4(o);
            }
        }
    }
}

constexpr size_t HALO_ELEMS = (size_t)512 * 2 * FH;
struct EpiUpF {
    bf16_t* hid; const float* cw; const float* cb; float* glast; float* gfirst; float* vfirst;
    DI void operator()(const f32x4 (&acc)[2][2][4][2], const pg8::Unit& u, int wr, int wc, int fr, int fq) const {
        const int lane = fq * 16 + fr;
        const int src1 = (lane & 48) | ((fr + 15) & 15), src2 = (lane & 48) | ((fr + 14) & 15);
        float4 w0v[2], w1v[2], w2v[2], bbv[2];
#pragma unroll
        for (int bj = 0; bj < 2; ++bj) {
            const int hc = (u.pn * 256 + bj * 128 + wc * 32 + 8 * fq) >> 1;
            w0v[bj] = *(const float4*)(cw + hc); w1v[bj] = *(const float4*)(cw + FH + hc); w2v[bj] = *(const float4*)(cw + 2 * FH + hc); bbv[bj] = *(const float4*)(cb + hc);
        }
#pragma unroll
        for (int bj = 0; bj < 2; ++bj) {
            const int hc = (u.pn * 256 + bj * 128 + wc * 32 + 8 * fq) >> 1;
            const float4 w0 = w0v[bj], w1 = w1v[bj], w2 = w2v[bj], bb = bbv[bj];
#pragma unroll
            for (int ai = 0; ai < 2; ++ai) {
                f32x4 gprev = (f32x4){0.f, 0.f, 0.f, 0.f};
#pragma unroll
                for (int m = 0; m < 4; ++m) {
                    const f32x4 v = acc[ai][bj][m][0], g = acc[ai][bj][m][1];
                    f32x4 p1, p2;
#pragma unroll
                    for (int r = 0; r < 4; ++r) {
                        p1[r] = __builtin_bit_cast(float, __builtin_amdgcn_update_dpp(0, __builtin_bit_cast(int, (fr == 15) ? gprev[r] : g[r]), 0x121, 0xF, 0xF, false));
                        p2[r] = __builtin_bit_cast(float, __builtin_amdgcn_update_dpp(0, __builtin_bit_cast(int, (fr >= 14) ? gprev[r] : g[r]), 0x122, 0xF, 0xF, false));
                    }
                    const int row = u.pm * 256 + ai * 128 + wr * 64 + m * 16 + fr;
                    const int wb = row >> 6;
                    if (m == 0 && fr < 2) {
                        *(f32x4*)(gfirst + ((size_t)wb * 2 + fr) * FH + hc) = g;
                        *(f32x4*)(vfirst + ((size_t)wb * 2 + fr) * FH + hc) = v;
                    } else {
                        f32x4 o;
                        o[0] = gelu_t(bb.x + w0.x * p2[0] + w1.x * p1[0] + w2.x * g[0]) * v[0];
                        o[1] = gelu_t(bb.y + w0.y * p2[1] + w1.y * p1[1] + w2.y * g[1]) * v[1];
                        o[2] = gelu_t(bb.z + w0.z * p2[2] + w1.z * p1[2] + w2.z * g[2]) * v[2];
                        o[3] = gelu_t(bb.w + w0.w * p2[3] + w1.w * p1[3] + w2.w * g[3]) * v[3];
                        *(uint2*)(hid + (size_t)row * FH + hc) = pk4(o);
                    }
                    if (m == 3 && fr >= 14) *(f32x4*)(glast + ((size_t)wb * 2 + (fr - 14)) * FH + hc) = g;
                    gprev = g;
                }
            }
        }
    }
};

DI void phase12(const Params& p) {
    bf16_t* hid = (bf16_t*)(p.ws + 4 * U_);
    const float* glast = p.out;
    const float* gfirst = p.out + HALO_ELEMS;
    const float* vfirst = p.out + 2 * HALO_ELEMS;
    const float* cw = p.in[25];
    const float* cb = p.in[26];
    const int gtid = blockIdx.x * 512 + fresh_tid(), gstr = gridDim.x * 512;
    for (int idx = gtid; idx < 512 * 2 * (FH / 4); idx += gstr) {
        const int cgp = idx % (FH / 4), rr = (idx / (FH / 4)) & 1, wb = idx / (2 * (FH / 4));
        const int hc = cgp * 4;
        const bool seq_start = (wb & 127) == 0;
        const int pb = seq_start ? wb : wb - 1;
        const float pz = seq_start ? 0.f : 1.f;
        float4 la = *(const float4*)(glast + ((size_t)pb * 2 + 0) * FH + hc), lb = *(const float4*)(glast + ((size_t)pb * 2 + 1) * FH + hc);
        la.x *= pz; la.y *= pz; la.z *= pz; la.w *= pz; lb.x *= pz; lb.y *= pz; lb.z *= pz; lb.w *= pz;
        const float4 f0 = *(const float4*)(gfirst + ((size_t)wb * 2 + 0) * FH + hc), f1 = *(const float4*)(gfirst + ((size_t)wb * 2 + 1) * FH + hc);
        float4 gm2, gm1, g0;
        if (rr == 0) { gm2 = la; gm1 = lb; g0 = f0; } else { gm2 = lb; gm1 = f0; g0 = f1; }
        const float4 v = *(const float4*)(vfirst + ((size_t)wb * 2 + rr) * FH + hc);
        const float4 w0 = *(const float4*)(cw + hc), w1 = *(const float4*)(cw + FH + hc), w2 = *(const float4*)(cw + 2 * FH + hc), bb = *(const float4*)(cb + hc);
        f32x4 o;
        o[0] = gelu_t(bb.x + w0.x * gm2.x + w1.x * gm1.x + w2.x * g0.x) * v.x;
        o[1] = gelu_t(bb.y + w0.y * gm2.y + w1.y * gm1.y + w2.y * g0.y) * v.y;
        o[2] = gelu_t(bb.z + w0.z * gm2.z + w1.z * gm1.z + w2.z * g0.z) * v.z;
        o[3] = gelu_t(bb.w + w0.w * gm2.w + w1.w * gm1.w + w2.w * g0.w) * v.w;
        *(uint2*)(hid + ((size_t)wb * 64 + rr) * FH + hc) = pk4(o);
    }
}

DI void phase14(const Params& p) {
    int ft_ = threadIdx.x; asm volatile("" : "+v"(ft_));
    const int lane = ft_ & 63, wid = ft_ >> 6;
    for (int row0 = (blockIdx.x * 8 + wid) * 4; row0 < T_; row0 += gridDim.x * 32) {
        float v[4][16];
#pragma unroll
        for (int rr = 0; rr < 4; ++rr)
#pragma unroll
            for (int i = 0; i < 4; ++i) { uint2 t = *(const uint2*)((const bf16_t*)(p.ws + 1 * U_) + (size_t)(row0 + rr) * 1024 + i * 256 + lane * 4); v[rr][4 * i] = bf2f(t.x & 0xffff); v[rr][4 * i + 1] = bf2f(t.x >> 16); v[rr][4 * i + 2] = bf2f(t.y & 0xffff); v[rr][4 * i + 3] = bf2f(t.y >> 16); }
#pragma unroll
        for (int rr = 0; rr < 4; ++rr) {
            float* xr = p.out + (size_t)(row0 + rr) * 1024;
            float mean, rstd; row_stats(v[rr], mean, rstd);
#pragma unroll
            for (int i = 0; i < 4; ++i) {
                int c = i * 256 + lane * 4;
                float4 g = *(const float4*)(p.in[28] + c), bb = *(const float4*)(p.in[29] + c);
                *(float4*)(xr + c) = make_float4((v[rr][4 * i] - mean) * rstd * g.x + bb.x, (v[rr][4 * i + 1] - mean) * rstd * g.y + bb.y,
                                                 (v[rr][4 * i + 2] - mean) * rstd * g.z + bb.z, (v[rr][4 * i + 3] - mean) * rstd * g.w + bb.w);
            }
        }
    }
}

#define XB_TMO      128
#define XB_XCNT(j)  (256  + 64 * (j))
#define XB_XSUB(j)  (1280 + 64 * (j))
#define XB_XGEN(j)  (2304 + 64 * (j))
#define XB_TOP      3328
#define XB_TOPGEN   3392
#define XB_SPIN_CAP (1u << 22)
DI unsigned xb_ld(unsigned* p)              { return __hip_atomic_load(p, __ATOMIC_RELAXED, __HIP_MEMORY_SCOPE_AGENT); }
DI unsigned xb_add(unsigned* p, unsigned v) { return __hip_atomic_fetch_add(p, v, __ATOMIC_RELAXED, __HIP_MEMORY_SCOPE_AGENT); }
DI unsigned xb_xcc_id() { return (unsigned)__builtin_amdgcn_s_getreg((3 << 11) | 20) & 0xFu; }
#define XB_SPIN(cond, bar) do { unsigned _sp = 0; while (cond) { __builtin_amdgcn_s_sleep(1); \
    if ((++_sp & 255u) == 0u) { if (xb_ld(&(bar)[XB_TMO])) break; if (_sp > XB_SPIN_CAP) { atomicAdd(&(bar)[XB_TMO], 1u); break; } } } } while (0)
DI void xcd_barrier_complete(unsigned* bar, unsigned x, unsigned& nloc, unsigned& nx) {
    const unsigned G = gridDim.x;
    unsigned sum, cnt, mine, sp = 0u;
    for (;;) {
        sum = 0u; cnt = 0u; mine = 0u;
#pragma unroll
        for (unsigned j = 0; j < 16; ++j) { const unsigned c = xb_ld(&bar[XB_XCNT(j)]); sum += c; cnt += (c > 0u) ? 1u : 0u; mine = (j == x) ? c : mine; }
        if (sum == G) break;
        __builtin_amdgcn_s_sleep(1);
        if ((++sp & 255u) == 0u) { if (xb_ld(&bar[XB_TMO])) break; if (sp > XB_SPIN_CAP) { atomicAdd(&bar[XB_TMO], 1u); break; } }
    }
    nloc = mine > 0u ? mine : 1u; nx = cnt > 0u ? cnt : 1u;
}
DI void xcd_barrier(unsigned* bar, volatile __attribute__((address_space(3))) unsigned* st) {
    asm volatile("s_waitcnt vmcnt(0)" ::: "memory");
    __syncthreads();
    if (fresh_tid() == 0) {
        __builtin_amdgcn_s_waitcnt(0);
        const unsigned x = xb_xcc_id();
        unsigned nloc = st[0], nx = st[1];
        if (nloc == 0u) { xcd_barrier_complete(bar, x, nloc, nx); st[0] = nloc; st[1] = nx; }
        const unsigned old = xb_add(&bar[XB_XSUB(x)], 1u);
        const unsigned gen = old / nloc;
        if (old + 1u == (gen + 1u) * nloc) {
            __builtin_amdgcn_fence(__ATOMIC_RELEASE, "agent");
            asm volatile("s_waitcnt vmcnt(0)" ::: "memory");
            const unsigned og = xb_add(&bar[XB_TOP], 1u);
            const unsigned tg = og / nx;
            if (og + 1u == (tg + 1u) * nx) xb_add(&bar[XB_TOPGEN], 1u);
            else XB_SPIN(xb_ld(&bar[XB_TOPGEN]) == tg, bar);
            __builtin_amdgcn_fence(__ATOMIC_ACQUIRE, "agent");
            xb_add(&bar[XB_XGEN(x)], 1u);
            asm volatile("s_waitcnt vmcnt(0)" ::: "memory");
        } else {
            XB_SPIN(xb_ld(&bar[XB_XGEN(x)]) == gen, bar);
            __builtin_amdgcn_fence(__ATOMIC_ACQUIRE, "agent");
            asm volatile("s_waitcnt vmcnt(0)" ::: "memory");
        }
    }
    __syncthreads();
}

constexpr int LDS_BYTES = 131072;
__global__ void __launch_bounds__(512, 2) fwd_megakernel(Params p) {
    extern __shared__ __attribute__((aligned(16))) unsigned char lds[];
    cg::grid_group grid = cg::this_grid();
    unsigned* bar = (unsigned*)(p.ws + OFF_BAR);
    __shared__ __attribute__((aligned(16))) unsigned xb_st[4];
    volatile __attribute__((address_space(3))) unsigned* st = (volatile __attribute__((address_space(3))) unsigned*)xb_st;
    if (threadIdx.x < 4) xb_st[threadIdx.x] = 0u;
    __syncthreads();
    if (threadIdx.x == 0) (void)xb_add(&bar[XB_XCNT(xb_xcc_id())], 1u);
#define GSYNC() xcd_barrier(bar, st)
#define HALF_CTX int ft_ = threadIdx.x; asm volatile("" : "+v"(ft_)); const int half = ft_ >> 8, vtid = ft_ & 255; \
    const int vb = blockIdx.x * 2 + half, nvb = gridDim.x * 2; unsigned char* hsm = lds + half * 65536;
    PG8_LAS unsigned char* glds = (PG8_LAS unsigned char*)lds;
    unsigned char* ws = p.ws;
    pg8::StaticOrder S;
    if (p.out == nullptr) grid.sync();
    { HALF_CTX phase0(p, hsm, vtid, vb, nvb); }
    GSYNC();
    phase1(p, lds);
    GSYNC();
    {
        pg8::Gemm g{(const bf16_t*)(ws + 1 * U_), (const bf16_t*)(ws + OFF_WIN), 1024, 1024, 1024, 0};
        S.init(T_, 4608, gridDim.x, blockIdx.x);
        EpiIn E{p.in[5], (bf16_t*)(ws + 2 * U_), (bf16_t*)(ws + 3 * U_), (bf16_t*)(ws + 4 * U_), (bf16_t*)(ws + 5 * U_), (bf16_t*)(ws + 6 * U_), (bf16_t*)(ws + 7 * U_)};
        pg8::gemm_phase(glds, g, S, E);
    }
    GSYNC();
    { HALF_CTX phase3(p, hsm, vtid, vb, nvb); }
    GSYNC();
    phase4_small(p, lds);
    {
        bf16_t* q = (bf16_t*)((unsigned char*)p.out + U_);
        pg8::Gemm g{(const bf16_t*)(ws + 1 * U_), (const bf16_t*)(ws + OFF_WQK), 1024, 256, 256, 512};
        S.init(T_, 1024, gridDim.x, blockIdx.x);
        EpiQK E{q, q + (size_t)16 * 8192 * 128, (bf16_t*)(ws + 7 * U_ + U_ / 2)};
        pg8::gemm_phase(glds, g, S, E);
    }
    GSYNC();
    { HALF_CTX phase5(p, hsm, vtid, vb, nvb); }
    GSYNC();
    phase6_scan(p);
    {
        pg8::Gemm g{(const bf16_t*)p.out, (const bf16_t*)(ws + OFF_WGL), 512, 512, 512, 0};
        S.init(T_, 2048, gridDim.x, blockIdx.x);
        EpiGlu E{(bf16_t*)(ws + 7 * U_)};
        pg8::gemm_phase(glds, g, S, E);
    }
    GSYNC();
    { HALF_CTX for (int u = vb; u < 2048; u += nvb) mlstm_out_unit(p, hsm, vtid, u); }
    GSYNC();
    {
        pg8::Gemm g{(const bf16_t*)p.out, (const bf16_t*)(ws + OFF_WDN), 1024, 1024, 1024, 0};
        S.init(T_, 1024, gridDim.x, blockIdx.x);
        EpiDown E{(const unsigned char*)(ws + 5 * U_), (const unsigned char*)(ws + 6 * U_), (const bf16_t*)(ws + 7 * U_), (bf16_t*)(ws + 1 * U_)};
        pg8::gemm_phase(glds, g, S, E);
    }
    GSYNC();
    {
        pg8::Gemm g{(const bf16_t*)(ws + 1 * U_), (const bf16_t*)(ws + OFF_WMX), 1024, 1024, 1024, 0};
        S.init(T_, 1024, gridDim.x, blockIdx.x);
        EpiRes E{p.in[0], (const float*)(ws + OFF_MOD) + 2048, (bf16_t*)(ws + 2 * U_)};
        pg8::gemm_phase(glds, g, S, E);
    }
    GSYNC();
    phase10(p);
    GSYNC();
    {
        pg8::Gemm g{(const bf16_t*)(ws + 1 * U_), (const bf16_t*)(ws + OFF_WUP), 1024, 1024, 1024, 0};
        S.init(T_, 5632, gridDim.x, blockIdx.x);
        EpiUpF E{(bf16_t*)(ws + 4 * U_), p.in[25], p.in[26], p.out, p.out + HALO_ELEMS, p.out + 2 * HALO_ELEMS};
        pg8::gemm_phase(glds, g, S, E);
    }
    GSYNC();
    phase12(p);
    GSYNC();
    {
        pg8::Gemm g{(const bf16_t*)(ws + 4 * U_), (const bf16_t*)(ws + OFF_WFD), FH, FH, FH, 0};
        S.init(T_, 1024, gridDim.x, blockIdx.x);
        EpiRes2 E{(const bf16_t*)(ws + 2 * U_), (const float2*)(ws + OFF_STATS), p.in[22], p.in[23], (const float*)(ws + OFF_MOD) + 5120, (bf16_t*)(ws + 1 * U_)};
        pg8::gemm_phase(glds, g, S, E);
    }
    GSYNC();
    phase14(p);
}

extern "C" void kernel_launch(void* const* d_in, const int* in_sizes, int n_in, void* d_out, int out_size, void* d_ws, size_t ws_size, hipStream_t stream) {
    static int grid_blocks = 0;
    if (grid_blocks == 0) {
        if (n_in != 30 || out_size != T_ * 1024 || ws_size < 8 * U_) { fprintf(stderr, "kernel_launch: unexpected shapes (n_in %d out %d ws %zu)\n", n_in, out_size, ws_size); grid_blocks = -1; return; }
        int dev = 0, cus = 0, per_cu = 0;
        (void)hipGetDevice(&dev);
        (void)hipDeviceGetAttribute(&cus, hipDeviceAttributeMultiprocessorCount, dev);
        if (hipFuncSetAttribute((const void*)fwd_megakernel, hipFuncAttributeMaxDynamicSharedMemorySize, LDS_BYTES) != hipSuccess) { fprintf(stderr, "hipFuncSetAttribute failed\n"); grid_blocks = -1; return; }
        (void)hipOccupancyMaxActiveBlocksPerMultiprocessor(&per_cu, fwd_megakernel, 512, LDS_BYTES);
        if (per_cu < 1) { fprintf(stderr, "occupancy query says 0 blocks/CU\n"); per_cu = 1; }
        grid_blocks = cus;
    }
    if (grid_blocks < 0) return;
    Params p{};
    for (int i = 0; i < 30; ++i) p.in[i] = (const float*)d_in[i];
    p.out = (float*)d_out;
    p.ws = (unsigned char*)d_ws;
    if (hipMemsetAsync((unsigned char*)d_ws + OFF_BAR, 0, 16384, stream) != hipSuccess) { fprintf(stderr, "memset failed\n"); return; }
    void* args[] = {&p};
    hipError_t e = hipLaunchCooperativeKernel((const void*)fwd_megakernel, dim3(grid_blocks), dim3(512), args, LDS_BYTES, stream);
    if (e != hipSuccess) fprintf(stderr, "cooperative launch failed: %s (grid %d)\n", hipGetErrorString(e), grid_blocks);
}
```

```cpp
#include <hip/hip_runtime.h>
#include <hip/hip_cooperative_groups.h>
#include <cstdio>
#include <cstdint>
namespace cg = cooperative_groups;

#define DI __device__ __forceinline__
typedef unsigned short bf16_t;
typedef short bf16x8 __attribute__((ext_vector_type(8)));
typedef float f32x4 __attribute__((ext_vector_type(4)));

constexpr int T_ = 32768, S_ = 8192, FH = 2816;
constexpr size_t U_ = 67108864;
constexpr float ALPHA_ = 1.189207115002721f;

constexpr size_t OFF_WIN = 0;
constexpr size_t OFF_WQK = OFF_WIN + 9437184;
constexpr size_t OFF_WDN = OFF_WQK + 524288;
constexpr size_t OFF_WGL = OFF_WDN + 2097152;
constexpr size_t OFF_WMX = OFF_WGL + 2097152;
constexpr size_t OFF_WUP = OFF_WMX + 2097152;
constexpr size_t OFF_WFD = OFF_WUP + 11534336;
constexpr size_t OFF_MOD = OFF_WFD + 5767168;
constexpr size_t OFF_APOW = OFF_MOD + 98304;
constexpr size_t OFF_BBAR = OFF_APOW + 1064960;
constexpr size_t OFF_KC = OFF_BBAR + 262144;
constexpr size_t OFF_EMAT = OFF_KC + 1048576;
constexpr size_t OFF_CMAT = OFF_EMAT + 8388608;
constexpr size_t OFF_IG = OFF_CMAT + 8388608;
constexpr size_t OFF_LOGF = OFF_IG + 524288;
constexpr size_t OFF_BCUM = OFF_LOGF + 524288;
constexpr size_t OFF_AARR = OFF_BCUM + 524288;
constexpr size_t OFF_BLAST = OFF_AARR + 8192;
constexpr size_t OFF_MST = OFF_BLAST + 8192;
constexpr size_t OFF_NU = OFF_MST + 8448;
constexpr size_t OFF_BAR = OFF_NU + 1048576;
constexpr size_t OFF_STATS = OFF_BAR + 16384;
constexpr size_t OFF_END = OFF_STATS + 262144;
static_assert(OFF_END <= U_, "R0 overflow");

struct Params { const float* in[30]; float* out; unsigned char* ws; };

DI float bf2f(unsigned short h) { return __uint_as_float(((unsigned)h) << 16); }
typedef __bf16 bf16x2_t __attribute__((ext_vector_type(2)));
typedef float f32x2_t __attribute__((ext_vector_type(2)));
DI unsigned pk2(float lo, float hi) { f32x2_t v = {lo, hi}; bf16x2_t b = __builtin_convertvector(v, bf16x2_t); return __builtin_bit_cast(unsigned, b); }
DI unsigned short f2bf(float x) { return (unsigned short)(pk2(x, 0.f) & 0xffffu); }
DI uint2 pk4(f32x4 v) { return make_uint2(pk2(v[0], v[1]), pk2(v[2], v[3])); }
DI float sigm(float x) { return __builtin_amdgcn_rcpf(1.f + __expf(-x)); }
DI float gelu_t(float x) { float u = 1.5957691216057308f * (x + 0.044715f * x * x * x); return x * __builtin_amdgcn_rcpf(1.f + __expf(-u)); }
DI float logsig(float x) { return (x < 0.f) ? (x - log1pf(__expf(x))) : (-log1pf(__expf(-x))); }
DI bf16x8 ld16(const bf16_t* p) { return *reinterpret_cast<const bf16x8*>(p); }
DI f32x4 mfma16(bf16x8 a, bf16x8 b, f32x4 c) { return __builtin_amdgcn_mfma_f32_16x16x32_bf16(a, b, c, 0, 0, 0); }
DI int fresh_tid() { int t = threadIdx.x; asm volatile("" : "+v"(t)); return t; }
DI float dpp_f(float v, const int ctrl_sel) {
    int x = __builtin_bit_cast(int, v), r;
    if (ctrl_sel == 0) r = __builtin_amdgcn_update_dpp(0, x, 0xB1, 0xF, 0xF, false);
    else if (ctrl_sel == 1) r = __builtin_amdgcn_update_dpp(0, x, 0x4E, 0xF, 0xF, false);
    else if (ctrl_sel == 2) r = __builtin_amdgcn_update_dpp(0, x, 0x141, 0xF, 0xF, false);
    else r = __builtin_amdgcn_update_dpp(0, x, 0x140, 0xF, 0xF, false);
    return __builtin_bit_cast(float, r);
}
DI float wsum(float v) {
    v += dpp_f(v, 0); v += dpp_f(v, 1); v += dpp_f(v, 2); v += dpp_f(v, 3);
    const int x = __builtin_bit_cast(int, v);
    return __builtin_bit_cast(float, __builtin_amdgcn_readlane(x, 0)) + __builtin_bit_cast(float, __builtin_amdgcn_readlane(x, 16))
         + __builtin_bit_cast(float, __builtin_amdgcn_readlane(x, 32)) + __builtin_bit_cast(float, __builtin_amdgcn_readlane(x, 48));
}

template <class LA, class LB>
DI void gemm_tile(unsigned char* smem, const int tid, int nk, LA la, LB lb, f32x4 (&acc)[4][4]) {
    const int lane = tid & 63, wid = tid >> 6;
    const int wf = wid >> 1, wt = wid & 1;
    const int lr = tid >> 3, lc = tid & 7;
    unsigned char* sA = smem;
    unsigned char* sB = smem + 32768;
#pragma unroll
    for (int i = 0; i < 4; ++i)
#pragma unroll
        for (int j = 0; j < 4; ++j) acc[i][j] = f32x4{0.f, 0.f, 0.f, 0.f};
    uint4 ra[4], rb[4], na[4], nb[4];
#pragma unroll
    for (int i = 0; i < 4; ++i) { ra[i] = la(lr + 32 * i, lc * 8); rb[i] = lb(lr + 32 * i, lc * 8); }
    if (nk > 1) {
#pragma unroll
        for (int i = 0; i < 4; ++i) { na[i] = la(lr + 32 * i, 64 + lc * 8); nb[i] = lb(lr + 32 * i, 64 + lc * 8); }
    }
    const int woff = lr * 128 + ((lc ^ ((lr >> 1) & 7)) << 4);
#pragma unroll
    for (int i = 0; i < 4; ++i) { *(uint4*)(sA + woff + i * 4096) = ra[i]; *(uint4*)(sB + woff + i * 4096) = rb[i]; }
    __syncthreads();
    const int frow = lane & 15, fq = lane >> 4, fsw = (frow >> 1) & 7;
    for (int kt = 0; kt < nk; ++kt) {
        const int cur = kt & 1;
#pragma unroll
        for (int i = 0; i < 4; ++i) { ra[i] = na[i]; rb[i] = nb[i]; }
        if (kt + 2 < nk) {
#pragma unroll
            for (int i = 0; i < 4; ++i) { na[i] = la(lr + 32 * i, (kt + 2) * 64 + lc * 8); nb[i] = lb(lr + 32 * i, (kt + 2) * 64 + lc * 8); }
        }
        const unsigned char* cA = sA + cur * 16384 + (wf * 64 + frow) * 128;
        const unsigned char* cB = sB + cur * 16384 + (wt * 64 + frow) * 128;
#pragma unroll
        for (int ks = 0; ks < 2; ++ks) {
            const int ch = ((ks * 4 + fq) ^ fsw) << 4;
            bf16x8 af[4], bfr[4];
#pragma unroll
            for (int i = 0; i < 4; ++i) { af[i] = *(const bf16x8*)(cA + i * 2048 + ch); bfr[i] = *(const bf16x8*)(cB + i * 2048 + ch); }
#pragma unroll
            for (int i = 0; i < 4; ++i)
#pragma unroll
                for (int j = 0; j < 4; ++j) acc[i][j] = mfma16(af[i], bfr[j], acc[i][j]);
        }
        if (kt + 1 < nk) {
            const int nbuf = (cur ^ 1) * 16384;
#pragma unroll
            for (int i = 0; i < 4; ++i) { *(uint4*)(sA + nbuf + woff + i * 4096) = ra[i]; *(uint4*)(sB + nbuf + woff + i * 4096) = rb[i]; }
        }
        __syncthreads();
    }
}
template <class F>
DI void epi_loop(f32x4 (&acc)[4][4], const int vtid_, F f) {
    const int lane_ = vtid_ & 63, wid_ = vtid_ >> 6, wf_ = wid_ >> 1, wt_ = wid_ & 1;
#pragma unroll
    for (int fi = 0; fi < 4; ++fi)
#pragma unroll
        for (int ti = 0; ti < 4; ++ti) f(wf_ * 64 + fi * 16 + (lane_ >> 4) * 4, wt_ * 64 + ti * 16 + (lane_ & 15), acc[fi][ti]);
}


namespace pg8 {
#define PG8_LAS __attribute__((address_space(3)))
constexpr int BM = 256, BK = 64, HALF = 128, HTB = HALF * BK * 2, NXCD = 8, WGM = 4;
DI int lds_byte(int r, int c) { const int st = (r >> 4) * 2 + (c >> 5), rr = r & 15, cc = c & 31, ob = rr * 64 + cc * 2; return st * 1024 + (ob ^ (((ob >> 9) & 1) << 5)); }
DI void stage_rc(int b, int& R, int& C) { const int st = b / 1024, sb = b % 1024, swz = sb ^ (((sb >> 9) & 1) << 5); R = (st >> 1) * 16 + swz / 64; C = (st & 1) * 32 + (swz % 64) / 2; }
DI int perm32(int rho) { const int n = rho >> 4, i = rho & 15; return 8 * (i >> 2) + 4 * n + (i & 3); }
struct Unit { int pm, pn; };
struct Gemm { const bf16_t* A; const bf16_t* Bt; int lda, ldb, K, a_pn_off; };
struct StaticOrder {
    int nM, nN, nwg, G, c;
    DI void init(int M, int N, int G_, int c_) { nM = M / BM; nN = N / BM; nwg = nM * nN; G = G_; c = c_; }
    DI bool next(int i, Unit& u) const {
        const long L = (long)i * G + c; if (L >= nwg) return false;
        int wgid = (int)L; { const int q = nwg / NXCD, r = nwg % NXCD, xcd = wgid % NXCD, off = wgid / NXCD; wgid = (xcd < r ? xcd * (q + 1) : r * (q + 1) + (xcd - r) * q) + off; }
        const int nig = WGM * nN, gid = wgid / nig, fm = gid * WGM, gsz = (nM - fm) < WGM ? (nM - fm) : WGM;
        u.pm = fm + ((wgid % nig) % gsz); u.pn = (wgid % nig) / gsz; return true;
    }
};
template <class Epi>
DI void gemm_phase(PG8_LAS unsigned char* lds, const Gemm g, const StaticOrder& S, const Epi& E) {
    int tid = threadIdx.x; asm volatile("" : "+v"(tid));
    const int wid = __builtin_amdgcn_readfirstlane(tid >> 6), lane = tid & 63, wr = wid >> 2, wc = wid & 3, fr = lane & 15, fq = lane >> 4;
    const int nt = g.K / BK;
    unsigned voffA[2], voffB[2];
#pragma unroll
    for (int i = 0; i < 2; ++i) { int R, C; stage_rc(tid * 16 + i * 8192, R, C); const int Rb = (R & ~31) + perm32(R & 31);
        voffA[i] = (unsigned)(R * g.lda + C) * 2u; voffB[i] = (unsigned)(Rb * g.ldb + C) * 2u; }
    const size_t kstep = (size_t)(BK * 2);
    const size_t hstepA = (size_t)HALF * g.lda * 2, hstepB = (size_t)HALF * g.ldb * 2;
    const size_t tstepA = 2 * hstepA, tstepB = 2 * hstepB;
    const unsigned ldsw = (unsigned)wid * 1024u;
    const int aoff = lds_byte(wr * 64 + fr, fq * 8), boff = lds_byte(wc * 32 + fr, fq * 8);
#define PG8_SA(b, h) (((b) * 2 + (h)) * HTB)
#define PG8_SB(b, h) ((4 + (b) * 2 + (h)) * HTB)
#define PG8_STAGE(bufoff, gbase, voff) do { _Pragma("unroll") for (int _i = 0; _i < 2; ++_i) \
        __builtin_amdgcn_global_load_lds((const unsigned*)((const char*)(gbase) + (voff)[_i]), (PG8_LAS unsigned*)(lds + (bufoff) + ldsw + _i * 8192), 16, 0, 0); } while (0)
#define PG8_LDA(dst, b, h) do { _Pragma("unroll") for (int m = 0; m < 4; ++m) _Pragma("unroll") for (int k = 0; k < 2; ++k) dst[m][k] = *(const PG8_LAS bf16x8*)(lds + PG8_SA(b, h) + aoff + m * 2048 + k * 1024); } while (0)
#define PG8_LDB(dst, b, h) do { _Pragma("unroll") for (int n = 0; n < 2; ++n) _Pragma("unroll") for (int k = 0; k < 2; ++k) dst[n][k] = *(const PG8_LAS bf16x8*)(lds + PG8_SB(b, h) + boff + n * 2048 + k * 1024); } while (0)
#define PG8_MMA(ai, bj, At, Bt) do { __builtin_amdgcn_s_setprio(1); _Pragma("unroll") for (int m = 0; m < 4; ++m) _Pragma("unroll") for (int n = 0; n < 2; ++n) _Pragma("unroll") for (int k = 0; k < 2; ++k) \
        acc[ai][bj][m][n] = __builtin_amdgcn_mfma_f32_16x16x32_bf16(Bt[n][k], At[m][k], acc[ai][bj][m][n], 0, 0, 0); __builtin_amdgcn_s_setprio(0); } while (0)
#define PG8_WAIT_V(n) asm volatile("s_waitcnt vmcnt(" #n ")" ::: "memory")
#define PG8_WAIT_L(n) asm volatile("s_waitcnt lgkmcnt(" #n ")" ::: "memory")
#define PG8_BAR __builtin_amdgcn_s_barrier()
#define PG8_SCHED __builtin_amdgcn_sched_barrier(0)
    Unit cur, nxt; int ui = 0;
    if (!S.next(0, cur)) return;
    f32x4 acc[2][2][4][2];
#pragma unroll
    for (int a = 0; a < 2; ++a)
#pragma unroll
        for (int b = 0; b < 2; ++b)
#pragma unroll
            for (int m = 0; m < 4; ++m)
#pragma unroll
                for (int n = 0; n < 2; ++n) acc[a][b][m][n] = (f32x4){0.f, 0.f, 0.f, 0.f};
    bf16x8 At[4][2], B0[2][2], B1[2][2];
    const char* cA = (const char*)g.A + (size_t)cur.pm * tstepA + (size_t)cur.pn * g.a_pn_off; const char* cB = (const char*)g.Bt + (size_t)cur.pn * tstepB;
    PG8_STAGE(PG8_SB(0, 0), cB, voffB); PG8_STAGE(PG8_SB(0, 1), cB + hstepB, voffB); PG8_STAGE(PG8_SA(0, 0), cA, voffA); PG8_STAGE(PG8_SA(0, 1), cA + hstepA, voffA);
    if (wr == 1) PG8_BAR;
    PG8_WAIT_V(2); PG8_BAR;
    PG8_STAGE(PG8_SB(1, 0), cB + kstep, voffB); PG8_STAGE(PG8_SA(1, 0), cA + kstep, voffA); PG8_STAGE(PG8_SB(1, 1), cB + hstepB + kstep, voffB);
    PG8_WAIT_V(6); PG8_BAR;
    for (;;) {
        const bool has_next = S.next(ui + 1, nxt);
        const char* nA = has_next ? (const char*)g.A + (size_t)nxt.pm * tstepA + (size_t)nxt.pn * g.a_pn_off : cA; const char* nB = has_next ? (const char*)g.Bt + (size_t)nxt.pn * tstepB : cB;
        for (int t = 0; t < nt; t += 2) {
            const bool last = (t == nt - 2);
            const char* a1 = cA + (size_t)(t + 1) * kstep;
            const char* a2 = last ? nA : cA + (size_t)(t + 2) * kstep; const char* b2 = last ? nB : cB + (size_t)(t + 2) * kstep;
            const char* a3 = a2 + kstep; const char* b3 = b2 + kstep;
            PG8_LDB(B0, 0, 0); PG8_LDB(B1, 0, 1); PG8_SCHED; PG8_LDA(At, 0, 0); PG8_STAGE(PG8_SA(1, 1), a1 + hstepA, voffA);
            PG8_WAIT_V(8); PG8_WAIT_L(0); PG8_BAR; PG8_MMA(0, 0, At, B0); PG8_MMA(0, 1, At, B1); PG8_BAR; PG8_SCHED;
            PG8_LDA(At, 0, 1); PG8_STAGE(PG8_SB(0, 0), b2, voffB); PG8_STAGE(PG8_SB(0, 1), b2 + hstepB, voffB); PG8_STAGE(PG8_SA(0, 0), a2, voffA);
            PG8_WAIT_V(8); PG8_WAIT_L(0); PG8_BAR; PG8_MMA(1, 0, At, B0); PG8_MMA(1, 1, At, B1); PG8_BAR; PG8_SCHED;
            PG8_LDB(B0, 1, 0); PG8_LDB(B1, 1, 1); PG8_SCHED; PG8_LDA(At, 1, 0); PG8_STAGE(PG8_SA(0, 1), a2 + hstepA, voffA);
            PG8_WAIT_V(8); PG8_WAIT_L(0); PG8_BAR; PG8_MMA(0, 0, At, B0); PG8_MMA(0, 1, At, B1); PG8_BAR; PG8_SCHED;
            PG8_LDA(At, 1, 1); PG8_STAGE(PG8_SB(1, 0), b3, voffB); PG8_STAGE(PG8_SB(1, 1), b3 + hstepB, voffB); PG8_STAGE(PG8_SA(1, 0), a3, voffA);
            PG8_WAIT_V(8); PG8_WAIT_L(0); PG8_BAR; PG8_MMA(1, 0, At, B0); PG8_MMA(1, 1, At, B1); PG8_BAR; PG8_SCHED;
        }
        if (wr == 0) PG8_BAR;
        { int efr = fr, efq = fq; asm volatile("" : "+v"(efr), "+v"(efq)); E(acc, cur, wr, wc, efr, efq); }
        if (!has_next) break;
#pragma unroll
        for (int a = 0; a < 2; ++a)
#pragma unroll
            for (int b = 0; b < 2; ++b)
#pragma unroll
                for (int m = 0; m < 4; ++m)
#pragma unroll
                    for (int n = 0; n < 2; ++n) acc[a][b][m][n] = (f32x4){0.f, 0.f, 0.f, 0.f};
        cur = nxt; cA = nA; cB = nB; ++ui;
        if (wr == 1) PG8_BAR;
    }
    PG8_WAIT_V(0);
    PG8_BAR;
#undef PG8_SA
#undef PG8_SB
#undef PG8_STAGE
#undef PG8_LDA
#undef PG8_LDB
#undef PG8_MMA
#undef PG8_WAIT_V
#undef PG8_WAIT_L
#undef PG8_BAR
#undef PG8_SCHED
}
template <class F>
DI void epi8(const f32x4 (&acc)[2][2][4][2], const Unit& u, int wr, int wc, int fr, int fq, F f) {
#pragma unroll
    for (int ai = 0; ai < 2; ++ai)
#pragma unroll
        for (int m = 0; m < 4; ++m)
#pragma unroll
            for (int bj = 0; bj < 2; ++bj) f(u.pm * 256 + ai * 128 + wr * 64 + m * 16 + fr, u.pn * 256 + bj * 128 + wc * 32 + 8 * fq, acc[ai][bj][m][0], acc[ai][bj][m][1]);
}
}
#define TILE_AI(i) ((i) >> 3)
#define TILE_M(i)  (((i) >> 1) & 3)
#define TILE_BJ(i) ((i) & 1)
DI unsigned pk4u8(f32x4 v) {
    unsigned r = 0;
    r = __builtin_amdgcn_cvt_pk_u8_f32(v[0] * 255.f, 0, r); r = __builtin_amdgcn_cvt_pk_u8_f32(v[1] * 255.f, 1, r);
    r = __builtin_amdgcn_cvt_pk_u8_f32(v[2] * 255.f, 2, r); r = __builtin_amdgcn_cvt_pk_u8_f32(v[3] * 255.f, 3, r);
    return r;
}
DI f32x4 un4u8(unsigned w) {
    const float k = 1.f / 255.f;
    return (f32x4){(float)(w & 0xffu) * k, (float)((w >> 8) & 0xffu) * k, (float)((w >> 16) & 0xffu) * k, (float)(w >> 24) * k};
}
DI uint4 pk8(f32x4 a, f32x4 b) { return make_uint4(pk2(a[0], a[1]), pk2(a[2], a[3]), pk2(b[0], b[1]), pk2(b[2], b[3])); }

struct RowMajor {
    const bf16_t* base; int ld;
    DI uint4 operator()(int r, int k) const { return *(const uint4*)(base + (size_t)r * ld + k); }
};

DI void transpose_tile(unsigned char* smem, const int tid, const float* src, int K, int N, bf16_t* dst, int ldd, int permid, int kt, int nt) {
    float (*tile)[65] = (float (*)[65])smem;
    const int k0 = kt * 64, n0 = nt * 64;
    float tv[16];
#pragma unroll
    for (int i = 0; i < 16; ++i) {
        int kk = i * 4 + (tid >> 6), nn = tid & 63;
        tv[i] = (n0 + nn < N) ? src[(size_t)(k0 + kk) * N + n0 + nn] : 0.f;
    }
#pragma unroll
    for (int i = 0; i < 16; ++i) tile[tid & 63][i * 4 + (tid >> 6)] = tv[i];
    __syncthreads();
#pragma unroll 4
    for (int i = 0; i < 16; ++i) {
        int nn = i * 4 + (tid >> 6), kk = tid & 63;
        int n = n0 + nn;
        if (n < N) {
            int row = n;
            if (permid == 1) row = (n < 2048) ? n : ((n >= 2056) ? n - 8 : -1);
            else if (permid == 2) row = (n < 1024) ? ((n >> 2) * 8 + (n & 3)) : (((n - 1024) >> 2) * 8 + 4 + (n & 3));
            else if (permid == 3) row = (n < 2816) ? ((n >> 2) * 8 + (n & 3)) : (((n - 2816) >> 2) * 8 + 4 + (n & 3));
            if (row >= 0) dst[(size_t)row * ldd + k0 + kk] = f2bf(tile[nn][kk]);
        }
    }
    __syncthreads();
}

DI void phase0(const Params& p, unsigned char* smem, const int tid, const int vb, const int nvb) {
    unsigned char* ws = p.ws;
    const int NTR = 4112, NADA = 192, NS5 = 32;
    for (int it0 = vb; it0 < NTR + NADA + NS5; it0 += nvb) {
        const int it = (it0 < NADA + NS5) ? (NTR + it0) : (it0 - NADA - NS5);
        if (it < NTR) {
            int id = it;
            if (id < 1168) { transpose_tile(smem, tid, p.in[4], 1024, 4616, (bf16_t*)(ws + OFF_WIN), 1024, 1, id / 73, id % 73); continue; }
            id -= 1168;
            if (id < 64) {
                int isk = id >> 5, r = id & 31, h = r >> 3, t = r & 7;
                transpose_tile(smem, tid, (isk ? p.in[9] : p.in[8]) + (size_t)h * 256 * 128, 256, 128,
                               (bf16_t*)(ws + OFF_WQK) + (size_t)h * 65536 + (isk ? 128 * 256 : 0), 256, 0, t >> 1, t & 1);
                continue;
            }
            id -= 64;
            if (id < 256) { transpose_tile(smem, tid, p.in[11], 1024, 1024, (bf16_t*)(ws + OFF_WDN), 1024, 0, id >> 4, id & 15); continue; }
            id -= 256;
            if (id < 256) { transpose_tile(smem, tid, p.in[20], 512, 2048, (bf16_t*)(ws + OFF_WGL), 512, 2, id >> 5, id & 31); continue; }
            id -= 256;
            if (id < 256) { transpose_tile(smem, tid, p.in[21], 1024, 1024, (bf16_t*)(ws + OFF_WMX), 1024, 0, id >> 4, id & 15); continue; }
            id -= 256;
            if (id < 1408) { transpose_tile(smem, tid, p.in[24], 1024, 5632, (bf16_t*)(ws + OFF_WUP), 1024, 3, id / 88, id % 88); continue; }
            id -= 1408;
            transpose_tile(smem, tid, p.in[27], 2816, 1024, (bf16_t*)(ws + OFF_WFD), 2816, 0, id >> 4, id & 15);
        } else if (it < NTR + NADA) {
            const int a = it - NTR;
            float* sc = (float*)smem;
            float* red = (float*)(smem + 16384);
            for (int i = tid; i < 4096; i += 256) { float v = p.in[1][i]; sc[i] = v / (1.f + __expf(-v)); }
            __syncthreads();
            const int col = tid & 31, kg = tid >> 5, n0 = a * 32;
            float a0 = 0, a1 = 0, a2 = 0, a3 = 0;
            const float* wp = p.in[2] + (size_t)(kg * 128) * 6144 + n0 + col;
#pragma unroll 16
            for (int k = 0; k < 128; ++k) {
                float w = wp[(size_t)k * 6144];
                int kk = kg * 128 + k;
                a0 += sc[kk] * w; a1 += sc[1024 + kk] * w; a2 += sc[2048 + kk] * w; a3 += sc[3072 + kk] * w;
            }
            red[(kg * 4 + 0) * 32 + col] = a0; red[(kg * 4 + 1) * 32 + col] = a1; red[(kg * 4 + 2) * 32 + col] = a2; red[(kg * 4 + 3) * 32 + col] = a3;
            __syncthreads();
            if (tid < 128) {
                int b = tid >> 5, c2 = tid & 31;
                float sacc = p.in[3][n0 + c2];
                for (int g = 0; g < 8; ++g) sacc += red[(g * 4 + b) * 32 + c2];
                ((float*)(ws + OFF_MOD))[b * 6144 + n0 + c2] = sacc;
            }
            __syncthreads();
        } else {
            const int g = it - NTR - NADA;
            const float dtf = expf(p.in[14][g]);
            const double dt = (double)dtf;
            float2* apow = (float2*)(ws + OFF_APOW);
            for (int idx = tid; idx < 64 * 65; idx += 256) {
                int pp = idx / 65, tau = idx % 65;
                double lr = p.in[12][g * 64 + pp], li = p.in[13][g * 64 + pp];
                double rev = li * dt * (double)tau * 0.15915494309189535;
                rev -= rint(rev);
                float mag = expf((float)(lr * dt * (double)tau));
                apow[((size_t)g * 65 + tau) * 64 + pp] = make_float2(mag * __builtin_amdgcn_cosf((float)rev), mag * __builtin_amdgcn_sinf((float)rev));
            }
            if (tid < 64) {
                int pp = tid;
                float lr = p.in[12][g * 64 + pp], li = p.in[13][g * 64 + pp];
                float em1 = expm1f(lr * dtf), mag = em1 + 1.f;
                double rev = (double)li * dt * 0.15915494309189535;
                double revh = 0.5 * rev;
                rev -= rint(rev); revh -= rint(revh);
                float sh = __builtin_amdgcn_sinf((float)revh);
                float arm1 = em1 - 2.f * mag * sh * sh;
                float ai = mag * __builtin_amdgcn_sinf((float)rev);
                float den = lr * lr + li * li;
                float zr = (arm1 * lr + ai * li) / den, zi = (ai * lr - arm1 * li) / den;
                float2* bb = (float2*)(ws + OFF_BBAR);
                for (int c2 = 0; c2 < 16; ++c2) {
                    float br = p.in[15][(size_t)(g * 64 + pp) * 16 + c2], bi = p.in[16][(size_t)(g * 64 + pp) * 16 + c2];
                    bb[(size_t)(g * 64 + pp) * 16 + c2] = make_float2(zr * br - zi * bi, zr * bi + zi * br);
                }
            }
            __syncthreads();
            __syncthreads();
        }
    }
}

DI void row_stats(const float (&v)[16], float& mean, float& rstd) {
    float s = 0.f;
#pragma unroll
    for (int i = 0; i < 16; ++i) s += v[i];
    mean = wsum(s) * (1.f / 1024.f);
    float q = 0.f;
#pragma unroll
    for (int i = 0; i < 16; ++i) { float d = v[i] - mean; q += d * d; }
    rstd = rsqrtf(wsum(q) * (1.f / 1024.f) + 1e-5f);
}

DI void phase1(const Params& p, unsigned char* smem) {
    unsigned char* ws = p.ws;
    int ft_ = threadIdx.x; asm volatile("" : "+v"(ft_));
    const int lane = ft_ & 63, wid = ft_ >> 6;
    const float* mod = (const float*)(ws + OFF_MOD);
    bf16_t* h1 = (bf16_t*)(ws + 1 * U_);
    float4 gw0[16], gw1[16];
#pragma unroll
    for (int i = 0; i < 4; ++i)
#pragma unroll
        for (int e = 0; e < 4; ++e) {
            const float* wp = p.in[4] + (size_t)(i * 256 + lane * 4 + e) * 4616 + 2048;
            gw0[i * 4 + e] = *(const float4*)wp; gw1[i * 4 + e] = *(const float4*)(wp + 4);
        }
    float* ig = (float*)(ws + OFF_IG);
    float* lf = (float*)(ws + OFF_LOGF);
    for (int row0 = (blockIdx.x * 8 + wid) * 4; row0 < T_; row0 += gridDim.x * 32) {
        float vv[4][16];
#pragma unroll
        for (int rr = 0; rr < 4; ++rr)
#pragma unroll
            for (int i = 0; i < 4; ++i) { float4 t = *(const float4*)(p.in[0] + (size_t)(row0 + rr) * 1024 + i * 256 + lane * 4); vv[rr][4 * i] = t.x; vv[rr][4 * i + 1] = t.y; vv[rr][4 * i + 2] = t.z; vv[rr][4 * i + 3] = t.w; }
#pragma unroll
        for (int rr = 0; rr < 4; ++rr) {
            const int row = row0 + rr;
            float mean, rstd; row_stats(vv[rr], mean, rstd);
            const float* mb = mod + (row >> 13) * 6144;
            float ga[8];
#pragma unroll
            for (int j = 0; j < 8; ++j) ga[j] = 0.f;
#pragma unroll
            for (int i = 0; i < 4; ++i) {
                int c = i * 256 + lane * 4;
                float4 sh = *(const float4*)(mb + c), sc = *(const float4*)(mb + 1024 + c);
                f32x4 o;
                o[0] = (vv[rr][4 * i] - mean) * rstd * (1.f + sc.x) + sh.x;
                o[1] = (vv[rr][4 * i + 1] - mean) * rstd * (1.f + sc.y) + sh.y;
                o[2] = (vv[rr][4 * i + 2] - mean) * rstd * (1.f + sc.z) + sh.z;
                o[3] = (vv[rr][4 * i + 3] - mean) * rstd * (1.f + sc.w) + sh.w;
                *(uint2*)(h1 + (size_t)row * 1024 + c) = pk4(o);
#pragma unroll
                for (int e = 0; e < 4; ++e) {
                    const float4 w0 = gw0[i * 4 + e], w1 = gw1[i * 4 + e];
                    ga[0] += o[e] * w0.x; ga[1] += o[e] * w0.y; ga[2] += o[e] * w0.z; ga[3] += o[e] * w0.w;
                    ga[4] += o[e] * w1.x; ga[5] += o[e] * w1.y; ga[6] += o[e] * w1.z; ga[7] += o[e] * w1.w;
                }
            }
#pragma unroll
            for (int j = 0; j < 8; ++j) ga[j] = wsum(ga[j]);
            if (lane < 8) {
                float val = ga[0];
#pragma unroll
                for (int j = 1; j < 8; ++j) val = (lane == j) ? ga[j] : val;
                val += p.in[5][2048 + lane];
                const int b = row >> 13, sidx = row & 8191;
                if (lane < 4) ig[(size_t)(b * 4 + lane) * 8192 + sidx] = val;
                else lf[(size_t)(b * 4 + lane - 4) * 8192 + sidx] = logsig(val);
            }
        }
    }
    const float2* apow = (const float2*)(ws + OFF_APOW);
    const float2* bbar = (const float2*)(ws + OFF_BBAR);
    const float* cre = p.in[17];
    const float* cim = p.in[18];
    const int gtid = blockIdx.x * 512 + fresh_tid(), gstr = gridDim.x * 512;
    bf16_t* emat = (bf16_t*)(ws + OFF_EMAT);
    for (int idx = gtid; idx < 32 * 128 * 128; idx += gstr) {
        const int g = idx >> 14, m = (idx >> 7) & 127, k8 = idx & 127;
        const int pp = m & 63, j = k8 >> 1, c20 = (k8 & 1) * 8;
        const float2 a = apow[((size_t)g * 65 + (63 - j)) * 64 + pp];
        const float4* bp = (const float4*)(bbar + (size_t)(g * 64 + pp) * 16 + c20);
        float o[8];
#pragma unroll
        for (int e = 0; e < 4; ++e) {
            float4 b2 = bp[e];
            o[2 * e] = (m < 64) ? (a.x * b2.x - a.y * b2.y) : (a.x * b2.y + a.y * b2.x);
            o[2 * e + 1] = (m < 64) ? (a.x * b2.z - a.y * b2.w) : (a.x * b2.w + a.y * b2.z);
        }
        *(uint4*)(emat + (size_t)idx * 8) = make_uint4(pk2(o[0], o[1]), pk2(o[2], o[3]), pk2(o[4], o[5]), pk2(o[6], o[7]));
    }
}

struct EpiIn {
    const float* bin; bf16_t *xm, *xmT, *og, *sga, *sgb, *us;
    DI void operator()(const f32x4 (&acc)[2][2][4][2], const pg8::Unit& u, int wr, int wc, int fr, int fq) const {
        const int pn = u.pn;
        int boff, c0, slot;
        if (pn < 4) { boff = 0; c0 = 0; slot = 0; }
        else if (pn < 8) { boff = 1024; c0 = 1024; slot = 0; }
        else if (pn < 10) { boff = 2056; c0 = 2048; slot = 0; }
        else if (pn < 14) { boff = 2568; c0 = 2560; slot = 1; }
        else { boff = 3592; c0 = 3584; slot = 2; }
        const int colb = pn * 256 + wc * 32 + 8 * fq - c0;
        f32x4 bia[2][2];
#pragma unroll
        for (int bj = 0; bj < 2; ++bj) { bia[bj][0] = *(const f32x4*)(bin + boff + colb + bj * 128); bia[bj][1] = *(const f32x4*)(bin + boff + colb + bj * 128 + 4); }
        const int t0 = u.pm * 256 + wr * 64 + fr;
        if (pn < 4) {
#pragma unroll
            for (int i = 0; i < 16; ++i) {
                const int ai = TILE_AI(i), m = TILE_M(i), bj = TILE_BJ(i);
                const int t = t0 + ai * 128 + m * 16, col = colb + bj * 128;
                const f32x4 v0 = acc[ai][bj][m][0] + bia[bj][0], v1 = acc[ai][bj][m][1] + bia[bj][1];
                *(uint4*)(xm + (size_t)t * 1024 + col) = pk8(v0, v1);
                const int b = t >> 13, sidx = t & 8191;
                bf16_t* tp = xmT + ((((size_t)(b * 4 + (col >> 8)) * 128 + (sidx >> 6)) * 256 + (col & 255)) * 64) + (sidx & 63);
#pragma unroll
                for (int r = 0; r < 4; ++r) { *tp = f2bf(v0[r]); tp += 64; asm volatile("" : "+v"(tp)); }
#pragma unroll
                for (int r = 0; r < 4; ++r) { *tp = f2bf(v1[r]); tp += 64; asm volatile("" : "+v"(tp)); }
            }
        } else if (pn == 8 || pn == 9) {
#pragma unroll
            for (int i = 0; i < 16; ++i) {
                const int ai = TILE_AI(i), m = TILE_M(i), bj = TILE_BJ(i);
                const int t = t0 + ai * 128 + m * 16, col = colb + bj * 128;
                *(uint4*)(us + ((((size_t)(col >> 4) * 512 + (t >> 6)) * 64 + (t & 63)) * 16 + (col & 15))) = pk8(acc[ai][bj][m][0] + bia[bj][0], acc[ai][bj][m][1] + bia[bj][1]);
            }
        } else {
            unsigned char* dst = (unsigned char*)og + (size_t)slot * U_;
#pragma unroll
            for (int i = 0; i < 16; ++i) {
                const int ai = TILE_AI(i), m = TILE_M(i), bj = TILE_BJ(i);
                const int t = t0 + ai * 128 + m * 16, col = colb + bj * 128;
                f32x4 v0 = acc[ai][bj][m][0] + bia[bj][0], v1 = acc[ai][bj][m][1] + bia[bj][1];
#pragma unroll
                for (int r = 0; r < 4; ++r) { v0[r] = sigm(v0[r]); v1[r] = sigm(v1[r]); }
                *(uint2*)(dst + (size_t)t * 1024 + col) = make_uint2(pk4u8(v0), pk4u8(v1));
            }
        }
    }
};

DI void s5_tables_late(const Params& p, const int gtid, const int gstr) {
    unsigned char* ws = p.ws;
    const float2* apow = (const float2*)(ws + OFF_APOW);
    const float2* bbar = (const float2*)(ws + OFF_BBAR);
    const float* cre = p.in[17];
    const float* cim = p.in[18];
    bf16_t* kc = (bf16_t*)(ws + OFF_KC);
    for (int idx = gtid; idx < 32 * 64 * 16 * 2; idx += gstr) {
        const int g = idx >> 11, tau = (idx >> 5) & 63, c = (idx >> 1) & 15, c20 = (idx & 1) * 8;
        float sacc[8];
#pragma unroll
        for (int e = 0; e < 8; ++e) sacc[e] = 0.f;
#pragma unroll 4
        for (int pp = 0; pp < 64; ++pp) {
            const float cr = cre[(size_t)(g * 16 + c) * 64 + pp], ci = cim[(size_t)(g * 16 + c) * 64 + pp];
            const float2 a = apow[((size_t)g * 65 + tau) * 64 + pp];
            const float wr_ = cr * a.x - ci * a.y, wi_ = cr * a.y + ci * a.x;
            const float4* bp = (const float4*)(bbar + (size_t)(g * 64 + pp) * 16 + c20);
#pragma unroll
            for (int e = 0; e < 4; ++e) { float4 b2 = bp[e]; sacc[2 * e] += wr_ * b2.x - wi_ * b2.y; sacc[2 * e + 1] += wr_ * b2.z - wi_ * b2.w; }
        }
        *(uint4*)(kc + (((size_t)(g * 64 + tau) * 16 + c) * 16 + c20)) = make_uint4(pk2(sacc[0], sacc[1]), pk2(sacc[2], sacc[3]), pk2(sacc[4], sacc[5]), pk2(sacc[6], sacc[7]));
    }
    bf16_t* cmat = (bf16_t*)(ws + OFF_CMAT);
    for (int idx = gtid; idx < 32 * 1024 * 16; idx += gstr) {
        const int g = idx >> 14, m = (idx >> 4) & 1023, kk0 = (idx & 15) * 8;
        const int t = m >> 4, c = m & 15, p0 = kk0 & 63;
        const float4* crp = (const float4*)(cre + (size_t)(g * 16 + c) * 64 + p0);
        const float4* cip = (const float4*)(cim + (size_t)(g * 16 + c) * 64 + p0);
        float4 cr0 = crp[0], cr1 = crp[1], ci0 = cip[0], ci1 = cip[1];
        const float crv[8] = {cr0.x, cr0.y, cr0.z, cr0.w, cr1.x, cr1.y, cr1.z, cr1.w};
        const float civ[8] = {ci0.x, ci0.y, ci0.z, ci0.w, ci1.x, ci1.y, ci1.z, ci1.w};
        float o[8];
#pragma unroll
        for (int e = 0; e < 8; ++e) {
            const float2 a = apow[((size_t)g * 65 + t + 1) * 64 + p0 + e];
            o[e] = (kk0 < 64) ? (crv[e] * a.x - civ[e] * a.y) : -(crv[e] * a.y + civ[e] * a.x);
        }
        *(uint4*)(cmat + (size_t)idx * 8) = make_uint4(pk2(o[0], o[1]), pk2(o[2], o[3]), pk2(o[4], o[5]), pk2(o[6], o[7]));
    }
}

DI void phase3(const Params& p, unsigned char* smem, const int tid, const int vb, const int nvb) {
    unsigned char* ws = p.ws;
    const bf16_t* us = (const bf16_t*)(ws + 7 * U_);
    const bf16_t* emat = (const bf16_t*)(ws + OFF_EMAT);
    float* ebuf = (float*)((unsigned char*)p.out + (size_t)48 * 1048576);
    const bf16_t* xm = (const bf16_t*)(ws + 2 * U_);
    bf16_t* xc = (bf16_t*)(ws + 1 * U_);
    for (int it = vb; it < 256; it += nvb) {
        const int g = it >> 3, nt = (it >> 1) & 3, kh = it & 1;
        f32x4 acc[4][4];
        auto lb = [=](int r, int k) -> uint4 { return *(const uint4*)(us + ((size_t)g * 512 + nt * 128 + r) * 1024 + kh * 512 + k); };
        gemm_tile(smem, tid, 8, RowMajor{emat + (size_t)g * 128 * 1024 + kh * 512, 1024}, lb, acc);
        epi_loop(acc, tid, [&](const int epi_f, const int epi_t, const f32x4 accv) __attribute__((always_inline)) {
            const int f = epi_f, n = nt * 128 + epi_t;
            *(f32x4*)(ebuf + (size_t)kh * 2097152 + ((size_t)n * 32 + g) * 128 + f) = accv;
        });
    }
    if (blockIdx.x >= 128) s5_tables_late(p, (blockIdx.x - 128) * 512 + fresh_tid(), (gridDim.x - 128) * 512);
    for (int i0 = vb; i0 < 512; i0 += nvb) {
        const int cgp = tid & 127, half = tid >> 7;
        const int t0 = i0 * 64 + half * 32, s0 = t0 & 8191;
        const int c0 = cgp * 8;
        float w[4][8], bb[8];
#pragma unroll
        for (int j = 0; j < 4; ++j)
#pragma unroll
            for (int e = 0; e < 8; ++e) w[j][e] = p.in[6][j * 1024 + c0 + e];
#pragma unroll
        for (int e = 0; e < 8; ++e) bb[e] = p.in[7][c0 + e];
        float r0[8], r1[8], r2[8];
#pragma unroll
        for (int e = 0; e < 8; ++e) { r0[e] = 0.f; r1[e] = 0.f; r2[e] = 0.f; }
        if (s0 > 0) {
            uint4 a = *(const uint4*)(xm + (size_t)(t0 - 3) * 1024 + c0), b = *(const uint4*)(xm + (size_t)(t0 - 2) * 1024 + c0), c = *(const uint4*)(xm + (size_t)(t0 - 1) * 1024 + c0);
            const unsigned* pa = (const unsigned*)&a; const unsigned* pb = (const unsigned*)&b; const unsigned* pc = (const unsigned*)&c;
#pragma unroll
            for (int e = 0; e < 4; ++e) {
                r0[2 * e] = bf2f(pa[e] & 0xffff); r0[2 * e + 1] = bf2f(pa[e] >> 16);
                r1[2 * e] = bf2f(pb[e] & 0xffff); r1[2 * e + 1] = bf2f(pb[e] >> 16);
                r2[2 * e] = bf2f(pc[e] & 0xffff); r2[2 * e + 1] = bf2f(pc[e] >> 16);
            }
        }
        for (int tb = 0; tb < 32; tb += 8) {
            uint4 av[8];
#pragma unroll
            for (int i = 0; i < 8; ++i) av[i] = *(const uint4*)(xm + (size_t)(t0 + tb + i) * 1024 + c0);
#pragma unroll
            for (int i = 0; i < 8; ++i) {
                const unsigned* pa = (const unsigned*)&av[i];
                float cur[8], y[8];
#pragma unroll
                for (int e = 0; e < 4; ++e) { cur[2 * e] = bf2f(pa[e] & 0xffff); cur[2 * e + 1] = bf2f(pa[e] >> 16); }
#pragma unroll
                for (int e = 0; e < 8; ++e) {
                    float z = bb[e] + w[0][e] * r0[e] + w[1][e] * r1[e] + w[2][e] * r2[e] + w[3][e] * cur[e];
                    y[e] = z * sigm(z);
                    r0[e] = r1[e]; r1[e] = r2[e]; r2[e] = cur[e];
                }
                *(uint4*)(xc + (size_t)(t0 + tb + i) * 1024 + c0) = make_uint4(pk2(y[0], y[1]), pk2(y[2], y[3]), pk2(y[4], y[5]), pk2(y[6], y[7]));
            }
        }
    }
    for (int u = vb * 4 + (tid >> 6); u < 2048; u += nvb * 4) {
        const int lane = tid & 63;
        const int bh = u >> 7, c = u & 127;
        const size_t o = (size_t)bh * 8192 + c * 64 + lane;
        float b = ((const float*)(ws + OFF_LOGF))[o];
        float ii = ((const float*)(ws + OFF_IG))[o];
        for (int d = 1; d < 64; d <<= 1) { float t = __shfl_up(b, d, 64); if (lane >= d) b += t; }
        float bl = __shfl(b, 63, 64);
        float g = bl - b + ii;
        for (int o2 = 32; o2 > 0; o2 >>= 1) g = fmaxf(g, __shfl_xor(g, o2, 64));
        ((float*)(ws + OFF_BCUM))[o] = b;
        if (lane == 0) { ((float*)(ws + OFF_AARR))[u] = g; ((float*)(ws + OFF_BLAST))[u] = bl; }
    }
}

DI void phase4_small(const Params& p, unsigned char* smem) {
    unsigned char* ws = p.ws;
    const int tid = fresh_tid();
    const int lane = tid & 63, wid = tid >> 6;
    if (blockIdx.x >= gridDim.x - 2) {
        const int bh = (blockIdx.x - (gridDim.x - 2)) * 8 + wid;
        const float* aa = (const float*)(ws + OFF_AARR) + bh * 128;
        const float* bl = (const float*)(ws + OFF_BLAST) + bh * 128;
        float* ms = (float*)(ws + OFF_MST) + bh * 132;
        const float p0 = bl[2 * lane], q0 = aa[2 * lane], p1 = bl[2 * lane + 1], q1 = aa[2 * lane + 1];
        float P = p0 + p1, Q = fmaxf(q0 + p1, q1);
#pragma unroll
        for (int d = 1; d < 64; d <<= 1) {
            const float Pp = __shfl_up(P, d, 64), Qp = __shfl_up(Q, d, 64);
            if (lane >= d) { Q = fmaxf(Qp + P, Q); P = Pp + P; }
        }
        float Pe = __shfl_up(P, 1, 64), Qe = __shfl_up(Q, 1, 64);
        const float m_even = (lane == 0) ? 0.f : fmaxf(Pe, Qe);
        const float m_odd = fmaxf(m_even + p0, q0);
        ms[2 * lane] = m_even; ms[2 * lane + 1] = m_odd;
        if (lane == 63) ms[128] = fmaxf(P, Q);
    }
    if (blockIdx.x < 128) {
        const int b = blockIdx.x >> 5, g = blockIdx.x & 31, pp = lane, seg = wid;
        const float2 a64 = ((const float2*)(ws + OFF_APOW))[((size_t)g * 65 + 64) * 64 + pp];
        const float* ebuf = (const float*)((unsigned char*)p.out + (size_t)48 * 1048576);
        bf16_t* xcar = (bf16_t*)((unsigned char*)p.out + (size_t)40 * 1048576);
        float2* L = (float2*)smem;
        float erv[16], eiv[16];
#pragma unroll
        for (int i = 0; i < 16; ++i) { size_t o = ((size_t)(b * 128 + seg * 16 + i) * 32 + g) * 128 + pp; erv[i] = ebuf[o] + ebuf[o + 2097152]; eiv[i] = ebuf[o + 64] + ebuf[o + 2097152 + 64]; }
        float xr = 0.f, xi = 0.f;
#pragma unroll
        for (int i = 0; i < 16; ++i) { const float nr = a64.x * xr - a64.y * xi + erv[i], ni = a64.x * xi + a64.y * xr + eiv[i]; xr = nr; xi = ni; }
        L[seg * 64 + pp] = make_float2(xr, xi);
        float ar = a64.x, ai = a64.y;
#pragma unroll
        for (int k = 0; k < 4; ++k) { const float nr = ar * ar - ai * ai, ni = 2.f * ar * ai; ar = nr; ai = ni; }
        __syncthreads();
        xr = 0.f; xi = 0.f;
        for (int s2 = 0; s2 < seg; ++s2) { const float2 l = L[s2 * 64 + pp]; const float nr = ar * xr - ai * xi + l.x, ni = ar * xi + ai * xr + l.y; xr = nr; xi = ni; }
#pragma unroll
        for (int i = 0; i < 16; ++i) {
            size_t o = ((size_t)(b * 128 + seg * 16 + i) * 32 + g) * 128 + pp;
            xcar[o] = f2bf(xr); xcar[o + 64] = f2bf(xi);
            const float nr = a64.x * xr - a64.y * xi + erv[i], ni = a64.x * xi + a64.y * xr + eiv[i]; xr = nr; xi = ni;
        }
        __syncthreads();
    }
}
struct EpiQK {
    bf16_t *q, *k, *kT;
    DI void operator()(const f32x4 (&acc)[2][2][4][2], const pg8::Unit& u, int wr, int wc, int fr, int fq) const {
        const int h = u.pn;
        const int d = wc * 32 + 8 * fq;
        const int t0 = u.pm * 256 + wr * 64 + fr;
        const int b = t0 >> 13, bh = b * 4 + h, s0 = t0 & 8191;
        bf16_t* qp = q + ((size_t)bh * 8192 + s0) * 128 + d;
#pragma unroll
        for (int ai = 0; ai < 2; ++ai)
#pragma unroll
            for (int m = 0; m < 4; ++m) {
                f32x4 q0 = acc[ai][0][m][0] * 0.08838834764831845f, q1 = acc[ai][0][m][1] * 0.08838834764831845f;
                *(uint4*)(qp + (size_t)(ai * 128 + m * 16) * 128) = pk8(q0, q1);
            }
        bf16_t* kp = k + ((size_t)bh * 8192 + s0) * 128 + d;
#pragma unroll
        for (int ai = 0; ai < 2; ++ai)
#pragma unroll
            for (int m = 0; m < 4; ++m) *(uint4*)(kp + (size_t)(ai * 128 + m * 16) * 128) = pk8(acc[ai][1][m][0], acc[ai][1][m][1]);
        bf16_t* tp0 = kT + (((size_t)bh * 128 + (s0 >> 6)) * 128 + d) * 64 + (s0 & 63);
#pragma unroll
        for (int ai = 0; ai < 2; ++ai)
#pragma unroll
            for (int m = 0; m < 4; ++m) {
                bf16_t* tp = tp0 + (size_t)(ai * 2 + (m >> 2)) * 0 + ((ai * 128 + m * 16) >> 6) * (128 * 64) + ((ai * 128 + m * 16) & 63);
                asm volatile("" : "+v"(tp));
#pragma unroll
                for (int r = 0; r < 4; ++r) { *tp = f2bf(acc[ai][1][m][0][r]); tp += 64; asm volatile("" : "+v"(tp)); }
#pragma unroll
                for (int r = 0; r < 4; ++r) { *tp = f2bf(acc[ai][1][m][1][r]); tp += 64; asm volatile("" : "+v"(tp)); }
            }
    }
};

DI void mlstm_u_unit(const Params& p, unsigned char* smem, const int tid, int u) {
    unsigned char* ws = p.ws;
    const int lane = tid & 63, w = tid >> 6;
    const int bh = u >> 7, c = u & 127, b = bh >> 2, h = bh & 3;
    float* wk = (float*)smem;
    const bf16_t* kT = (const bf16_t*)(ws + 7 * U_ + U_ / 2);
    const bf16_t* vT = (const bf16_t*)(ws + 3 * U_);
    bf16_t* UT = (bf16_t*)(ws + 1 * U_);
    bf16x8 vfr[2][8][2];
#pragma unroll
    for (int nh = 0; nh < 2; ++nh)
#pragma unroll
        for (int ni = 0; ni < 8; ++ni) {
            const bf16_t* vr = vT + (((size_t)bh * 128 + c) * 256 + nh * 128 + ni * 16 + (lane & 15)) * 64 + (lane >> 4) * 8;
            vfr[nh][ni][0] = ld16(vr); vfr[nh][ni][1] = ld16(vr + 32);
        }
    if (tid < 64) {
        const size_t o = (size_t)bh * 8192 + c * 64 + tid;
        float bl = ((const float*)(ws + OFF_BLAST))[u];
        float mn = ((const float*)(ws + OFF_MST))[bh * 132 + c + 1];
        wk[tid] = __expf(bl - ((const float*)(ws + OFF_BCUM))[o] + ((const float*)(ws + OFF_IG))[o] - mn);
    }
    __syncthreads();
    {
        const int d = tid >> 1, hf = tid & 1;
        const bf16_t* kr = kT + (((size_t)bh * 128 + c) * 128 + d) * 64 + hf * 32;
        float s = 0.f;
#pragma unroll
        for (int i = 0; i < 4; ++i) {
            uint4 a = *(const uint4*)(kr + i * 8);
            const unsigned* pa = (const unsigned*)&a;
#pragma unroll
            for (int e = 0; e < 4; ++e) { s += bf2f(pa[e] & 0xffff) * wk[hf * 32 + i * 8 + 2 * e] + bf2f(pa[e] >> 16) * wk[hf * 32 + i * 8 + 2 * e + 1]; }
        }
        s += __shfl_xor(s, 1, 64);
        if (hf == 0) ((float*)(ws + OFF_NU))[((size_t)bh * 128 + c) * 128 + d] = s;
    }
    bf16x8 af[2][2];
#pragma unroll
    for (int mi = 0; mi < 2; ++mi)
#pragma unroll
        for (int ks = 0; ks < 2; ++ks) {
            const int j0 = ks * 32 + (lane >> 4) * 8;
            uint4 a = *(const uint4*)(kT + (((size_t)bh * 128 + c) * 128 + 32 * w + 16 * mi + (lane & 15)) * 64 + j0);
            const unsigned* pa = (const unsigned*)&a;
            uint4 o;
            unsigned* po = (unsigned*)&o;
#pragma unroll
            for (int e = 0; e < 4; ++e) po[e] = pk2(bf2f(pa[e] & 0xffff) * wk[j0 + 2 * e], bf2f(pa[e] >> 16) * wk[j0 + 2 * e + 1]);
            af[mi][ks] = __builtin_bit_cast(bf16x8, o);
        }
#pragma unroll
    for (int nh = 0; nh < 2; ++nh) {
        f32x4 acc[2][8];
#pragma unroll
        for (int mi = 0; mi < 2; ++mi)
#pragma unroll
            for (int ni = 0; ni < 8; ++ni) acc[mi][ni] = f32x4{0.f, 0.f, 0.f, 0.f};
#pragma unroll
        for (int ni = 0; ni < 8; ++ni)
#pragma unroll
            for (int ks = 0; ks < 2; ++ks)
#pragma unroll
                for (int mi = 0; mi < 2; ++mi) acc[mi][ni] = mfma16(af[mi][ks], vfr[nh][ni][ks], acc[mi][ni]);
#pragma unroll
        for (int mi = 0; mi < 2; ++mi)
#pragma unroll
            for (int ni = 0; ni < 8; ++ni) {
                const int dv = nh * 128 + ni * 16 + (lane & 15), d = 32 * w + 16 * mi + (lane >> 4) * 4;
                *(uint2*)(UT + (((size_t)bh * 128 + c) * 256 + dv) * 128 + d) = pk4(acc[mi][ni]);
            }
    }
    __syncthreads();
}

DI void phase5(const Params& p, unsigned char* smem, const int tid, const int vb, const int nvb) {
    unsigned char* ws = p.ws;
    const bf16_t* us = (const bf16_t*)(ws + 7 * U_);
    const bf16_t* kc = (const bf16_t*)(ws + OFF_KC);
    const bf16_t* cmat = (const bf16_t*)(ws + OFF_CMAT);
    const bf16_t* xcar = (const bf16_t*)((unsigned char*)p.out + (size_t)40 * 1048576);
    bf16_t* ys = (bf16_t*)p.out;
    const float* dsk = p.in[19];
    for (int it = vb; it < 1024; it += nvb) {
        const int g = it >> 5, mt = (it < 512) ? (7 - ((it >> 2) & 7)) : ((it >> 2) & 7), nt = it & 3;
        const int ktz = 128 * (mt + 1);
        const int nk = 2 * (mt + 1) + 2;
        auto la = [=](int r, int kv) -> uint4 {
            const int m = mt * 128 + r;
            if (kv < ktz) {
                const int t = m >> 4, c = m & 15, j = kv >> 4, c0 = kv & 15;
                if (j > t) return make_uint4(0, 0, 0, 0);
                return *(const uint4*)(kc + (((size_t)(g * 64 + (t - j)) * 16 + c) * 16 + c0));
            }
            return *(const uint4*)(cmat + ((size_t)(g * 1024 + m)) * 128 + (kv - ktz));
        };
        auto lb = [=](int r, int kv) -> uint4 {
            const int n = nt * 128 + r;
            if (kv < ktz) return *(const uint4*)(us + ((size_t)g * 512 + n) * 1024 + kv);
            return *(const uint4*)(xcar + ((size_t)n * 32 + g) * 128 + (kv - ktz));
        };
        f32x4 acc[4][4];
        gemm_tile(smem, tid, nk, la, lb, acc);
        epi_loop(acc, tid, [&](const int epi_f, const int epi_t, const f32x4 accv) __attribute__((always_inline)) {
            const int m = mt * 128 + epi_f, n = nt * 128 + epi_t;
            const int t = m >> 4, c = m & 15;
            const size_t tok = (size_t)n * 64 + t;
            const int ch = g * 16 + c;
            uint2 uu = *(const uint2*)(us + (((size_t)g * 512 + n) * 64 + t) * 16 + c);
            float4 dd = *(const float4*)(dsk + ch);
            f32x4 v = accv;
            v[0] = gelu_t(v[0] + dd.x * bf2f(uu.x & 0xffff));
            v[1] = gelu_t(v[1] + dd.y * bf2f(uu.x >> 16));
            v[2] = gelu_t(v[2] + dd.z * bf2f(uu.y & 0xffff));
            v[3] = gelu_t(v[3] + dd.w * bf2f(uu.y >> 16));
            *(uint2*)(ys + tok * 512 + ch) = pk4(v);
        });
    }
    for (int u = vb; u < 2048; u += nvb) mlstm_u_unit(p, smem, tid, u);
}

DI void phase6_scan(const Params& p) {
    unsigned char* ws = p.ws;
    const int tid = fresh_tid();
    for (int it = blockIdx.x; it < 256; it += gridDim.x) {
        const int e4 = it * 512 + tid;
        const int bh = e4 >> 13;
        const size_t off = (size_t)(e4 & 8191) * 4;
        bf16_t* base = (bf16_t*)(ws + 1 * U_) + (size_t)bh * 128 * 32768 + off;
        const float* bl = (const float*)(ws + OFF_BLAST) + bh * 128;
        const float* ms = (const float*)(ws + OFF_MST) + bh * 132;
        float C[4] = {0.f, 0.f, 0.f, 0.f};
        uint2 nxt[16];
#pragma unroll
        for (int i = 0; i < 16; ++i) nxt[i] = *(const uint2*)(base + (size_t)i * 32768);
        for (int c8 = 0; c8 < 128; c8 += 16) {
            float decv[16];
#pragma unroll
            for (int i = 0; i < 16; ++i) decv[i] = __expf(bl[c8 + i] + ms[c8 + i] - ms[c8 + i + 1]);
#pragma unroll
            for (int i = 0; i < 16; ++i) {
                const int c = c8 + i;
                uint2 v = nxt[i];
                if (c + 16 < 128) nxt[i] = *(const uint2*)(base + (size_t)(c + 16) * 32768);
                *(uint2*)(base + (size_t)c * 32768) = make_uint2(pk2(C[0], C[1]), pk2(C[2], C[3]));
                const float dec = decv[i];
                C[0] = dec * C[0] + bf2f(v.x & 0xffff); C[1] = dec * C[1] + bf2f(v.x >> 16);
                C[2] = dec * C[2] + bf2f(v.y & 0xffff); C[3] = dec * C[3] + bf2f(v.y >> 16);
            }
        }
    }
    if (blockIdx.x >= gridDim.x - 4) {
        const int e = (blockIdx.x - (gridDim.x - 4)) * 512 + tid;
        const int bh = e >> 7, d = e & 127;
        float* nb = (float*)(ws + OFF_NU) + (size_t)bh * 128 * 128 + d;
        const float* bl = (const float*)(ws + OFF_BLAST) + bh * 128;
        const float* ms = (const float*)(ws + OFF_MST) + bh * 132;
        float n = 0.f;
        for (int c0 = 0; c0 < 128; c0 += 16) {
            float vv[16], dd[16];
#pragma unroll
            for (int i = 0; i < 16; ++i) { vv[i] = nb[(c0 + i) * 128]; dd[i] = __expf(bl[c0 + i] + ms[c0 + i] - ms[c0 + i + 1]); }
#pragma unroll
            for (int i = 0; i < 16; ++i) { nb[(c0 + i) * 128] = n; n = dd[i] * n + vv[i]; }
        }
    }
}
struct EpiGlu {
    bf16_t* yb;
    DI void operator()(const f32x4 (&acc)[2][2][4][2], const pg8::Unit& u, int wr, int wc, int fr, int fq) const {
        pg8::epi8(acc, u, wr, wc, fr, fq, [&](int t, int col8, f32x4 v0, f32x4 v1) __attribute__((always_inline)) {
            f32x4 o;
#pragma unroll
            for (int r = 0; r < 4; ++r) o[r] = v0[r] * sigm(v1[r]);
            *(uint2*)(yb + (size_t)t * 1024 + (col8 >> 1)) = pk4(o);
        });
    }
};

DI void mlstm_out_unit(const Params& p, unsigned char* smem, const int tid, int u) {
    unsigned char* ws = p.ws;
    const int lane = tid & 63, w = tid >> 6;
    const int bh = u >> 7, c = u & 127, b = bh >> 2, h = bh & 3;
    float* gk = (float*)smem;
    float* bq = gk + 64;
    float* sci = bq + 64;
    float* emt = sci + 64;
    float* qn = emt + 64;
    float* rden = qn + 64;
    float* part = rden + 64;
    float* mean_s = part + 256;
    float* rstd_s = mean_s + 64;
    uint4* xs = (uint4*)(smem + 4096);
    const bf16_t* q = (const bf16_t*)((unsigned char*)p.out + U_);
    const bf16_t* k = q + (size_t)16 * 8192 * 128;
    const bf16_t* vT = (const bf16_t*)(ws + 3 * U_);
    const bf16_t* CT = (const bf16_t*)(ws + 1 * U_);
    const bf16_t* og = (const bf16_t*)(ws + 4 * U_);
    bf16_t* hm = (bf16_t*)p.out;
    const float mc = ((const float*)(ws + OFF_MST))[bh * 132 + c];
    const size_t tok0 = (size_t)bh * 8192 + c * 64;
    bf16x8 ctf[4][4];
    {
        const bf16_t* ctb0 = CT + (((size_t)bh * 128 + c) * 256 + 64 * w + (lane & 15)) * 128 + (lane >> 4) * 8;
#pragma unroll
        for (int ks = 0; ks < 4; ++ks)
#pragma unroll
            for (int i = 0; i < 4; ++i) ctf[ks][i] = ld16(ctb0 + (size_t)i * 16 * 128 + ks * 32);
    }
    if (w == 0) {
        float bj = ((const float*)(ws + OFF_BCUM))[tok0 + lane], ij = ((const float*)(ws + OFF_IG))[tok0 + lane];
        float g = ij - bj, pm = g;
        for (int d = 1; d < 64; d <<= 1) { float o = __shfl_up(pm, d, 64); if (lane >= d) pm = fmaxf(pm, o); }
        float mt = bj + fmaxf(mc, pm);
        gk[lane] = g; bq[lane] = bj - mt; sci[lane] = __expf(bj + mc - mt); emt[lane] = __expf(-mt);
    }
    {
        const int t = tid >> 2, p4 = tid & 3;
        const bf16_t* qr = q + (tok0 + t) * 128 + p4 * 32;
        const float* nr = (const float*)(ws + OFF_NU) + ((size_t)bh * 128 + c) * 128 + p4 * 32;
        float s = 0.f;
#pragma unroll
        for (int i = 0; i < 4; ++i) {
            uint4 a = *(const uint4*)(qr + i * 8);
            const unsigned* pa = (const unsigned*)&a;
#pragma unroll
            for (int e = 0; e < 4; ++e) s += bf2f(pa[e] & 0xffff) * nr[i * 8 + 2 * e] + bf2f(pa[e] >> 16) * nr[i * 8 + 2 * e + 1];
        }
        s += __shfl_xor(s, 1, 64); s += __shfl_xor(s, 2, 64);
        if (p4 == 0) qn[t] = s;
    }
    __syncthreads();
    {
        f32x4 X[4];
#pragma unroll
        for (int jt = 0; jt < 4; ++jt) X[jt] = f32x4{0.f, 0.f, 0.f, 0.f};
        const bf16_t* qb = q + (tok0 + 16 * w + (lane & 15)) * 128 + (lane >> 4) * 8;
        bf16x8 qf[4];
#pragma unroll
        for (int ks = 0; ks < 4; ++ks) qf[ks] = ld16(qb + ks * 32);
#pragma unroll
        for (int jt = 0; jt < 4; ++jt) {
            if (jt <= w) {
                const bf16_t* kb = k + (tok0 + 16 * jt + (lane & 15)) * 128 + (lane >> 4) * 8;
#pragma unroll
                for (int ks = 0; ks < 4; ++ks) X[jt] = mfma16(ld16(kb + ks * 32), qf[ks], X[jt]);
            }
        }
        const int t = 16 * w + (lane & 15);
        const float bqt = bq[t];
        float dsum = 0.f;
#pragma unroll
        for (int jt = 0; jt < 4; ++jt)
#pragma unroll
            for (int r = 0; r < 4; ++r) {
                const int j = 16 * jt + (lane >> 4) * 4 + r;
                float v = (j <= t) ? X[jt][r] * __expf(bqt + gk[j]) : 0.f;
                X[jt][r] = v; dsum += v;
            }
        dsum += __shfl_xor(dsum, 16, 64); dsum += __shfl_xor(dsum, 32, 64);
        if (lane < 16) { float den = dsum + sci[t] * qn[t]; rden[t] = 1.f / fmaxf(fabsf(den), emt[t]); }
#pragma unroll
        for (int pr = 0; pr < 2; ++pr) {
            uint2 lo = pk4(X[2 * pr]), hi = pk4(X[2 * pr + 1]);
            xs[(w * 2 + pr) * 64 + lane] = make_uint4(lo.x, lo.y, hi.x, hi.y);
        }
    }
    __syncthreads();
    f32x4 acc[4][4];
#pragma unroll
    for (int i = 0; i < 4; ++i)
#pragma unroll
        for (int j = 0; j < 4; ++j) acc[i][j] = f32x4{0.f, 0.f, 0.f, 0.f};
    {
        const bf16_t* qb = q + (tok0 + (lane & 15)) * 128 + (lane >> 4) * 8;
#pragma unroll
        for (int ks = 0; ks < 4; ++ks) {
            bf16x8 bfr[4];
#pragma unroll
            for (int i = 0; i < 4; ++i) bfr[i] = ld16(qb + (size_t)i * 16 * 128 + ks * 32);
#pragma unroll
            for (int i = 0; i < 4; ++i)
#pragma unroll
                for (int j = 0; j < 4; ++j) acc[i][j] = mfma16(ctf[ks][i], bfr[j], acc[i][j]);
        }
    }
#pragma unroll
    for (int ni = 0; ni < 4; ++ni) {
        const float s = sci[16 * ni + (lane & 15)];
#pragma unroll
        for (int mi = 0; mi < 4; ++mi) { acc[mi][ni][0] *= s; acc[mi][ni][1] *= s; acc[mi][ni][2] *= s; acc[mi][ni][3] *= s; }
    }
    {
        const bf16_t* vb = vT + (((size_t)bh * 128 + c) * 256 + 64 * w + (lane & 15)) * 64 + (lane >> 4) * 4;
#pragma unroll
        for (int pr = 0; pr < 2; ++pr) {
            bf16x8 af[4];
#pragma unroll
            for (int mi = 0; mi < 4; ++mi) {
                uint2 lo = *(const uint2*)(vb + (size_t)mi * 16 * 64 + pr * 32);
                uint2 hi = *(const uint2*)(vb + (size_t)mi * 16 * 64 + pr * 32 + 16);
                af[mi] = __builtin_bit_cast(bf16x8, make_uint4(lo.x, lo.y, hi.x, hi.y));
            }
#pragma unroll
            for (int ni = 0; ni < 4; ++ni) {
                if (ni >= 2 * pr) {
                    bf16x8 xb = __builtin_bit_cast(bf16x8, xs[(ni * 2 + pr) * 64 + lane]);
#pragma unroll
                    for (int mi = 0; mi < 4; ++mi) acc[mi][ni] = mfma16(af[mi], xb, acc[mi][ni]);
                }
            }
        }
    }
#pragma unroll
    for (int ni = 0; ni < 4; ++ni) {
        const float rd = rden[16 * ni + (lane & 15)];
        float s = 0.f;
#pragma unroll
        for (int mi = 0; mi < 4; ++mi) { acc[mi][ni][0] *= rd; acc[mi][ni][1] *= rd; acc[mi][ni][2] *= rd; acc[mi][ni][3] *= rd;
            s += acc[mi][ni][0] + acc[mi][ni][1] + acc[mi][ni][2] + acc[mi][ni][3]; }
        s += __shfl_xor(s, 16, 64); s += __shfl_xor(s, 32, 64);
        if (lane < 16) part[w * 64 + 16 * ni + lane] = s;
    }
    __syncthreads();
    if (tid < 64) mean_s[tid] = (part[tid] + part[64 + tid] + part[128 + tid] + part[192 + tid]) * (1.f / 256.f);
    __syncthreads();
#pragma unroll
    for (int ni = 0; ni < 4; ++ni) {
        const float mu = mean_s[16 * ni + (lane & 15)];
        float s = 0.f;
#pragma unroll
        for (int mi = 0; mi < 4; ++mi)
#pragma unroll
            for (int r = 0; r < 4; ++r) { float d = acc[mi][ni][r] - mu; s += d * d; }
        s += __shfl_xor(s, 16, 64); s += __shfl_xor(s, 32, 64);
        if (lane < 16) part[w * 64 + 16 * ni + lane] = s;
    }
    __syncthreads();
    if (tid < 64) rstd_s[tid] = rsqrtf((part[tid] + part[64 + tid] + part[128 + tid] + part[192 + tid]) * (1.f / 256.f) + 1e-5f);
    __syncthreads();
    const float* gain = p.in[10];
    float4 gg[4];
    unsigned ogv[4][4];
#pragma unroll
    for (int mi = 0; mi < 4; ++mi) gg[mi] = *(const float4*)(gain + h * 256 + 64 * w + 16 * mi + (lane >> 4) * 4);
#pragma unroll
    for (int ni = 0; ni < 4; ++ni)
#pragma unroll
        for (int mi = 0; mi < 4; ++mi)
            ogv[ni][mi] = *(const unsigned*)((const unsigned char*)og + ((size_t)b * 8192 + c * 64 + 16 * ni + (lane & 15)) * 1024 + h * 256 + 64 * w + 16 * mi + (lane >> 4) * 4);
#pragma unroll
    for (int ni = 0; ni < 4; ++ni) {
        const int t = 16 * ni + (lane & 15);
        const float mu = mean_s[t], rs = rstd_s[t];
        const size_t tok = (size_t)b * 8192 + c * 64 + t;
#pragma unroll
        for (int mi = 0; mi < 4; ++mi) {
            const int ch = h * 256 + 64 * w + 16 * mi + (lane >> 4) * 4;
            const f32x4 o2 = un4u8(ogv[ni][mi]);
            f32x4 o;
            o[0] = (acc[mi][ni][0] - mu) * rs * gg[mi].x * o2[0];
            o[1] = (acc[mi][ni][1] - mu) * rs * gg[mi].y * o2[1];
            o[2] = (acc[mi][ni][2] - mu) * rs * gg[mi].z * o2[2];
            o[3] = (acc[mi][ni][3] - mu) * rs * gg[mi].w * o2[3];
            *(uint2*)(hm + tok * 1024 + ch) = pk4(o);
        }
    }
    __syncthreads();
}

struct EpiDown {
    const unsigned char *sga, *sgb; const bf16_t* yb; bf16_t* ymix;
    DI void operator()(const f32x4 (&acc)[2][2][4][2], const pg8::Unit& u, int wr, int wc, int fr, int fq) const {
        const size_t o0 = (size_t)(u.pm * 256 + wr * 64 + fr) * 1024 + u.pn * 256 + wc * 32 + 8 * fq;
#define TOFF(i) (o0 + (size_t)(TILE_AI(i) * 128 + TILE_M(i) * 16) * 1024 + TILE_BJ(i) * 128)
        uint2 A[2], B[2]; uint4 Y[2];
        A[0] = *(const uint2*)(sga + TOFF(0)); B[0] = *(const uint2*)(sgb + TOFF(0)); Y[0] = *(const uint4*)(yb + TOFF(0));
#pragma unroll
        for (int i = 0; i < 16; ++i) {
            if (i + 1 < 16) { A[(i + 1) & 1] = *(const uint2*)(sga + TOFF(i + 1)); B[(i + 1) & 1] = *(const uint2*)(sgb + TOFF(i + 1)); Y[(i + 1) & 1] = *(const uint4*)(yb + TOFF(i + 1)); }
            const uint4 y = Y[i & 1];
            const f32x4 a0 = un4u8(A[i & 1].x), a1 = un4u8(A[i & 1].y), b0 = un4u8(B[i & 1].x), b1 = un4u8(B[i & 1].y);
            const f32x4 v0 = acc[TILE_AI(i)][TILE_BJ(i)][TILE_M(i)][0], v1 = acc[TILE_AI(i)][TILE_BJ(i)][TILE_M(i)][1];
            f32x4 r0, r1;
            r0[0] = a0[0] * v0[0] + b0[0] * bf2f(y.x & 0xffff);
            r0[1] = a0[1] * v0[1] + b0[1] * bf2f(y.x >> 16);
            r0[2] = a0[2] * v0[2] + b0[2] * bf2f(y.y & 0xffff);
            r0[3] = a0[3] * v0[3] + b0[3] * bf2f(y.y >> 16);
            r1[0] = a1[0] * v1[0] + b1[0] * bf2f(y.z & 0xffff);
            r1[1] = a1[1] * v1[1] + b1[1] * bf2f(y.z >> 16);
            r1[2] = a1[2] * v1[2] + b1[2] * bf2f(y.w & 0xffff);
            r1[3] = a1[3] * v1[3] + b1[3] * bf2f(y.w >> 16);
            *(uint4*)(ymix + TOFF(i)) = pk8(r0, r1);
        }
    }
};
struct EpiRes {
    const float* res; const float* gmod; bf16_t* dst;
    DI void operator()(const f32x4 (&acc)[2][2][4][2], const pg8::Unit& u, int wr, int wc, int fr, int fq) const {
        const int t0 = u.pm * 256 + wr * 64 + fr, colb = u.pn * 256 + wc * 32 + 8 * fq;
        const size_t o0 = (size_t)t0 * 1024 + colb;
        f32x4 gg[2][2];
#pragma unroll
        for (int bj = 0; bj < 2; ++bj) { const float* gp = gmod + (t0 >> 13) * 6144 + colb + bj * 128; gg[bj][0] = *(const f32x4*)gp + 1.f; gg[bj][1] = *(const f32x4*)(gp + 4) + 1.f; }
        f32x4 X0[2], X1[2];
        X0[0] = *(const f32x4*)(res + TOFF(0)); X1[0] = *(const f32x4*)(res + TOFF(0) + 4);
#pragma unroll
        for (int i = 0; i < 16; ++i) {
            if (i + 1 < 16) { X0[(i + 1) & 1] = *(const f32x4*)(res + TOFF(i + 1)); X1[(i + 1) & 1] = *(const f32x4*)(res + TOFF(i + 1) + 4); }
            const int bj = TILE_BJ(i);
            const f32x4 r0 = X0[i & 1] * ALPHA_ + gg[bj][0] * acc[TILE_AI(i)][bj][TILE_M(i)][0];
            const f32x4 r1 = X1[i & 1] * ALPHA_ + gg[bj][1] * acc[TILE_AI(i)][bj][TILE_M(i)][1];
            *(uint4*)(dst + TOFF(i)) = pk8(r0, r1);
        }
    }
};

struct EpiRes2 {
    const bf16_t* r1; const float2* stats; const float* lg; const float* lb; const float* gmod; bf16_t* dst;
    DI void operator()(const f32x4 (&acc)[2][2][4][2], const pg8::Unit& u, int wr, int wc, int fr, int fq) const {
        const int t0 = u.pm * 256 + wr * 64 + fr, colb = u.pn * 256 + wc * 32 + 8 * fq;
        const size_t o0 = (size_t)t0 * 1024 + colb;
        f32x4 gg[2][2], la[2][2], lbv[2][2];
#pragma unroll
        for (int bj = 0; bj < 2; ++bj) {
            const float* gp = gmod + (t0 >> 13) * 6144 + colb + bj * 128;
            gg[bj][0] = *(const f32x4*)gp + 1.f; gg[bj][1] = *(const f32x4*)(gp + 4) + 1.f;
            la[bj][0] = *(const f32x4*)(lg + colb + bj * 128) * ALPHA_; la[bj][1] = *(const f32x4*)(lg + colb + bj * 128 + 4) * ALPHA_;
            lbv[bj][0] = *(const f32x4*)(lb + colb + bj * 128) * ALPHA_; lbv[bj][1] = *(const f32x4*)(lb + colb + bj * 128 + 4) * ALPHA_;
        }
        float2 st[8];
#pragma unroll
        for (int j = 0; j < 8; ++j) st[j] = stats[t0 + (j >> 2) * 128 + (j & 3) * 16];
        uint4 XR[2];
        XR[0] = *(const uint4*)(r1 + TOFF(0));
#pragma unroll
        for (int i = 0; i < 16; ++i) {
            if (i + 1 < 16) XR[(i + 1) & 1] = *(const uint4*)(r1 + TOFF(i + 1));
            const int bj = TILE_BJ(i);
            const float2 s2 = st[i >> 1];
            const uint4 xr = XR[i & 1];
            const f32x4 X0 = {bf2f(xr.x & 0xffff), bf2f(xr.x >> 16), bf2f(xr.y & 0xffff), bf2f(xr.y >> 16)};
            const f32x4 X1 = {bf2f(xr.z & 0xffff), bf2f(xr.z >> 16), bf2f(xr.w & 0xffff), bf2f(xr.w >> 16)};
            const f32x4 r0 = ((X0 - s2.x) * s2.y) * la[bj][0] + lbv[bj][0] + gg[bj][0] * acc[TILE_AI(i)][bj][TILE_M(i)][0];
            const f32x4 r1v = ((X1 - s2.x) * s2.y) * la[bj][1] + lbv[bj][1] + gg[bj][1] * acc[TILE_AI(i)][bj][TILE_M(i)][1];
            *(uint4*)(dst + TOFF(i)) = pk8(r0, r1v);
        }
    }
};
#undef TOFF

DI void phase10(const Params& p) {
    unsigned char* ws = p.ws;
    int ft_ = threadIdx.x; asm volatile("" : "+v"(ft_));
    const int lane = ft_ & 63, wid = ft_ >> 6;
    const float* mod = (const float*)(ws + OFF_MOD);
    const bf16_t* r1 = (const bf16_t*)(ws + 2 * U_);
    float2* stats = (float2*)(ws + OFF_STATS);
    bf16_t* h2 = (bf16_t*)(ws + 1 * U_);
    for (int row0 = (blockIdx.x * 8 + wid) * 4; row0 < T_; row0 += gridDim.x * 32) {
        float v[4][16];
#pragma unroll
        for (int rr = 0; rr < 4; ++rr)
#pragma unroll
            for (int i = 0; i < 4; ++i) { uint2 t = *(const uint2*)(r1 + (size_t)(row0 + rr) * 1024 + i * 256 + lane * 4); v[rr][4 * i] = bf2f(t.x & 0xffff); v[rr][4 * i + 1] = bf2f(t.x >> 16); v[rr][4 * i + 2] = bf2f(t.y & 0xffff); v[rr][4 * i + 3] = bf2f(t.y >> 16); }
#pragma unroll
        for (int rr = 0; rr < 4; ++rr) {
            const int row = row0 + rr;
            float mean, rstd; row_stats(v[rr], mean, rstd);
            if (lane == 0) stats[row] = make_float2(mean, rstd);
#pragma unroll
            for (int i = 0; i < 4; ++i) {
                int c = i * 256 + lane * 4;
                float4 g = *(const float4*)(p.in[22] + c), bb = *(const float4*)(p.in[23] + c);
                v[rr][4 * i] = (v[rr][4 * i] - mean) * rstd * g.x + bb.x;
                v[rr][4 * i + 1] = (v[rr][4 * i + 1] - mean) * rstd * g.y + bb.y;
                v[rr][4 * i + 2] = (v[rr][4 * i + 2] - mean) * rstd * g.z + bb.z;
                v[rr][4 * i + 3] = (v[rr][4 * i + 3] - mean) * rstd * g.w + bb.w;
            }
            row_stats(v[rr], mean, rstd);
            const float* mb = mod + (row >> 13) * 6144;
#pragma unroll
            for (int i = 0; i < 4; ++i) {
                int c = i * 256 + lane * 4;
                float4 sh = *(const float4*)(mb + 3072 + c), sc = *(const float4*)(mb + 4096 + c);
                f32x4 o;
                o[0] = (v[rr][4 * i] - mean) * rstd * (1.f + sc.x) + sh.x;
                o[1] = (v[rr][4 * i + 1] - mean) * rstd * (1.f + sc.y) + sh.y;
                o[2] = (v[rr][4 * i + 2] - mean) * rstd * (1.f + sc.z) + sh.z;
                o[3] = (v[rr][4 * i + 3] - mean) * rstd * (1.f + sc.w) + sh.w;
                *(uint2*)(h2 + (size_t)row * 1024 + c) = pk4(o);
            }
        }
    }
}

constexpr size_t HALO_ELEMS = (size_t)512 * 2 * FH;
struct EpiUpF {
    bf16_t* hid; const float* cw; const float* cb; float* glast; float* gfirst; float* vfirst;
    DI void operator()(const f32x4 (&acc)[2][2][4][2], const pg8::Unit& u, int wr, int wc, int fr, int fq) const {
        const int lane = fq * 16 + fr;
        const int src1 = (lane & 48) | ((fr + 15) & 15), src2 = (lane & 48) | ((fr + 14) & 15);
        float4 w0v[2], w1v[2], w2v[2], bbv[2];
#pragma unroll
        for (int bj = 0; bj < 2; ++bj) {
            const int hc = (u.pn * 256 + bj * 128 + wc * 32 + 8 * fq) >> 1;
            w0v[bj] = *(const float4*)(cw + hc); w1v[bj] = *(const float4*)(cw + FH + hc); w2v[bj] = *(const float4*)(cw + 2 * FH + hc); bbv[bj] = *(const float4*)(cb + hc);
        }
#pragma unroll
        for (int bj = 0; bj < 2; ++bj) {
            const int hc = (u.pn * 256 + bj * 128 + wc * 32 + 8 * fq) >> 1;
            const float4 w0 = w0v[bj], w1 = w1v[bj], w2 = w2v[bj], bb = bbv[bj];
#pragma unroll
            for (int ai = 0; ai < 2; ++ai) {
                f32x4 gprev = (f32x4){0.f, 0.f, 0.f, 0.f};
#pragma unroll
                for (int m = 0; m < 4; ++m) {
                    const f32x4 v = acc[ai][bj][m][0], g = acc[ai][bj][m][1];
                    f32x4 p1, p2;
#pragma unroll
                    for (int r = 0; r < 4; ++r) {
                        p1[r] = __builtin_bit_cast(float, __builtin_amdgcn_update_dpp(0, __builtin_bit_cast(int, (fr == 15) ? gprev[r] : g[r]), 0x121, 0xF, 0xF, false));
                        p2[r] = __builtin_bit_cast(float, __builtin_amdgcn_update_dpp(0, __builtin_bit_cast(int, (fr >= 14) ? gprev[r] : g[r]), 0x122, 0xF, 0xF, false));
                    }
                    const int row = u.pm * 256 + ai * 128 + wr * 64 + m * 16 + fr;
                    const int wb = row >> 6;
                    if (m == 0 && fr < 2) {
                        *(f32x4*)(gfirst + ((size_t)wb * 2 + fr) * FH + hc) = g;
                        *(f32x4*)(vfirst + ((size_t)wb * 2 + fr) * FH + hc) = v;
                    } else {
                        f32x4 o;
                        o[0] = gelu_t(bb.x + w0.x * p2[0] + w1.x * p1[0] + w2.x * g[0]) * v[0];
                        o[1] = gelu_t(bb.y + w0.y * p2[1] + w1.y * p1[1] + w2.y * g[1]) * v[1];
                        o[2] = gelu_t(bb.z + w0.z * p2[2] + w1.z * p1[2] + w2.z * g[2]) * v[2];
                        o[3] = gelu_t(bb.w + w0.w * p2[3] + w1.w * p1[3] + w2.w * g[3]) * v[3];
                        *(uint2*)(hid + (size_t)row * FH + hc) = pk4(o);
                    }
                    if (m == 3 && fr >= 14) *(f32x4*)(glast + ((size_t)wb * 2 + (fr - 14)) * FH + hc) = g;
                    gprev = g;
                }
            }
        }
    }
};

DI void phase12(const Params& p) {
    bf16_t* hid = (bf16_t*)(p.ws + 4 * U_);
    const float* glast = p.out;
    const float* gfirst = p.out + HALO_ELEMS;
    const float* vfirst = p.out + 2 * HALO_ELEMS;
    const float* cw = p.in[25];
    const float* cb = p.in[26];
    const int gtid = blockIdx.x * 512 + fresh_tid(), gstr = gridDim.x * 512;
    for (int idx = gtid; idx < 512 * 2 * (FH / 4); idx += gstr) {
        const int cgp = idx % (FH / 4), rr = (idx / (FH / 4)) & 1, wb = idx / (2 * (FH / 4));
        const int hc = cgp * 4;
        const bool seq_start = (wb & 127) == 0;
        const int pb = seq_start ? wb : wb - 1;
        const float pz = seq_start ? 0.f : 1.f;
        float4 la = *(const float4*)(glast + ((size_t)pb * 2 + 0) * FH + hc), lb = *(const float4*)(glast + ((size_t)pb * 2 + 1) * FH + hc);
        la.x *= pz; la.y *= pz; la.z *= pz; la.w *= pz; lb.x *= pz; lb.y *= pz; lb.z *= pz; lb.w *= pz;
        const float4 f0 = *(const float4*)(gfirst + ((size_t)wb * 2 + 0) * FH + hc), f1 = *(const float4*)(gfirst + ((size_t)wb * 2 + 1) * FH + hc);
        float4 gm2, gm1, g0;
        if (rr == 0) { gm2 = la; gm1 = lb; g0 = f0; } else { gm2 = lb; gm1 = f0; g0 = f1; }
        const float4 v = *(const float4*)(vfirst + ((size_t)wb * 2 + rr) * FH + hc);
        const float4 w0 = *(const float4*)(cw + hc), w1 = *(const float4*)(cw + FH + hc), w2 = *(const float4*)(cw + 2 * FH + hc), bb = *(const float4*)(cb + hc);
        f32x4 o;
        o[0] = gelu_t(bb.x + w0.x * gm2.x + w1.x * gm1.x + w2.x * g0.x) * v.x;
        o[1] = gelu_t(bb.y + w0.y * gm2.y + w1.y * gm1.y + w2.y * g0.y) * v.y;
        o[2] = gelu_t(bb.z + w0.z * gm2.z + w1.z * gm1.z + w2.z * g0.z) * v.z;
        o[3] = gelu_t(bb.w + w0.w * gm2.w + w1.w * gm1.w + w2.w * g0.w) * v.w;
        *(uint2*)(hid + ((size_t)wb * 64 + rr) * FH + hc) = pk4(o);
    }
}

DI void phase14(const Params& p) {
    int ft_ = threadIdx.x; asm volatile("" : "+v"(ft_));
    const int lane = ft_ & 63, wid = ft_ >> 6;
    for (int row0 = (blockIdx.x * 8 + wid) * 4; row0 < T_; row0 += gridDim.x * 32) {
        float v[4][16];
#pragma unroll
        for (int rr = 0; rr < 4; ++rr)
#pragma unroll
            for (int i = 0; i < 4; ++i) { uint2 t = *(const uint2*)((const bf16_t*)(p.ws + 1 * U_) + (size_t)(row0 + rr) * 1024 + i * 256 + lane * 4); v[rr][4 * i] = bf2f(t.x & 0xffff); v[rr][4 * i + 1] = bf2f(t.x >> 16); v[rr][4 * i + 2] = bf2f(t.y & 0xffff); v[rr][4 * i + 3] = bf2f(t.y >> 16); }
#pragma unroll
        for (int rr = 0; rr < 4; ++rr) {
            float* xr = p.out + (size_t)(row0 + rr) * 1024;
            float mean, rstd; row_stats(v[rr], mean, rstd);
#pragma unroll
            for (int i = 0; i < 4; ++i) {
                int c = i * 256 + lane * 4;
                float4 g = *(const float4*)(p.in[28] + c), bb = *(const float4*)(p.in[29] + c);
                *(float4*)(xr + c) = make_float4((v[rr][4 * i] - mean) * rstd * g.x + bb.x, (v[rr][4 * i + 1] - mean) * rstd * g.y + bb.y,
                                                 (v[rr][4 * i + 2] - mean) * rstd * g.z + bb.z, (v[rr][4 * i + 3] - mean) * rstd * g.w + bb.w);
            }
        }
    }
}

#define XB_TMO      128
#define XB_XCNT(j)  (256  + 64 * (j))
#define XB_XSUB(j)  (1280 + 64 * (j))
#define XB_XGEN(j)  (2304 + 64 * (j))
#define XB_TOP      3328
#define XB_TOPGEN   3392
#define XB_SPIN_CAP (1u << 22)
DI unsigned xb_ld(unsigned* p)              { return __hip_atomic_load(p, __ATOMIC_RELAXED, __HIP_MEMORY_SCOPE_AGENT); }
DI unsigned xb_add(unsigned* p, unsigned v) { return __hip_atomic_fetch_add(p, v, __ATOMIC_RELAXED, __HIP_MEMORY_SCOPE_AGENT); }
DI unsigned xb_xcc_id() { return (unsigned)__builtin_amdgcn_s_getreg((3 << 11) | 20) & 0xFu; }
#define XB_SPIN(cond, bar) do { unsigned _sp = 0; while (cond) { __builtin_amdgcn_s_sleep(1); \
    if ((++_sp & 255u) == 0u) { if (xb_ld(&(bar)[XB_TMO])) break; if (_sp > XB_SPIN_CAP) { atomicAdd(&(bar)[XB_TMO], 1u); break; } } } } while (0)
DI void xcd_barrier_complete(unsigned* bar, unsigned x, unsigned& nloc, unsigned& nx) {
    const unsigned G = gridDim.x;
    unsigned sum, cnt, mine, sp = 0u;
    for (;;) {
        sum = 0u; cnt = 0u; mine = 0u;
#pragma unroll
        for (unsigned j = 0; j < 16; ++j) { const unsigned c = xb_ld(&bar[XB_XCNT(j)]); sum += c; cnt += (c > 0u) ? 1u : 0u; mine = (j == x) ? c : mine; }
        if (sum == G) break;
        __builtin_amdgcn_s_sleep(1);
        if ((++sp & 255u) == 0u) { if (xb_ld(&bar[XB_TMO])) break; if (sp > XB_SPIN_CAP) { atomicAdd(&bar[XB_TMO], 1u); break; } }
    }
    nloc = mine > 0u ? mine : 1u; nx = cnt > 0u ? cnt : 1u;
}
DI void xcd_barrier(unsigned* bar, volatile __attribute__((address_space(3))) unsigned* st) {
    asm volatile("s_waitcnt vmcnt(0)" ::: "memory");
    __syncthreads();
    if (fresh_tid() == 0) {
        __builtin_amdgcn_s_waitcnt(0);
        const unsigned x = xb_xcc_id();
        unsigned nloc = st[0], nx = st[1];
        if (nloc == 0u) { xcd_barrier_complete(bar, x, nloc, nx); st[0] = nloc; st[1] = nx; }
        const unsigned old = xb_add(&bar[XB_XSUB(x)], 1u);
        const unsigned gen = old / nloc;
        if (old + 1u == (gen + 1u) * nloc) {
            __builtin_amdgcn_fence(__ATOMIC_RELEASE, "agent");
            asm volatile("s_waitcnt vmcnt(0)" ::: "memory");
            const unsigned og = xb_add(&bar[XB_TOP], 1u);
            const unsigned tg = og / nx;
            if (og + 1u == (tg + 1u) * nx) xb_add(&bar[XB_TOPGEN], 1u);
            else XB_SPIN(xb_ld(&bar[XB_TOPGEN]) == tg, bar);
            __builtin_amdgcn_fence(__ATOMIC_ACQUIRE, "agent");
            xb_add(&bar[XB_XGEN(x)], 1u);
            asm volatile("s_waitcnt vmcnt(0)" ::: "memory");
        } else {
            XB_SPIN(xb_ld(&bar[XB_XGEN(x)]) == gen, bar);
            __builtin_amdgcn_fence(__ATOMIC_ACQUIRE, "agent");
            asm volatile("s_waitcnt vmcnt(0)" ::: "memory");
        }
    }
    __syncthreads();
}

constexpr int LDS_BYTES = 131072;
__global__ void __launch_bounds__(512, 2) fwd_megakernel(Params p) {
    extern __shared__ __attribute__((aligned(16))) unsigned char lds[];
    cg::grid_group grid = cg::this_grid();
    unsigned* bar = (unsigned*)(p.ws + OFF_BAR);
    __shared__ __attribute__((aligned(16))) unsigned xb_st[4];
    volatile __attribute__((address_space(3))) unsigned* st = (volatile __attribute__((address_space(3))) unsigned*)xb_st;
    if (threadIdx.x < 4) xb_st[threadIdx.x] = 0u;
    __syncthreads();
    if (threadIdx.x == 0) (void)xb_add(&bar[XB_XCNT(xb_xcc_id())], 1u);
#define GSYNC() xcd_barrier(bar, st)
#define HALF_CTX int ft_ = threadIdx.x; asm volatile("" : "+v"(ft_)); const int half = ft_ >> 8, vtid = ft_ & 255; \
    const int vb = blockIdx.x * 2 + half, nvb = gridDim.x * 2; unsigned char* hsm = lds + half * 65536;
    PG8_LAS unsigned char* glds = (PG8_LAS unsigned char*)lds;
    unsigned char* ws = p.ws;
    pg8::StaticOrder S;
    if (p.out == nullptr) grid.sync();
    { HALF_CTX phase0(p, hsm, vtid, vb, nvb); }
    GSYNC();
    phase1(p, lds);
    GSYNC();
    {
        pg8::Gemm g{(const bf16_t*)(ws + 1 * U_), (const bf16_t*)(ws + OFF_WIN), 1024, 1024, 1024, 0};
        S.init(T_, 4608, gridDim.x, blockIdx.x);
        EpiIn E{p.in[5], (bf16_t*)(ws + 2 * U_), (bf16_t*)(ws + 3 * U_), (bf16_t*)(ws + 4 * U_), (bf16_t*)(ws + 5 * U_), (bf16_t*)(ws + 6 * U_), (bf16_t*)(ws + 7 * U_)};
        pg8::gemm_phase(glds, g, S, E);
    }
    GSYNC();
    { HALF_CTX phase3(p, hsm, vtid, vb, nvb); }
    GSYNC();
    phase4_small(p, lds);
    {
        bf16_t* q = (bf16_t*)((unsigned char*)p.out + U_);
        pg8::Gemm g{(const bf16_t*)(ws + 1 * U_), (const bf16_t*)(ws + OFF_WQK), 1024, 256, 256, 512};
        S.init(T_, 1024, gridDim.x, blockIdx.x);
        EpiQK E{q, q + (size_t)16 * 8192 * 128, (bf16_t*)(ws + 7 * U_ + U_ / 2)};
        pg8::gemm_phase(glds, g, S, E);
    }
    GSYNC();
    { HALF_CTX phase5(p, hsm, vtid, vb, nvb); }
    GSYNC();
    phase6_scan(p);
    {
        pg8::Gemm g{(const bf16_t*)p.out, (const bf16_t*)(ws + OFF_WGL), 512, 512, 512, 0};
        S.init(T_, 2048, gridDim.x, blockIdx.x);
        EpiGlu E{(bf16_t*)(ws + 7 * U_)};
        pg8::gemm_phase(glds, g, S, E);
    }
    GSYNC();
    { HALF_CTX for (int u = vb; u < 2048; u += nvb) mlstm_out_unit(p, hsm, vtid, u); }
    GSYNC();
    {
        pg8::Gemm g{(const bf16_t*)p.out, (const bf16_t*)(ws + OFF_WDN), 1024, 1024, 1024, 0};
        S.init(T_, 1024, gridDim.x, blockIdx.x);
        EpiDown E{(const unsigned char*)(ws + 5 * U_), (const unsigned char*)(ws + 6 * U_), (const bf16_t*)(ws + 7 * U_), (bf16_t*)(ws + 1 * U_)};
        pg8::gemm_phase(glds, g, S, E);
    }
    GSYNC();
    {
        pg8::Gemm g{(const bf16_t*)(ws + 1 * U_), (const bf16_t*)(ws + OFF_WMX), 1024, 1024, 1024, 0};
        S.init(T_, 1024, gridDim.x, blockIdx.x);
        EpiRes E{p.in[0], (const float*)(ws + OFF_MOD) + 2048, (bf16_t*)(ws + 2 * U_)};
        pg8::gemm_phase(glds, g, S, E);
    }
    GSYNC();
    phase10(p);
    GSYNC();
    {
        pg8::Gemm g{(const bf16_t*)(ws + 1 * U_), (const bf16_t*)(ws + OFF_WUP), 1024, 1024, 1024, 0};
        S.init(T_, 5632, gridDim.x, blockIdx.x);
        EpiUpF E{(bf16_t*)(ws + 4 * U_), p.in[25], p.in[26], p.out, p.out + HALO_ELEMS, p.out + 2 * HALO_ELEMS};
        pg8::gemm_phase(glds, g, S, E);
    }
    GSYNC();
    phase12(p);
    GSYNC();
    {
        pg8::Gemm g{(const bf16_t*)(ws + 4 * U_), (const bf16_t*)(ws + OFF_WFD), FH, FH, FH, 0};
        S.init(T_, 1024, gridDim.x, blockIdx.x);
        EpiRes2 E{(const bf16_t*)(ws + 2 * U_), (const float2*)(ws + OFF_STATS), p.in[22], p.in[23], (const float*)(ws + OFF_MOD) + 5120, (bf16_t*)(ws + 1 * U_)};
        pg8::gemm_phase(glds, g, S, E);
    }
    GSYNC();
    phase14(p);
}

extern "C" void kernel_launch(void* const* d_in, const int* in_sizes, int n_in, void* d_out, int out_size, void* d_ws, size_t ws_size, hipStream_t stream) {
    static int grid_blocks = 0;
    if (grid_blocks == 0) {
        if (n_in != 30 || out_size != T_ * 1024 || ws_size < 8 * U_) { fprintf(stderr, "kernel_launch: unexpected shapes (n_in %d out %d ws %zu)\n", n_in, out_size, ws_size); grid_blocks = -1; return; }
        int dev = 0, cus = 0, per_cu = 0;
        (void)hipGetDevice(&dev);
        (void)hipDeviceGetAttribute(&cus, hipDeviceAttributeMultiprocessorCount, dev);
        if (hipFuncSetAttribute((const void*)fwd_megakernel, hipFuncAttributeMaxDynamicSharedMemorySize, LDS_BYTES) != hipSuccess) { fprintf(stderr, "hipFuncSetAttribute failed\n"); grid_blocks = -1; return; }
        (void)hipOccupancyMaxActiveBlocksPerMultiprocessor(&per_cu, fwd_megakernel, 512, LDS_BYTES);
        if (per_cu < 1) { fprintf(stderr, "occupancy query says 0 blocks/CU\n"); per_cu = 1; }
        grid_blocks = cus;
    }
    if (grid_blocks < 0) return;
    Params p{};
    for (int i = 0; i < 30; ++i) p.in[i] = (const float*)d_in[i];
    p.out = (float*)d_out;
    p.ws = (unsigned char*)d_ws;
    if (hipMemsetAsync((unsigned char*)d_ws + OFF_BAR, 0, 16384, stream) != hipSuccess) { fprintf(stderr, "memset failed\n"); return; }
    void* args[] = {&p};
    hipError_t e = hipLaunchCooperativeKernel((const void*)fwd_megakernel, dim3(grid_blocks), dim3(512), args, LDS_BYTES, stream);
    if (e != hipSuccess) fprintf(stderr, "cooperative launch failed: %s (grid %d)\n", hipGetErrorString(e), grid_blocks);
}
```

```cpp
#include <hip/hip_runtime.h>
#include <hip/hip_cooperative_groups.h>
#include <cstdio>
#include <cstdint>
namespace cg = cooperative_groups;

#define DI __device__ __forceinline__
typedef unsigned short bf16_t;
typedef short bf16x8 __attribute__((ext_vector_type(8)));
typedef float f32x4 __attribute__((ext_vector_type(4)));

constexpr int T_ = 32768, S_ = 8192, FH = 2816;
constexpr size_t U_ = 67108864;
constexpr float ALPHA_ = 1.189207115002721f;

constexpr size_t OFF_WIN = 0;
constexpr size_t OFF_WQK = OFF_WIN + 9437184;
constexpr size_t OFF_WDN = OFF_WQK + 524288;
constexpr size_t OFF_WGL = OFF_WDN + 2097152;
constexpr size_t OFF_WMX = OFF_WGL + 2097152;
constexpr size_t OFF_WUP = OFF_WMX + 2097152;
constexpr size_t OFF_WFD = OFF_WUP + 11534336;
constexpr size_t OFF_MOD = OFF_WFD + 5767168;
constexpr size_t OFF_APOW = OFF_MOD + 98304;
constexpr size_t OFF_BBAR = OFF_APOW + 1064960;
constexpr size_t OFF_KC = OFF_BBAR + 262144;
constexpr size_t OFF_EMAT = OFF_KC + 1048576;
constexpr size_t OFF_CMAT = OFF_EMAT + 8388608;
constexpr size_t OFF_IG = OFF_CMAT + 8388608;
constexpr size_t OFF_LOGF = OFF_IG + 524288;
constexpr size_t OFF_BCUM = OFF_LOGF + 524288;
constexpr size_t OFF_AARR = OFF_BCUM + 524288;
constexpr size_t OFF_BLAST = OFF_AARR + 8192;
constexpr size_t OFF_MST = OFF_BLAST + 8192;
constexpr size_t OFF_NU = OFF_MST + 8448;
constexpr size_t OFF_BAR = OFF_NU + 1048576;
constexpr size_t OFF_STATS = OFF_BAR + 16384;
constexpr size_t OFF_END = OFF_STATS + 262144;
static_assert(OFF_END <= U_, "R0 overflow");

struct Params { const float* in[30]; float* out; unsigned char* ws; };

DI float bf2f(unsigned short h) { return __uint_as_float(((unsigned)h) << 16); }
typedef __bf16 bf16x2_t __attribute__((ext_vector_type(2)));
typedef float f32x2_t __attribute__((ext_vector_type(2)));
DI unsigned pk2(float lo, float hi) { f32x2_t v = {lo, hi}; bf16x2_t b = __builtin_convertvector(v, bf16x2_t); return __builtin_bit_cast(unsigned, b); }
DI unsigned short f2bf(float x) { return (unsigned short)(pk2(x, 0.f) & 0xffffu); }
DI uint2 pk4(f32x4 v) { return make_uint2(pk2(v[0], v[1]), pk2(v[2], v[3])); }
DI float sigm(float x) { return __builtin_amdgcn_rcpf(1.f + __expf(-x)); }
DI float gelu_t(float x) { float u = 1.5957691216057308f * (x + 0.044715f * x * x * x); return x * __builtin_amdgcn_rcpf(1.f + __expf(-u)); }
DI float logsig(float x) { return (x < 0.f) ? (x - log1pf(__expf(x))) : (-log1pf(__expf(-x))); }
DI bf16x8 ld16(const bf16_t* p) { return *reinterpret_cast<const bf16x8*>(p); }
DI f32x4 mfma16(bf16x8 a, bf16x8 b, f32x4 c) { return __builtin_amdgcn_mfma_f32_16x16x32_bf16(a, b, c, 0, 0, 0); }
DI int fresh_tid() { int t = threadIdx.x; asm volatile("" : "+v"(t)); return t; }
DI float dpp_f(float v, const int ctrl_sel) {
    int x = __builtin_bit_cast(int, v), r;
    if (ctrl_sel == 0) r = __builtin_amdgcn_update_dpp(0, x, 0xB1, 0xF, 0xF, false);
    else if (ctrl_sel == 1) r = __builtin_amdgcn_update_dpp(0, x, 0x4E, 0xF, 0xF, false);
    else if (ctrl_sel == 2) r = __builtin_amdgcn_update_dpp(0, x, 0x141, 0xF, 0xF, false);
    else r = __builtin_amdgcn_update_dpp(0, x, 0x140, 0xF, 0xF, false);
    return __builtin_bit_cast(float, r);
}
DI float wsum(float v) {
    v += dpp_f(v, 0); v += dpp_f(v, 1); v += dpp_f(v, 2); v += dpp_f(v, 3);
    const int x = __builtin_bit_cast(int, v);
    return __builtin_bit_cast(float, __builtin_amdgcn_readlane(x, 0)) + __builtin_bit_cast(float, __builtin_amdgcn_readlane(x, 16))
         + __builtin_bit_cast(float, __builtin_amdgcn_readlane(x, 32)) + __builtin_bit_cast(float, __builtin_amdgcn_readlane(x, 48));
}

template <class LA, class LB>
DI void gemm_tile(unsigned char* smem, const int tid, int nk, LA la, LB lb, f32x4 (&acc)[4][4]) {
    const int lane = tid & 63, wid = tid >> 6;
    const int wf = wid >> 1, wt = wid & 1;
    const int lr = tid >> 3, lc = tid & 7;
    unsigned char* sA = smem;
    unsigned char* sB = smem + 32768;
#pragma unroll
    for (int i = 0; i < 4; ++i)
#pragma unroll
        for (int j = 0; j < 4; ++j) acc[i][j] = f32x4{0.f, 0.f, 0.f, 0.f};
    uint4 ra[4], rb[4], na[4], nb[4];
#pragma unroll
    for (int i = 0; i < 4; ++i) { ra[i] = la(lr + 32 * i, lc * 8); rb[i] = lb(lr + 32 * i, lc * 8); }
    if (nk > 1) {
#pragma unroll
        for (int i = 0; i < 4; ++i) { na[i] = la(lr + 32 * i, 64 + lc * 8); nb[i] = lb(lr + 32 * i, 64 + lc * 8); }
    }
    const int woff = lr * 128 + ((lc ^ ((lr >> 1) & 7)) << 4);
#pragma unroll
    for (int i = 0; i < 4; ++i) { *(uint4*)(sA + woff + i * 4096) = ra[i]; *(uint4*)(sB + woff + i * 4096) = rb[i]; }
    __syncthreads();
    const int frow = lane & 15, fq = lane >> 4, fsw = (frow >> 1) & 7;
    for (int kt = 0; kt < nk; ++kt) {
        const int cur = kt & 1;
#pragma unroll
        for (int i = 0; i < 4; ++i) { ra[i] = na[i]; rb[i] = nb[i]; }
        if (kt + 2 < nk) {
#pragma unroll
            for (int i = 0; i < 4; ++i) { na[i] = la(lr + 32 * i, (kt + 2) * 64 + lc * 8); nb[i] = lb(lr + 32 * i, (kt + 2) * 64 + lc * 8); }
        }
        const unsigned char* cA = sA + cur * 16384 + (wf * 64 + frow) * 128;
        const unsigned char* cB = sB + cur * 16384 + (wt * 64 + frow) * 128;
#pragma unroll
        for (int ks = 0; ks < 2; ++ks) {
            const int ch = ((ks * 4 + fq) ^ fsw) << 4;
            bf16x8 af[4], bfr[4];
#pragma unroll
            for (int i = 0; i < 4; ++i) { af[i] = *(const bf16x8*)(cA + i * 2048 + ch); bfr[i] = *(const bf16x8*)(cB + i * 2048 + ch); }
#pragma unroll
            for (int i = 0; i < 4; ++i)
#pragma unroll
                for (int j = 0; j < 4; ++j) acc[i][j] = mfma16(af[i], bfr[j], acc[i][j]);
        }
        if (kt + 1 < nk) {
            const int nbuf = (cur ^ 1) * 16384;
#pragma unroll
            for (int i = 0; i < 4; ++i) { *(uint4*)(sA + nbuf + woff + i * 4096) = ra[i]; *(uint4*)(sB + nbuf + woff + i * 4096) = rb[i]; }
        }
        __syncthreads();
    }
}
template <class F>
DI void epi_loop(f32x4 (&acc)[4][4], const int vtid_, F f) {
    const int lane_ = vtid_ & 63, wid_ = vtid_ >> 6, wf_ = wid_ >> 1, wt_ = wid_ & 1;
#pragma unroll
    for (int fi = 0; fi < 4; ++fi)
#pragma unroll
        for (int ti = 0; ti < 4; ++ti) f(wf_ * 64 + fi * 16 + (lane_ >> 4) * 4, wt_ * 64 + ti * 16 + (lane_ & 15), acc[fi][ti]);
}


namespace pg8 {
#define PG8_LAS __attribute__((address_space(3)))
constexpr int BM = 256, BK = 64, HALF = 128, HTB = HALF * BK * 2, NXCD = 8, WGM = 4;
DI int lds_byte(int r, int c) { const int st = (r >> 4) * 2 + (c >> 5), rr = r & 15, cc = c & 31, ob = rr * 64 + cc * 2; return st * 1024 + (ob ^ (((ob >> 9) & 1) << 5)); }
DI void stage_rc(int b, int& R, int& C) { const int st = b / 1024, sb = b % 1024, swz = sb ^ (((sb >> 9) & 1) << 5); R = (st >> 1) * 16 + swz / 64; C = (st & 1) * 32 + (swz % 64) / 2; }
DI int perm32(int rho) { const int n = rho >> 4, i = rho & 15; return 8 * (i >> 2) + 4 * n + (i & 3); }
struct Unit { int pm, pn; };
struct Gemm { const bf16_t* A; const bf16_t* Bt; int lda, ldb, K, a_pn_off; };
struct StaticOrder {
    int nM, nN, nwg, G, c;
    DI void init(int M, int N, int G_, int c_) { nM = M / BM; nN = N / BM; nwg = nM * nN; G = G_; c = c_; }
    DI bool next(int i, Unit& u) const {
        const long L = (long)i * G + c; if (L >= nwg) return false;
        int wgid = (int)L; { const int q = nwg / NXCD, r = nwg % NXCD, xcd = wgid % NXCD, off = wgid / NXCD; wgid = (xcd < r ? xcd * (q + 1) : r * (q + 1) + (xcd - r) * q) + off; }
        const int nig = WGM * nN, gid = wgid / nig, fm = gid * WGM, gsz = (nM - fm) < WGM ? (nM - fm) : WGM;
        u.pm = fm + ((wgid % nig) % gsz); u.pn = (wgid % nig) / gsz; return true;
    }
};
template <class Epi>
DI void gemm_phase(PG8_LAS unsigned char* lds, const Gemm g, const StaticOrder& S, const Epi& E) {
    int tid = threadIdx.x; asm volatile("" : "+v"(tid));
    const int wid = __builtin_amdgcn_readfirstlane(tid >> 6), lane = tid & 63, wr = wid >> 2, wc = wid & 3, fr = lane & 15, fq = lane >> 4;
    const int nt = g.K / BK;
    unsigned voffA[2], voffB[2];
#pragma unroll
    for (int i = 0; i < 2; ++i) { int R, C; stage_rc(tid * 16 + i * 8192, R, C); const int Rb = (R & ~31) + perm32(R & 31);
        voffA[i] = (unsigned)(R * g.lda + C) * 2u; voffB[i] = (unsigned)(Rb * g.ldb + C) * 2u; }
    const size_t kstep = (size_t)(BK * 2);
    const size_t hstepA = (size_t)HALF * g.lda * 2, hstepB = (size_t)HALF * g.ldb * 2;
    const size_t tstepA = 2 * hstepA, tstepB = 2 * hstepB;
    const unsigned ldsw = (unsigned)wid * 1024u;
    const int aoff = lds_byte(wr * 64 + fr, fq * 8), boff = lds_byte(wc * 32 + fr, fq * 8);
#define PG8_SA(b, h) (((b) * 2 + (h)) * HTB)
#define PG8_SB(b, h) ((4 + (b) * 2 + (h)) * HTB)
#define PG8_STAGE(bufoff, gbase, voff) do { _Pragma("unroll") for (int _i = 0; _i < 2; ++_i) \
        __builtin_amdgcn_global_load_lds((const unsigned*)((const char*)(gbase) + (voff)[_i]), (PG8_LAS unsigned*)(lds + (bufoff) + ldsw + _i * 8192), 16, 0, 0); } while (0)
#define PG8_LDA(dst, b, h) do { _Pragma("unroll") for (int m = 0; m < 4; ++m) _Pragma("unroll") for (int k = 0; k < 2; ++k) dst[m][k] = *(const PG8_LAS bf16x8*)(lds + PG8_SA(b, h) + aoff + m * 2048 + k * 1024); } while (0)
#define PG8_LDB(dst, b, h) do { _Pragma("unroll") for (int n = 0; n < 2; ++n) _Pragma("unroll") for (int k = 0; k < 2; ++k) dst[n][k] = *(const PG8_LAS bf16x8*)(lds + PG8_SB(b, h) + boff + n * 2048 + k * 1024); } while (0)
#define PG8_MMA(ai, bj, At, Bt) do { __builtin_amdgcn_s_setprio(1); _Pragma("unroll") for (int m = 0; m < 4; ++m) _Pragma("unroll") for (int n = 0; n < 2; ++n) _Pragma("unroll") for (int k = 0; k < 2; ++k) \
        acc[ai][bj][m][n] = __builtin_amdgcn_mfma_f32_16x16x32_bf16(Bt[n][k], At[m][k], acc[ai][bj][m][n], 0, 0, 0); __builtin_amdgcn_s_setprio(0); } while (0)
#define PG8_WAIT_V(n) asm volatile("s_waitcnt vmcnt(" #n ")" ::: "memory")
#define PG8_WAIT_L(n) asm volatile("s_waitcnt lgkmcnt(" #n ")" ::: "memory")
#define PG8_BAR __builtin_amdgcn_s_barrier()
#define PG8_SCHED __builtin_amdgcn_sched_barrier(0)
    Unit cur, nxt; int ui = 0;
    if (!S.next(0, cur)) return;
    f32x4 acc[2][2][4][2];
#pragma unroll
    for (int a = 0; a < 2; ++a)
#pragma unroll
        for (int b = 0; b < 2; ++b)
#pragma unroll
            for (int m = 0; m < 4; ++m)
#pragma unroll
                for (int n = 0; n < 2; ++n) acc[a][b][m][n] = (f32x4){0.f, 0.f, 0.f, 0.f};
    bf16x8 At[4][2], B0[2][2], B1[2][2];
    const char* cA = (const char*)g.A + (size_t)cur.pm * tstepA + (size_t)cur.pn * g.a_pn_off; const char* cB = (const char*)g.Bt + (size_t)cur.pn * tstepB;
    PG8_STAGE(PG8_SB(0, 0), cB, voffB); PG8_STAGE(PG8_SB(0, 1), cB + hstepB, voffB); PG8_STAGE(PG8_SA(0, 0), cA, voffA); PG8_STAGE(PG8_SA(0, 1), cA + hstepA, voffA);
    if (wr == 1) PG8_BAR;
    PG8_WAIT_V(2); PG8_BAR;
    PG8_STAGE(PG8_SB(1, 0), cB + kstep, voffB); PG8_STAGE(PG8_SA(1, 0), cA + kstep, voffA); PG8_STAGE(PG8_SB(1, 1), cB + hstepB + kstep, voffB);
    PG8_WAIT_V(6); PG8_BAR;
    for (;;) {
        const bool has_next = S.next(ui + 1, nxt);
        const char* nA = has_next ? (const char*)g.A + (size_t)nxt.pm * tstepA + (size_t)nxt.pn * g.a_pn_off : cA; const char* nB = has_next ? (const char*)g.Bt + (size_t)nxt.pn * tstepB : cB;
        for (int t = 0; t < nt; t += 2) {
            const bool last = (t == nt - 2);
            const char* a1 = cA + (size_t)(t + 1) * kstep;
            const char* a2 = last ? nA : cA + (size_t)(t + 2) * kstep; const char* b2 = last ? nB : cB + (size_t)(t + 2) * kstep;
            const char* a3 = a2 + kstep; const char* b3 = b2 + kstep;
            PG8_LDB(B0, 0, 0); PG8_LDB(B1, 0, 1); PG8_SCHED; PG8_LDA(At, 0, 0); PG8_STAGE(PG8_SA(1, 1), a1 + hstepA, voffA);
            PG8_WAIT_V(8); PG8_WAIT_L(0); PG8_BAR; PG8_MMA(0, 0, At, B0); PG8_MMA(0, 1, At, B1); PG8_BAR; PG8_SCHED;
            PG8_LDA(At, 0, 1); PG8_STAGE(PG8_SB(0, 0), b2, voffB); PG8_STAGE(PG8_SB(0, 1), b2 + hstepB, voffB); PG8_STAGE(PG8_SA(0, 0), a2, voffA);
            PG8_WAIT_V(8); PG8_WAIT_L(0); PG8_BAR; PG8_MMA(1, 0, At, B0); PG8_MMA(1, 1, At, B1); PG8_BAR; PG8_SCHED;
            PG8_LDB(B0, 1, 0); PG8_LDB(B1, 1, 1); PG8_SCHED; PG8_LDA(At, 1, 0); PG8_STAGE(PG8_SA(0, 1), a2 + hstepA, voffA);
            PG8_WAIT_V(8); PG8_WAIT_L(0); PG8_BAR; PG8_MMA(0, 0, At, B0); PG8_MMA(0, 1, At, B1); PG8_BAR; PG8_SCHED;
            PG8_LDA(At, 1, 1); PG8_STAGE(PG8_SB(1, 0), b3, voffB); PG8_STAGE(PG8_SB(1, 1), b3 + hstepB, voffB); PG8_STAGE(PG8_SA(1, 0), a3, voffA);
            PG8_WAIT_V(8); PG8_WAIT_L(0); PG8_BAR; PG8_MMA(1, 0, At, B0); PG8_MMA(1, 1, At, B1); PG8_BAR; PG8_SCHED;
        }
        if (wr == 0) PG8_BAR;
        { int efr = fr, efq = fq; asm volatile("" : "+v"(efr), "+v"(efq)); E(acc, cur, wr, wc, efr, efq); }
        if (!has_next) break;
#pragma unroll
        for (int a = 0; a < 2; ++a)
#pragma unroll
            for (int b = 0; b < 2; ++b)
#pragma unroll
                for (int m = 0; m < 4; ++m)
#pragma unroll
                    for (int n = 0; n < 2; ++n) acc[a][b][m][n] = (f32x4){0.f, 0.f, 0.f, 0.f};
        cur = nxt; cA = nA; cB = nB; ++ui;
        if (wr == 1) PG8_BAR;
    }
    PG8_WAIT_V(0);
    PG8_BAR;
#undef PG8_SA
#undef PG8_SB
#undef PG8_STAGE
#undef PG8_LDA
#undef PG8_LDB
#undef PG8_MMA
#undef PG8_WAIT_V
#undef PG8_WAIT_L
#undef PG8_BAR
#undef PG8_SCHED
}
template <class F>
DI void epi8(const f32x4 (&acc)[2][2][4][2], const Unit& u, int wr, int wc, int fr, int fq, F f) {
#pragma unroll
    for (int ai = 0; ai < 2; ++ai)
#pragma unroll
        for (int m = 0; m < 4; ++m)
#pragma unroll
            for (int bj = 0; bj < 2; ++bj) f(u.pm * 256 + ai * 128 + wr * 64 + m * 16 + fr, u.pn * 256 + bj * 128 + wc * 32 + 8 * fq, acc[ai][bj][m][0], acc[ai][bj][m][1]);
}
}
#define TILE_AI(i) ((i) >> 3)
#define TILE_M(i)  (((i) >> 1) & 3)
#define TILE_BJ(i) ((i) & 1)
DI unsigned pk4u8(f32x4 v) {
    unsigned r = 0;
    r = __builtin_amdgcn_cvt_pk_u8_f32(v[0] * 255.f, 0, r); r = __builtin_amdgcn_cvt_pk_u8_f32(v[1] * 255.f, 1, r);
    r = __builtin_amdgcn_cvt_pk_u8_f32(v[2] * 255.f, 2, r); r = __builtin_amdgcn_cvt_pk_u8_f32(v[3] * 255.f, 3, r);
    return r;
}
DI f32x4 un4u8(unsigned w) {
    const float k = 1.f / 255.f;
    return (f32x4){(float)(w & 0xffu) * k, (float)((w >> 8) & 0xffu) * k, (float)((w >> 16) & 0xffu) * k, (float)(w >> 24) * k};
}
DI uint4 pk8(f32x4 a, f32x4 b) { return make_uint4(pk2(a[0], a[1]), pk2(a[2], a[3]), pk2(b[0], b[1]), pk2(b[2], b[3])); }

struct RowMajor {
    const bf16_t* base; int ld;
    DI uint4 operator()(int r, int k) const { return *(const uint4*)(base + (size_t)r * ld + k); }
};

DI void transpose_tile(unsigned char* smem, const int tid, const float* src, int K, int N, bf16_t* dst, int ldd, int permid, int kt, int nt) {
    float (*tile)[65] = (float (*)[65])smem;
    const int k0 = kt * 64, n0 = nt * 64;
    float tv[16];
#pragma unroll
    for (int i = 0; i < 16; ++i) {
        int kk = i * 4 + (tid >> 6), nn = tid & 63;
        tv[i] = (n0 + nn < N) ? src[(size_t)(k0 + kk) * N + n0 + nn] : 0.f;
    }
#pragma unroll
    for (int i = 0; i < 16; ++i) tile[tid & 63][i * 4 + (tid >> 6)] = tv[i];
    __syncthreads();
#pragma unroll 4
    for (int i = 0; i < 16; ++i) {
        int nn = i * 4 + (tid >> 6), kk = tid & 63;
        int n = n0 + nn;
        if (n < N) {
            int row = n;
            if (permid == 1) row = (n < 2048) ? n : ((n >= 2056) ? n - 8 : -1);
            else if (permid == 2) row = (n < 1024) ? ((n >> 2) * 8 + (n & 3)) : (((n - 1024) >> 2) * 8 + 4 + (n & 3));
            else if (permid == 3) row = (n < 2816) ? ((n >> 2) * 8 + (n & 3)) : (((n - 2816) >> 2) * 8 + 4 + (n & 3));
            if (row >= 0) dst[(size_t)row * ldd + k0 + kk] = f2bf(tile[nn][kk]);
        }
    }
    __syncthreads();
}

DI void phase0(const Params& p, unsigned char* smem, const int tid, const int vb, const int nvb) {
    unsigned char* ws = p.ws;
    const int NTR = 4112, NADA = 192, NS5 = 32;
    for (int it0 = vb; it0 < NTR + NADA + NS5; it0 += nvb) {
        const int it = (it0 < NADA + NS5) ? (NTR + it0) : (it0 - NADA - NS5);
        if (it < NTR) {
            int id = it;
            if (id < 1168) { transpose_tile(smem, tid, p.in[4], 1024, 4616, (bf16_t*)(ws + OFF_WIN), 1024, 1, id / 73, id % 73); continue; }
            id -= 1168;
            if (id < 64) {
                int isk = id >> 5, r = id & 31, h = r >> 3, t = r & 7;
                transpose_tile(smem, tid, (isk ? p.in[9] : p.in[8]) + (size_t)h * 256 * 128, 256, 128,
                               (bf16_t*)(ws + OFF_WQK) + (size_t)h * 65536 + (isk ? 128 * 256 : 0), 256, 0, t >> 1, t & 1);
                continue;
            }
            id -= 64;
            if (id < 256) { transpose_tile(smem, tid, p.in[11], 1024, 1024, (bf16_t*)(ws + OFF_WDN), 1024, 0, id >> 4, id & 15); continue; }
            id -= 256;
            if (id < 256) { transpose_tile(smem, tid, p.in[20], 512, 2048, (bf16_t*)(ws + OFF_WGL), 512, 2, id >> 5, id & 31); continue; }
            id -= 256;
            if (id < 256) { transpose_tile(smem, tid, p.in[21], 1024, 1024, (bf16_t*)(ws + OFF_WMX), 1024, 0, id >> 4, id & 15); continue; }
            id -= 256;
            if (id < 1408) { transpose_tile(smem, tid, p.in[24], 1024, 5632, (bf16_t*)(ws + OFF_WUP), 1024, 3, id / 88, id % 88); continue; }
            id -= 1408;
            transpose_tile(smem, tid, p.in[27], 2816, 1024, (bf16_t*)(ws + OFF_WFD), 2816, 0, id >> 4, id & 15);
        } else if (it < NTR + NADA) {
            const int a = it - NTR;
            float* sc = (float*)smem;
            float* red = (float*)(smem + 16384);
            for (int i = tid; i < 4096; i += 256) { float v = p.in[1][i]; sc[i] = v / (1.f + __expf(-v)); }
            __syncthreads();
            const int col = tid & 31, kg = tid >> 5, n0 = a * 32;
            float a0 = 0, a1 = 0, a2 = 0, a3 = 0;
            const float* wp = p.in[2] + (size_t)(kg * 128) * 6144 + n0 + col;
#pragma unroll 16
            for (int k = 0; k < 128; ++k) {
                float w = wp[(size_t)k * 6144];
                int kk = kg * 128 + k;
                a0 += sc[kk] * w; a1 += sc[1024 + kk] * w; a2 += sc[2048 + kk] * w; a3 += sc[3072 + kk] * w;
            }
            red[(kg * 4 + 0) * 32 + col] = a0; red[(kg * 4 + 1) * 32 + col] = a1; red[(kg * 4 + 2) * 32 + col] = a2; red[(kg * 4 + 3) * 32 + col] = a3;
            __syncthreads();
            if (tid < 128) {
                int b = tid >> 5, c2 = tid & 31;
                float sacc = p.in[3][n0 + c2];
                for (int g = 0; g < 8; ++g) sacc += red[(g * 4 + b) * 32 + c2];
                ((float*)(ws + OFF_MOD))[b * 6144 + n0 + c2] = sacc;
            }
            __syncthreads();
        } else {
            const int g = it - NTR - NADA;
            const float dtf = expf(p.in[14][g]);
            const double dt = (double)dtf;
            float2* apow = (float2*)(ws + OFF_APOW);
            for (int idx = tid; idx < 64 * 65; idx += 256) {
                int pp = idx / 65, tau = idx % 65;
                double lr = p.in[12][g * 64 + pp], li = p.in[13][g * 64 + pp];
                double rev = li * dt * (double)tau * 0.15915494309189535;
                rev -= rint(rev);
                float mag = expf((float)(lr * dt * (double)tau));
                apow[((size_t)g * 65 + tau) * 64 + pp] = make_float2(mag * __builtin_amdgcn_cosf((float)rev), mag * __builtin_amdgcn_sinf((float)rev));
            }
            if (tid < 64) {
                int pp = tid;
                float lr = p.in[12][g * 64 + pp], li = p.in[13][g * 64 + pp];
                float em1 = expm1f(lr * dtf), mag = em1 + 1.f;
                double rev = (double)li * dt * 0.15915494309189535;
                double revh = 0.5 * rev;
                rev -= rint(rev); revh -= rint(revh);
                float sh = __builtin_amdgcn_sinf((float)revh);
                float arm1 = em1 - 2.f * mag * sh * sh;
                float ai = mag * __builtin_amdgcn_sinf((float)rev);
                float den = lr * lr + li * li;
                float zr = (arm1 * lr + ai * li) / den, zi = (ai * lr - arm1 * li) / den;
                float2* bb = (float2*)(ws + OFF_BBAR);
                for (int c2 = 0; c2 < 16; ++c2) {
                    float br = p.in[15][(size_t)(g * 64 + pp) * 16 + c2], bi = p.in[16][(size_t)(g * 64 + pp) * 16 + c2];
                    bb[(size_t)(g * 64 + pp) * 16 + c2] = make_float2(zr * br - zi * bi, zr * bi + zi * br);
                }
            }
            __syncthreads();
            __syncthreads();
        }
    }
}

DI void row_stats(const float (&v)[16], float& mean, float& rstd) {
    float s = 0.f;
#pragma unroll
    for (int i = 0; i < 16; ++i) s += v[i];
    mean = wsum(s) * (1.f / 1024.f);
    float q = 0.f;
#pragma unroll
    for (int i = 0; i < 16; ++i) { float d = v[i] - mean; q += d * d; }
    rstd = rsqrtf(wsum(q) * (1.f / 1024.f) + 1e-5f);
}

DI void phase1(const Params& p, unsigned char* smem) {
    unsigned char* ws = p.ws;
    int ft_ = threadIdx.x; asm volatile("" : "+v"(ft_));
    const int lane = ft_ & 63, wid = ft_ >> 6;
    const float* mod = (const float*)(ws + OFF_MOD);
    bf16_t* h1 = (bf16_t*)(ws + 1 * U_);
    float4 gw0[16], gw1[16];
#pragma unroll
    for (int i = 0; i < 4; ++i)
#pragma unroll
        for (int e = 0; e < 4; ++e) {
            const float* wp = p.in[4] + (size_t)(i * 256 + lane * 4 + e) * 4616 + 2048;
            gw0[i * 4 + e] = *(const float4*)wp; gw1[i * 4 + e] = *(const float4*)(wp + 4);
        }
    float* ig = (float*)(ws + OFF_IG);
    float* lf = (float*)(ws + OFF_LOGF);
    for (int row0 = (blockIdx.x * 8 + wid) * 4; row0 < T_; row0 += gridDim.x * 32) {
        float vv[4][16];
#pragma unroll
        for (int rr = 0; rr < 4; ++rr)
#pragma unroll
            for (int i = 0; i < 4; ++i) { float4 t = *(const float4*)(p.in[0] + (size_t)(row0 + rr) * 1024 + i * 256 + lane * 4); vv[rr][4 * i] = t.x; vv[rr][4 * i + 1] = t.y; vv[rr][4 * i + 2] = t.z; vv[rr][4 * i + 3] = t.w; }
#pragma unroll
        for (int rr = 0; rr < 4; ++rr) {
            const int row = row0 + rr;
            float mean, rstd; row_stats(vv[rr], mean, rstd);
            const float* mb = mod + (row >> 13) * 6144;
            float ga[8];
#pragma unroll
            for (int j = 0; j < 8; ++j) ga[j] = 0.f;
#pragma unroll
            for (int i = 0; i < 4; ++i) {
                int c = i * 256 + lane * 4;
                float4 sh = *(const float4*)(mb + c), sc = *(const float4*)(mb + 1024 + c);
                f32x4 o;
                o[0] = (vv[rr][4 * i] - mean) * rstd * (1.f + sc.x) + sh.x;
                o[1] = (vv[rr][4 * i + 1] - mean) * rstd * (1.f + sc.y) + sh.y;
                o[2] = (vv[rr][4 * i + 2] - mean) * rstd * (1.f + sc.z) + sh.z;
                o[3] = (vv[rr][4 * i + 3] - mean) * rstd * (1.f + sc.w) + sh.w;
                *(uint2*)(h1 + (size_t)row * 1024 + c) = pk4(o);
#pragma unroll
                for (int e = 0; e < 4; ++e) {
                    const float4 w0 = gw0[i * 4 + e], w1 = gw1[i * 4 + e];
                    ga[0] += o[e] * w0.x; ga[1] += o[e] * w0.y; ga[2] += o[e] * w0.z; ga[3] += o[e] * w0.w;
                    ga[4] += o[e] * w1.x; ga[5] += o[e] * w1.y; ga[6] += o[e] * w1.z; ga[7] += o[e] * w1.w;
                }
            }
#pragma unroll
            for (int j = 0; j < 8; ++j) ga[j] = wsum(ga[j]);
            if (lane < 8) {
                float val = ga[0];
#pragma unroll
                for (int j = 1; j < 8; ++j) val = (lane == j) ? ga[j] : val;
                val += p.in[5][2048 + lane];
                const int b = row >> 13, sidx = row & 8191;
                if (lane < 4) ig[(size_t)(b * 4 + lane) * 8192 + sidx] = val;
                else lf[(size_t)(b * 4 + lane - 4) * 8192 + sidx] = logsig(val);
            }
        }
    }
    const float2* apow = (const float2*)(ws + OFF_APOW);
    const float2* bbar = (const float2*)(ws + OFF_BBAR);
    const float* cre = p.in[17];
    const float* cim = p.in[18];
    const int gtid = blockIdx.x * 512 + fresh_tid(), gstr = gridDim.x * 512;
    bf16_t* emat = (bf16_t*)(ws + OFF_EMAT);
    for (int idx = gtid; idx < 32 * 128 * 128; idx += gstr) {
        const int g = idx >> 14, m = (idx >> 7) & 127, k8 = idx & 127;
        const int pp = m & 63, j = k8 >> 1, c20 = (k8 & 1) * 8;
        const float2 a = apow[((size_t)g * 65 + (63 - j)) * 64 + pp];
        const float4* bp = (const float4*)(bbar + (size_t)(g * 64 + pp) * 16 + c20);
        float o[8];
#pragma unroll
        for (int e = 0; e < 4; ++e) {
            float4 b2 = bp[e];
            o[2 * e] = (m < 64) ? (a.x * b2.x - a.y * b2.y) : (a.x * b2.y + a.y * b2.x);
            o[2 * e + 1] = (m < 64) ? (a.x * b2.z - a.y * b2.w) : (a.x * b2.w + a.y * b2.z);
        }
        *(uint4*)(emat + (size_t)idx * 8) = make_uint4(pk2(o[0], o[1]), pk2(o[2], o[3]), pk2(o[4], o[5]), pk2(o[6], o[7]));
    }
}

struct EpiIn {
    const float* bin; bf16_t *xm, *xmT, *og, *sga, *sgb, *us;
    DI void operator()(const f32x4 (&acc)[2][2][4][2], const pg8::Unit& u, int wr, int wc, int fr, int fq) const {
        const int pn = u.pn;
        int boff, c0, slot;
        if (pn < 4) { boff = 0; c0 = 0; slot = 0; }
        else if (pn < 8) { boff = 1024; c0 = 1024; slot = 0; }
        else if (pn < 10) { boff = 2056; c0 = 2048; slot = 0; }
        else if (pn < 14) { boff = 2568; c0 = 2560; slot = 1; }
        else { boff = 3592; c0 = 3584; slot = 2; }
        const int colb = pn * 256 + wc * 32 + 8 * fq - c0;
        f32x4 bia[2][2];
#pragma unroll
        for (int bj = 0; bj < 2; ++bj) { bia[bj][0] = *(const f32x4*)(bin + boff + colb + bj * 128); bia[bj][1] = *(const f32x4*)(bin + boff + colb + bj * 128 + 4); }
        const int t0 = u.pm * 256 + wr * 64 + fr;
        if (pn < 4) {
#pragma unroll
            for (int i = 0; i < 16; ++i) {
                const int ai = TILE_AI(i), m = TILE_M(i), bj = TILE_BJ(i);
                const int t = t0 + ai * 128 + m * 16, col = colb + bj * 128;
                const f32x4 v0 = acc[ai][bj][m][0] + bia[bj][0], v1 = acc[ai][bj][m][1] + bia[bj][1];
                *(uint4*)(xm + (size_t)t * 1024 + col) = pk8(v0, v1);
                const int b = t >> 13, sidx = t & 8191;
                bf16_t* tp = xmT + ((((size_t)(b * 4 + (col >> 8)) * 128 + (sidx >> 6)) * 256 + (col & 255)) * 64) + (sidx & 63);
#pragma unroll
                for (int r = 0; r < 4; ++r) { *tp = f2bf(v0[r]); tp += 64; asm volatile("" : "+v"(tp)); }
#pragma unroll
                for (int r = 0; r < 4; ++r) { *tp = f2bf(v1[r]); tp += 64; asm volatile("" : "+v"(tp)); }
            }
        } else if (pn == 8 || pn == 9) {
#pragma unroll
            for (int i = 0; i < 16; ++i) {
                const int ai = TILE_AI(i), m = TILE_M(i), bj = TILE_BJ(i);
                const int t = t0 + ai * 128 + m * 16, col = colb + bj * 128;
                *(uint4*)(us + ((((size_t)(col >> 4) * 512 + (t >> 6)) * 64 + (t & 63)) * 16 + (col & 15))) = pk8(acc[ai][bj][m][0] + bia[bj][0], acc[ai][bj][m][1] + bia[bj][1]);
            }
        } else {
            unsigned char* dst = (unsigned char*)og + (size_t)slot * U_;
#pragma unroll
            for (int i = 0; i < 16; ++i) {
                const int ai = TILE_AI(i), m = TILE_M(i), bj = TILE_BJ(i);
                const int t = t0 + ai * 128 + m * 16, col = colb + bj * 128;
                f32x4 v0 = acc[ai][bj][m][0] + bia[bj][0], v1 = acc[ai][bj][m][1] + bia[bj][1];
#pragma unroll
                for (int r = 0; r < 4; ++r) { v0[r] = sigm(v0[r]); v1[r] = sigm(v1[r]); }
                *(uint2*)(dst + (size_t)t * 1024 + col) = make_uint2(pk4u8(v0), pk4u8(v1));
            }
        }
    }
};

DI void s5_tables_late(const Params& p, const int gtid, const int gstr) {
    unsigned char* ws = p.ws;
    const float2* apow = (const float2*)(ws + OFF_APOW);
    const float2* bbar = (const float2*)(ws + OFF_BBAR);
    const float* cre = p.in[17];
    const float* cim = p.in[18];
    bf16_t* kc = (bf16_t*)(ws + OFF_KC);
    for (int idx = gtid; idx < 32 * 64 * 16 * 2; idx += gstr) {
        const int g = idx >> 11, tau = (idx >> 5) & 63, c = (idx >> 1) & 15, c20 = (idx & 1) * 8;
        float sacc[8];
#pragma unroll
        for (int e = 0; e < 8; ++e) sacc[e] = 0.f;
#pragma unroll 4
        for (int pp = 0; pp < 64; ++pp) {
            const float cr = cre[(size_t)(g * 16 + c) * 64 + pp], ci = cim[(size_t)(g * 16 + c) * 64 + pp];
            const float2 a = apow[((size_t)g * 65 + tau) * 64 + pp];
            const float wr_ = cr * a.x - ci * a.y, wi_ = cr * a.y + ci * a.x;
            const float4* bp = (const float4*)(bbar + (size_t)(g * 64 + pp) * 16 + c20);
#pragma unroll
            for (int e = 0; e < 4; ++e) { float4 b2 = bp[e]; sacc[2 * e] += wr_ * b2.x - wi_ * b2.y; sacc[2 * e + 1] += wr_ * b2.z - wi_ * b2.w; }
        }
        *(uint4*)(kc + (((size_t)(g * 64 + tau) * 16 + c) * 16 + c20)) = make_uint4(pk2(sacc[0], sacc[1]), pk2(sacc[2], sacc[3]), pk2(sacc[4], sacc[5]), pk2(sacc[6], sacc[7]));
    }
    bf16_t* cmat = (bf16_t*)(ws + OFF_CMAT);
    for (int idx = gtid; idx < 32 * 1024 * 16; idx += gstr) {
        const int g = idx >> 14, m = (idx >> 4) & 1023, kk0 = (idx & 15) * 8;
        const int t = m >> 4, c = m & 15, p0 = kk0 & 63;
        const float4* crp = (const float4*)(cre + (size_t)(g * 16 + c) * 64 + p0);
        const float4* cip = (const float4*)(cim + (size_t)(g * 16 + c) * 64 + p0);
        float4 cr0 = crp[0], cr1 = crp[1], ci0 = cip[0], ci1 = cip[1];
        const float crv[8] = {cr0.x, cr0.y, cr0.z, cr0.w, cr1.x, cr1.y, cr1.z, cr1.w};
        const float civ[8] = {ci0.x, ci0.y, ci0.z, ci0.w, ci1.x, ci1.y, ci1.z, ci1.w};
        float o[8];
#pragma unroll
        for (int e = 0; e < 8; ++e) {
            const float2 a = apow[((size_t)g * 65 + t + 1) * 64 + p0 + e];
            o[e] = (kk0 < 64) ? (crv[e] * a.x - civ[e] * a.y) : -(crv[e] * a.y + civ[e] * a.x);
        }
        *(uint4*)(cmat + (size_t)idx * 8) = make_uint4(pk2(o[0], o[1]), pk2(o[2], o[3]), pk2(o[4], o[5]), pk2(o[6], o[7]));
    }
}

DI void phase3(const Params& p, unsigned char* smem, const int tid, const int vb, const int nvb) {
    unsigned char* ws = p.ws;
    const bf16_t* us = (const bf16_t*)(ws + 7 * U_);
    const bf16_t* emat = (const bf16_t*)(ws + OFF_EMAT);
    float* ebuf = (float*)((unsigned char*)p.out + (size_t)48 * 1048576);
    const bf16_t* xm = (const bf16_t*)(ws + 2 * U_);
    bf16_t* xc = (bf16_t*)(ws + 1 * U_);
    for (int it = vb; it < 256; it += nvb) {
        const int g = it >> 3, nt = (it >> 1) & 3, kh = it & 1;
        f32x4 acc[4][4];
        auto lb = [=](int r, int k) -> uint4 { return *(const uint4*)(us + ((size_t)g * 512 + nt * 128 + r) * 1024 + kh * 512 + k); };
        gemm_tile(smem, tid, 8, RowMajor{emat + (size_t)g * 128 * 1024 + kh * 512, 1024}, lb, acc);
        epi_loop(acc, tid, [&](const int epi_f, const int epi_t, const f32x4 accv) __attribute__((always_inline)) {
            const int f = epi_f, n = nt * 128 + epi_t;
            *(f32x4*)(ebuf + (size_t)kh * 2097152 + ((size_t)n * 32 + g) * 128 + f) = accv;
        });
    }
    if (blockIdx.x >= 128) s5_tables_late(p, (blockIdx.x - 128) * 512 + fresh_tid(), (gridDim.x - 128) * 512);
    for (int i0 = vb; i0 < 512; i0 += nvb) {
        const int cgp = tid & 127, half = tid >> 7;
        const int t0 = i0 * 64 + half * 32, s0 = t0 & 8191;
        const int c0 = cgp * 8;
        float w[4][8], bb[8];
#pragma unroll
        for (int j = 0; j < 4; ++j)
#pragma unroll
            for (int e = 0; e < 8; ++e) w[j][e] = p.in[6][j * 1024 + c0 + e];
#pragma unroll
        for (int e = 0; e < 8; ++e) bb[e] = p.in[7][c0 + e];
        float r0[8], r1[8], r2[8];
#pragma unroll
        for (int e = 0; e < 8; ++e) { r0[e] = 0.f; r1[e] = 0.f; r2[e] = 0.f; }
        if (s0 > 0) {
            uint4 a = *(const uint4*)(xm + (size_t)(t0 - 3) * 1024 + c0), b = *(const uint4*)(xm + (size_t)(t0 - 2) * 1024 + c0), c = *(const uint4*)(xm + (size_t)(t0 - 1) * 1024 + c0);
            const unsigned* pa = (const unsigned*)&a; const unsigned* pb = (const unsigned*)&b; const unsigned* pc = (const unsigned*)&c;
#pragma unroll
            for (int e = 0; e < 4; ++e) {
                r0[2 * e] = bf2f(pa[e] & 0xffff); r0[2 * e + 1] = bf2f(pa[e] >> 16);
                r1[2 * e] = bf2f(pb[e] & 0xffff); r1[2 * e + 1] = bf2f(pb[e] >> 16);
                r2[2 * e] = bf2f(pc[e] & 0xffff); r2[2 * e + 1] = bf2f(pc[e] >> 16);
            }
        }
        for (int tb = 0; tb < 32; tb += 8) {
            uint4 av[8];
#pragma unroll
            for (int i = 0; i < 8; ++i) av[i] = *(const uint4*)(xm + (size_t)(t0 + tb + i) * 1024 + c0);
#pragma unroll
            for (int i = 0; i < 8; ++i) {
                const unsigned* pa = (const unsigned*)&av[i];
                float cur[8], y[8];
#pragma unroll
                for (int e = 0; e < 4; ++e) { cur[2 * e] = bf2f(pa[e] & 0xffff); cur[2 * e + 1] = bf2f(pa[e] >> 16); }
#pragma unroll
                for (int e = 0; e < 8; ++e) {
                    float z = bb[e] + w[0][e] * r0[e] + w[1][e] * r1[e] + w[2][e] * r2[e] + w[3][e] * cur[e];
                    y[e] = z * sigm(z);
                    r0[e] = r1[e]; r1[e] = r2[e]; r2[e] = cur[e];
                }
                *(uint4*)(xc + (size_t)(t0 + tb + i) * 1024 + c0) = make_uint4(pk2(y[0], y[1]), pk2(y[2], y[3]), pk2(y[4], y[5]), pk2(y[6], y[7]));
            }
        }
    }
    for (int u = vb * 4 + (tid >> 6); u < 2048; u += nvb * 4) {
        const int lane = tid & 63;
        const int bh = u >> 7, c = u & 127;
        const size_t o = (size_t)bh * 8192 + c * 64 + lane;
        float b = ((const float*)(ws + OFF_LOGF))[o];
        float ii = ((const float*)(ws + OFF_IG))[o];
        for (int d = 1; d < 64; d <<= 1) { float t = __shfl_up(b, d, 64); if (lane >= d) b += t; }
        float bl = __shfl(b, 63, 64);
        float g = bl - b + ii;
        for (int o2 = 32; o2 > 0; o2 >>= 1) g = fmaxf(g, __shfl_xor(g, o2, 64));
        ((float*)(ws + OFF_BCUM))[o] = b;
        if (lane == 0) { ((float*)(ws + OFF_AARR))[u] = g; ((float*)(ws + OFF_BLAST))[u] = bl; }
    }
}

DI void phase4_small(const Params& p, unsigned char* smem) {
    unsigned char* ws = p.ws;
    const int tid = fresh_tid();
    const int lane = tid & 63, wid = tid >> 6;
    if (blockIdx.x >= gridDim.x - 2) {
        const int bh = (blockIdx.x - (gridDim.x - 2)) * 8 + wid;
        const float* aa = (const float*)(ws + OFF_AARR) + bh * 128;
        const float* bl = (const float*)(ws + OFF_BLAST) + bh * 128;
        float* ms = (float*)(ws + OFF_MST) + bh * 132;
        const float p0 = bl[2 * lane], q0 = aa[2 * lane], p1 = bl[2 * lane + 1], q1 = aa[2 * lane + 1];
        float P = p0 + p1, Q = fmaxf(q0 + p1, q1);
#pragma unroll
        for (int d = 1; d < 64; d <<= 1) {
            const float Pp = __shfl_up(P, d, 64), Qp = __shfl_up(Q, d, 64);
            if (lane >= d) { Q = fmaxf(Qp + P, Q); P = Pp + P; }
        }
        float Pe = __shfl_up(P, 1, 64), Qe = __shfl_up(Q, 1, 64);
        const float m_even = (lane == 0) ? 0.f : fmaxf(Pe, Qe);
        const float m_odd = fmaxf(m_even + p0, q0);
        ms[2 * lane] = m_even; ms[2 * lane + 1] = m_odd;
        if (lane == 63) ms[128] = fmaxf(P, Q);
    }
    if (blockIdx.x < 128) {
        const int b = blockIdx.x >> 5, g = blockIdx.x & 31, pp = lane, seg = wid;
        const float2 a64 = ((const float2*)(ws + OFF_APOW))[((size_t)g * 65 + 64) * 64 + pp];
        const float* ebuf = (const float*)((unsigned char*)p.out + (size_t)48 * 1048576);
        bf16_t* xcar = (bf16_t*)((unsigned char*)p.out + (size_t)40 * 1048576);
        float2* L = (float2*)smem;
        float erv[16], eiv[16];
#pragma unroll
        for (int i = 0; i < 16; ++i) { size_t o = ((size_t)(b * 128 + seg * 16 + i) * 32 + g) * 128 + pp; erv[i] = ebuf[o] + ebuf[o + 2097152]; eiv[i] = ebuf[o + 64] + ebuf[o + 2097152 + 64]; }
        float xr = 0.f, xi = 0.f;
#pragma unroll
        for (int i = 0; i < 16; ++i) { const float nr = a64.x * xr - a64.y * xi + erv[i], ni = a64.x * xi + a64.y * xr + eiv[i]; xr = nr; xi = ni; }
        L[seg * 64 + pp] = make_float2(xr, xi);
        float ar = a64.x, ai = a64.y;
#pragma unroll
        for (int k = 0; k < 4; ++k) { const float nr = ar * ar - ai * ai, ni = 2.f * ar * ai; ar = nr; ai = ni; }
        __syncthreads();
        xr = 0.f; xi = 0.f;
        for (int s2 = 0; s2 < seg; ++s2) { const float2 l = L[s2 * 64 + pp]; const float nr = ar * xr - ai * xi + l.x, ni = ar * xi + ai * xr + l.y; xr = nr; xi = ni; }
#pragma unroll
        for (int i = 0; i < 16; ++i) {
            size_t o = ((size_t)(b * 128 + seg * 16 + i) * 32 + g) * 128 + pp;
            xcar[o] = f2bf(xr); xcar[o + 64] = f2bf(xi);
            const float nr = a64.x * xr - a64.y * xi + erv[i], ni = a64.x * xi + a64.y * xr + eiv[i]; xr = nr; xi = ni;
        }
        __syncthreads();
    }
}
struct EpiQK {
    bf16_t *q, *k, *kT;
    DI void operator()(const f32x4 (&acc)[2][2][4][2], const pg8::Unit& u, int wr, int wc, int fr, int fq) const {
        const int h = u.pn;
        const int d = wc * 32 + 8 * fq;
        const int t0 = u.pm * 256 + wr * 64 + fr;
        const int b = t0 >> 13, bh = b * 4 + h, s0 = t0 & 8191;
        bf16_t* qp = q + ((size_t)bh * 8192 + s0) * 128 + d;
#pragma unroll
        for (int ai = 0; ai < 2; ++ai)
#pragma unroll
            for (int m = 0; m < 4; ++m) {
                f32x4 q0 = acc[ai][0][m][0] * 0.08838834764831845f, q1 = acc[ai][0][m][1] * 0.08838834764831845f;
                *(uint4*)(qp + (size_t)(ai * 128 + m * 16) * 128) = pk8(q0, q1);
            }
        bf16_t* kp = k + ((size_t)bh * 8192 + s0) * 128 + d;
#pragma unroll
        for (int ai = 0; ai < 2; ++ai)
#pragma unroll
            for (int m = 0; m < 4; ++m) *(uint4*)(kp + (size_t)(ai * 128 + m * 16) * 128) = pk8(acc[ai][1][m][0], acc[ai][1][m][1]);
        bf16_t* tp0 = kT + (((size_t)bh * 128 + (s0 >> 6)) * 128 + d) * 64 + (s0 & 63);
#pragma unroll
        for (int ai = 0; ai < 2; ++ai)
#pragma unroll
            for (int m = 0; m < 4; ++m) {
                bf16_t* tp = tp0 + (size_t)(ai * 2 + (m >> 2)) * 0 + ((ai * 128 + m * 16) >> 6) * (128 * 64) + ((ai * 128 + m * 16) & 63);
                asm volatile("" : "+v"(tp));
#pragma unroll
                for (int r = 0; r < 4; ++r) { *tp = f2bf(acc[ai][1][m][0][r]); tp += 64; asm volatile("" : "+v"(tp)); }
#pragma unroll
                for (int r = 0; r < 4; ++r) { *tp = f2bf(acc[ai][1][m][1][r]); tp += 64; asm volatile("" : "+v"(tp)); }
            }
    }
};

DI void mlstm_u_unit(const Params& p, unsigned char* smem, const int tid, int u) {
    unsigned char* ws = p.ws;
    const int lane = tid & 63, w = tid >> 6;
    const int bh = u >> 7, c = u & 127, b = bh >> 2, h = bh & 3;
    float* wk = (float*)smem;
    const bf16_t* kT = (const bf16_t*)(ws + 7 * U_ + U_ / 2);
    const bf16_t* vT = (const bf16_t*)(ws + 3 * U_);
    bf16_t* UT = (bf16_t*)(ws + 1 * U_);
    bf16x8 vfr[2][8][2];
#pragma unroll
    for (int nh = 0; nh < 2; ++nh)
#pragma unroll
        for (int ni = 0; ni < 8; ++ni) {
            const bf16_t* vr = vT + (((size_t)bh * 128 + c) * 256 + nh * 128 + ni * 16 + (lane & 15)) * 64 + (lane >> 4) * 8;
            vfr[nh][ni][0] = ld16(vr); vfr[nh][ni][1] = ld16(vr + 32);
        }
    if (tid < 64) {
        const size_t o = (size_t)bh * 8192 + c * 64 + tid;
        float bl = ((const float*)(ws + OFF_BLAST))[u];
        float mn = ((const float*)(ws + OFF_MST))[bh * 132 + c + 1];
        wk[tid] = __expf(bl - ((const float*)(ws + OFF_BCUM))[o] + ((const float*)(ws + OFF_IG))[o] - mn);
    }
    __syncthreads();
    {
        const int d = tid >> 1, hf = tid & 1;
        const bf16_t* kr = kT + (((size_t)bh * 128 + c) * 128 + d) * 64 + hf * 32;
        float s = 0.f;
#pragma unroll
        for (int i = 0; i < 4; ++i) {
            uint4 a = *(const uint4*)(kr + i * 8);
            const unsigned* pa = (const unsigned*)&a;
#pragma unroll
            for (int e = 0; e < 4; ++e) { s += bf2f(pa[e] & 0xffff) * wk[hf * 32 + i * 8 + 2 * e] + bf2f(pa[e] >> 16) * wk[hf * 32 + i * 8 + 2 * e + 1]; }
        }
        s += __shfl_xor(s, 1, 64);
        if (hf == 0) ((float*)(ws + OFF_NU))[((size_t)bh * 128 + c) * 128 + d] = s;
    }
    bf16x8 af[2][2];
#pragma unroll
    for (int mi = 0; mi < 2; ++mi)
#pragma unroll
        for (int ks = 0; ks < 2; ++ks) {
            const int j0 = ks * 32 + (lane >> 4) * 8;
            uint4 a = *(const uint4*)(kT + (((size_t)bh * 128 + c) * 128 + 32 * w + 16 * mi + (lane & 15)) * 64 + j0);
            const unsigned* pa = (const unsigned*)&a;
            uint4 o;
            unsigned* po = (unsigned*)&o;
#pragma unroll
            for (int e = 0; e < 4; ++e) po[e] = pk2(bf2f(pa[e] & 0xffff) * wk[j0 + 2 * e], bf2f(pa[e] >> 16) * wk[j0 + 2 * e + 1]);
            af[mi][ks] = __builtin_bit_cast(bf16x8, o);
        }
#pragma unroll
    for (int nh = 0; nh < 2; ++nh) {
        f32x4 acc[2][8];
#pragma unroll
        for (int mi = 0; mi < 2; ++mi)
#pragma unroll
            for (int ni = 0; ni < 8; ++ni) acc[mi][ni] = f32x4{0.f, 0.f, 0.f, 0.f};
#pragma unroll
        for (int ni = 0; ni < 8; ++ni)
#pragma unroll
            for (int ks = 0; ks < 2; ++ks)
#pragma unroll
                for (int mi = 0; mi < 2; ++mi) acc[mi][ni] = mfma16(af[mi][ks], vfr[nh][ni][ks], acc[mi][ni]);
#pragma unroll
        for (int mi = 0; mi < 2; ++mi)
#pragma unroll
            for (int ni = 0; ni < 8; ++ni) {
                const int dv = nh * 128 + ni * 16 + (lane & 15), d = 32 * w + 16 * mi + (lane >> 4) * 4;
                *(uint2*)(UT + (((size_t)bh * 128 + c) * 256 + dv) * 128 + d) = pk4(acc[mi][ni]);
            }
    }
    __syncthreads();
}

DI void phase5(const Params& p, unsigned char* smem, const int tid, const int vb, const int nvb) {
    unsigned char* ws = p.ws;
    const bf16_t* us = (const bf16_t*)(ws + 7 * U_);
    const bf16_t* kc = (const bf16_t*)(ws + OFF_KC);
    const bf16_t* cmat = (const bf16_t*)(ws + OFF_CMAT);
    const bf16_t* xcar = (const bf16_t*)((unsigned char*)p.out + (size_t)40 * 1048576);
    bf16_t* ys = (bf16_t*)p.out;
    const float* dsk = p.in[19];
    for (int it = vb; it < 1024; it += nvb) {
        const int g = it >> 5, mt = (it < 512) ? (7 - ((it >> 2) & 7)) : ((it >> 2) & 7), nt = it & 3;
        const int ktz = 128 * (mt + 1);
        const int nk = 2 * (mt + 1) + 2;
        auto la = [=](int r, int kv) -> uint4 {
            const int m = mt * 128 + r;
            if (kv < ktz) {
                const int t = m >> 4, c = m & 15, j = kv >> 4, c0 = kv & 15;
                if (j > t) return make_uint4(0, 0, 0, 0);
                return *(const uint4*)(kc + (((size_t)(g * 64 + (t - j)) * 16 + c) * 16 + c0));
            }
            return *(const uint4*)(cmat + ((size_t)(g * 1024 + m)) * 128 + (kv - ktz));
        };
        auto lb = [=](int r, int kv) -> uint4 {
            const int n = nt * 128 + r;
            if (kv < ktz) return *(const uint4*)(us + ((size_t)g * 512 + n) * 1024 + kv);
            return *(const uint4*)(xcar + ((size_t)n * 32 + g) * 128 + (kv - ktz));
        };
        f32x4 acc[4][4];
        gemm_tile(smem, tid, nk, la, lb, acc);
        epi_loop(acc, tid, [&](const int epi_f, const int epi_t, const f32x4 accv) __attribute__((always_inline)) {
            const int m = mt * 128 + epi_f, n = nt * 128 + epi_t;
            const int t = m >> 4, c = m & 15;
            const size_t tok = (size_t)n * 64 + t;
            const int ch = g * 16 + c;
            uint2 uu = *(const uint2*)(us + (((size_t)g * 512 + n) * 64 + t) * 16 + c);
            float4 dd = *(const float4*)(dsk + ch);
            f32x4 v = accv;
            v[0] = gelu_t(v[0] + dd.x * bf2f(uu.x & 0xffff));
            v[1] = gelu_t(v[1] + dd.y * bf2f(uu.x >> 16));
            v[2] = gelu_t(v[2] + dd.z * bf2f(uu.y & 0xffff));
            v[3] = gelu_t(v[3] + dd.w * bf2f(uu.y >> 16));
            *(uint2*)(ys + tok * 512 + ch) = pk4(v);
        });
    }
    for (int u = vb; u < 2048; u += nvb) mlstm_u_unit(p, smem, tid, u);
}

DI void phase6_scan(const Params& p) {
    unsigned char* ws = p.ws;
    const int tid = fresh_tid();
    for (int it = blockIdx.x; it < 256; it += gridDim.x) {
        const int e4 = it * 512 + tid;
        const int bh = e4 >> 13;
        const size_t off = (size_t)(e4 & 8191) * 4;
        bf16_t* base = (bf16_t*)(ws + 1 * U_) + (size_t)bh * 128 * 32768 + off;
        const float* bl = (const float*)(ws + OFF_BLAST) + bh * 128;
        const float* ms = (const float*)(ws + OFF_MST) + bh * 132;
        float C[4] = {0.f, 0.f, 0.f, 0.f};
        uint2 nxt[16];
#pragma unroll
        for (int i = 0; i < 16; ++i) nxt[i] = *(const uint2*)(base + (size_t)i * 32768);
        for (int c8 = 0; c8 < 128; c8 += 16) {
            float decv[16];
#pragma unroll
            for (int i = 0; i < 16; ++i) decv[i] = __expf(bl[c8 + i] + ms[c8 + i] - ms[c8 + i + 1]);
#pragma unroll
            for (int i = 0; i < 16; ++i) {
                const int c = c8 + i;
                uint2 v = nxt[i];
                if (c + 16 < 128) nxt[i] = *(const uint2*)(base + (size_t)(c + 16) * 32768);
                *(uint2*)(base + (size_t)c * 32768) = make_uint2(pk2(C[0], C[1]), pk2(C[2], C[3]));
                const float dec = decv[i];
                C[0] = dec * C[0] + bf2f(v.x & 0xffff); C[1] = dec * C[1] + bf2f(v.x >> 16);
                C[2] = dec * C[2] + bf2f(v.y & 0xffff); C[3] = dec * C[3] + bf2f(v.y >> 16);
            }
        }
    }
    if (blockIdx.x >= gridDim.x - 4) {
        const int e = (blockIdx.x - (gridDim.x - 4)) * 512 + tid;
        const int bh = e >> 7, d = e & 127;
        float* nb = (float*)(ws + OFF_NU) + (size_t)bh * 128 * 128 + d;
        const float* bl = (const float*)(ws + OFF_BLAST) + bh * 128;
        const float* ms = (const float*)(ws + OFF_MST) + bh * 132;
        float n = 0.f;
        for (int c0 = 0; c0 < 128; c0 += 16) {
            float vv[16], dd[16];
#pragma unroll
            for (int i = 0; i < 16; ++i) { vv[i] = nb[(c0 + i) * 128]; dd[i] = __expf(bl[c0 + i] + ms[c0 + i] - ms[c0 + i + 1]); }
#pragma unroll
            for (int i = 0; i < 16; ++i) { nb[(c0 + i) * 128] = n; n = dd[i] * n + vv[i]; }
        }
    }
}
struct EpiGlu {
    bf16_t* yb;
    DI void operator()(const f32x4 (&acc)[2][2][4][2], const pg8::Unit& u, int wr, int wc, int fr, int fq) const {
        pg8::epi8(acc, u, wr, wc, fr, fq, [&](int t, int col8, f32x4 v0, f32x4 v1) __attribute__((always_inline)) {
            f32x4 o;
#pragma unroll
            for (int r = 0; r < 4; ++r) o[r] = v0[r] * sigm(v1[r]);
            *(uint2*)(yb + (size_t)t * 1024 + (col8 >> 1)) = pk4(o);
        });
    }
};

DI void mlstm_out_unit(const Params& p, unsigned char* smem, const int tid, int u) {
    unsigned char* ws = p.ws;
    const int lane = tid & 63, w = tid >> 6;
    const int bh = u >> 7, c = u & 127, b = bh >> 2, h = bh & 3;
    float* gk = (float*)smem;
    float* bq = gk + 64;
    float* sci = bq + 64;
    float* emt = sci + 64;
    float* qn = emt + 64;
    float* rden = qn + 64;
    float* part = rden + 64;
    float* mean_s = part + 256;
    float* rstd_s = mean_s + 64;
    uint4* xs = (uint4*)(smem + 4096);
    const bf16_t* q = (const bf16_t*)((unsigned char*)p.out + U_);
    const bf16_t* k = q + (size_t)16 * 8192 * 128;
    const bf16_t* vT = (const bf16_t*)(ws + 3 * U_);
    const bf16_t* CT = (const bf16_t*)(ws + 1 * U_);
    const bf16_t* og = (const bf16_t*)(ws + 4 * U_);
    bf16_t* hm = (bf16_t*)p.out;
    const float mc = ((const float*)(ws + OFF_MST))[bh * 132 + c];
    const size_t tok0 = (size_t)bh * 8192 + c * 64;
    bf16x8 ctf[4][4];
    {
        const int i16 = lane & 15;
        const bf16_t* ctb0 = CT + (((size_t)bh * 128 + c) * 256 + 64 * w + (i16 >> 2) * 8 + (i16 & 3)) * 128 + (lane >> 4) * 8;
#pragma unroll
        for (int ks = 0; ks < 4; ++ks)
#pragma unroll
            for (int i = 0; i < 4; ++i) ctf[ks][i] = ld16(ctb0 + (size_t)((i >> 1) * 32 + (i & 1) * 4) * 128 + ks * 32);
    }
    if (w == 0) {
        float bj = ((const float*)(ws + OFF_BCUM))[tok0 + lane], ij = ((const float*)(ws + OFF_IG))[tok0 + lane];
        float g = ij - bj, pm = g;
        for (int d = 1; d < 64; d <<= 1) { float o = __shfl_up(pm, d, 64); if (lane >= d) pm = fmaxf(pm, o); }
        float mt = bj + fmaxf(mc, pm);
        gk[lane] = g; bq[lane] = bj - mt; sci[lane] = __expf(bj + mc - mt); emt[lane] = __expf(-mt);
    }
    {
        const int t = tid >> 2, p4 = tid & 3;
        const bf16_t* qr = q + (tok0 + t) * 128 + p4 * 32;
        const float* nr = (const float*)(ws + OFF_NU) + ((size_t)bh * 128 + c) * 128 + p4 * 32;
        float s = 0.f;
#pragma unroll
        for (int i = 0; i < 4; ++i) {
            uint4 a = *(const uint4*)(qr + i * 8);
            const unsigned* pa = (const unsigned*)&a;
#pragma unroll
            for (int e = 0; e < 4; ++e) s += bf2f(pa[e] & 0xffff) * nr[i * 8 + 2 * e] + bf2f(pa[e] >> 16) * nr[i * 8 + 2 * e + 1];
        }
        s += __shfl_xor(s, 1, 64); s += __shfl_xor(s, 2, 64);
        if (p4 == 0) qn[t] = s;
    }
    __syncthreads();
    {
        f32x4 X[4];
#pragma unroll
        for (int jt = 0; jt < 4; ++jt) X[jt] = f32x4{0.f, 0.f, 0.f, 0.f};
        const bf16_t* qb = q + (tok0 + 16 * w + (lane & 15)) * 128 + (lane >> 4) * 8;
        bf16x8 qf[4];
#pragma unroll
        for (int ks = 0; ks < 4; ++ks) qf[ks] = ld16(qb + ks * 32);
#pragma unroll
        for (int jt = 0; jt < 4; ++jt) {
            if (jt <= w) {
                const bf16_t* kb = k + (tok0 + 16 * jt + (lane & 15)) * 128 + (lane >> 4) * 8;
#pragma unroll
                for (int ks = 0; ks < 4; ++ks) X[jt] = mfma16(ld16(kb + ks * 32), qf[ks], X[jt]);
            }
        }
        const int t = 16 * w + (lane & 15);
        const float bqt = bq[t];
        float dsum = 0.f;
#pragma unroll
        for (int jt = 0; jt < 4; ++jt)
#pragma unroll
            for (int r = 0; r < 4; ++r) {
                const int j = 16 * jt + (lane >> 4) * 4 + r;
                float v = (j <= t) ? X[jt][r] * __expf(bqt + gk[j]) : 0.f;
                X[jt][r] = v; dsum += v;
            }
        dsum += __shfl_xor(dsum, 16, 64); dsum += __shfl_xor(dsum, 32, 64);
        if (lane < 16) { float den = dsum + sci[t] * qn[t]; rden[t] = 1.f / fmaxf(fabsf(den), emt[t]); }
#pragma unroll
        for (int pr = 0; pr < 2; ++pr) {
            uint2 lo = pk4(X[2 * pr]), hi = pk4(X[2 * pr + 1]);
            xs[(w * 2 + pr) * 64 + lane] = make_uint4(lo.x, lo.y, hi.x, hi.y);
        }
    }
    __syncthreads();
    f32x4 acc[4][4];
#pragma unroll
    for (int i = 0; i < 4; ++i)
#pragma unroll
        for (int j = 0; j < 4; ++j) acc[i][j] = f32x4{0.f, 0.f, 0.f, 0.f};
    {
        const bf16_t* qb = q + (tok0 + (lane & 15)) * 128 + (lane >> 4) * 8;
#pragma unroll
        for (int ks = 0; ks < 4; ++ks) {
            bf16x8 bfr[4];
#pragma unroll
            for (int i = 0; i < 4; ++i) bfr[i] = ld16(qb + (size_t)i * 16 * 128 + ks * 32);
#pragma unroll
            for (int i = 0; i < 4; ++i)
#pragma unroll
                for (int j = 0; j < 4; ++j) acc[i][j] = mfma16(ctf[ks][i], bfr[j], acc[i][j]);
        }
    }
#pragma unroll
    for (int ni = 0; ni < 4; ++ni) {
        const float s = sci[16 * ni + (lane & 15)];
#pragma unroll
        for (int mi = 0; mi < 4; ++mi) { acc[mi][ni][0] *= s; acc[mi][ni][1] *= s; acc[mi][ni][2] *= s; acc[mi][ni][3] *= s; }
    }
    {
        const bf16_t* vb = vT + (((size_t)bh * 128 + c) * 256 + 64 * w + ((lane & 15) >> 2) * 8 + (lane & 3)) * 64 + (lane >> 4) * 4;
#pragma unroll
        for (int pr = 0; pr < 2; ++pr) {
            bf16x8 af[4];
#pragma unroll
            for (int mi = 0; mi < 4; ++mi) {
                uint2 lo = *(const uint2*)(vb + (size_t)((mi >> 1) * 32 + (mi & 1) * 4) * 64 + pr * 32);
                uint2 hi = *(const uint2*)(vb + (size_t)((mi >> 1) * 32 + (mi & 1) * 4) * 64 + pr * 32 + 16);
                af[mi] = __builtin_bit_cast(bf16x8, make_uint4(lo.x, lo.y, hi.x, hi.y));
            }
#pragma unroll
            for (int ni = 0; ni < 4; ++ni) {
                if (ni >= 2 * pr) {
                    bf16x8 xb = __builtin_bit_cast(bf16x8, xs[(ni * 2 + pr) * 64 + lane]);
#pragma unroll
                    for (int mi = 0; mi < 4; ++mi) acc[mi][ni] = mfma16(af[mi], xb, acc[mi][ni]);
                }
            }
        }
    }
#pragma unroll
    for (int ni = 0; ni < 4; ++ni) {
        const float rd = rden[16 * ni + (lane & 15)];
        float s = 0.f;
#pragma unroll
        for (int mi = 0; mi < 4; ++mi) { acc[mi][ni][0] *= rd; acc[mi][ni][1] *= rd; acc[mi][ni][2] *= rd; acc[mi][ni][3] *= rd;
            s += acc[mi][ni][0] + acc[mi][ni][1] + acc[mi][ni][2] + acc[mi][ni][3]; }
        s += __shfl_xor(s, 16, 64); s += __shfl_xor(s, 32, 64);
        if (lane < 16) part[w * 64 + 16 * ni + lane] = s;
    }
    __syncthreads();
    if (tid < 64) mean_s[tid] = (part[tid] + part[64 + tid] + part[128 + tid] + part[192 + tid]) * (1.f / 256.f);
    __syncthreads();
#pragma unroll
    for (int ni = 0; ni < 4; ++ni) {
        const float mu = mean_s[16 * ni + (lane & 15)];
        float s = 0.f;
#pragma unroll
        for (int mi = 0; mi < 4; ++mi)
#pragma unroll
            for (int r = 0; r < 4; ++r) { float d = acc[mi][ni][r] - mu; s += d * d; }
        s += __shfl_xor(s, 16, 64); s += __shfl_xor(s, 32, 64);
        if (lane < 16) part[w * 64 + 16 * ni + lane] = s;
    }
    __syncthreads();
    if (tid < 64) rstd_s[tid] = rsqrtf((part[tid] + part[64 + tid] + part[128 + tid] + part[192 + tid]) * (1.f / 256.f) + 1e-5f);
    __syncthreads();
    const float* gain = p.in[10];
    float4 gg[2][2];
    uint2 ogv[4][2];
    const int ch_l = h * 256 + 64 * w + (lane >> 4) * 8;
#pragma unroll
    for (int k = 0; k < 2; ++k) { gg[k][0] = *(const float4*)(gain + ch_l + 32 * k); gg[k][1] = *(const float4*)(gain + ch_l + 32 * k + 4); }
#pragma unroll
    for (int ni = 0; ni < 4; ++ni)
#pragma unroll
        for (int k = 0; k < 2; ++k)
            ogv[ni][k] = *(const uint2*)((const unsigned char*)og + ((size_t)b * 8192 + c * 64 + 16 * ni + (lane & 15)) * 1024 + ch_l + 32 * k);
#pragma unroll
    for (int ni = 0; ni < 4; ++ni) {
        const int t = 16 * ni + (lane & 15);
        const float mu = mean_s[t], rs = rstd_s[t];
        const size_t tok = (size_t)b * 8192 + c * 64 + t;
#pragma unroll
        for (int k = 0; k < 2; ++k) {
            const f32x4 o2a = un4u8(ogv[ni][k].x), o2b = un4u8(ogv[ni][k].y);
            f32x4 oa, ob;
            oa[0] = (acc[2 * k][ni][0] - mu) * rs * gg[k][0].x * o2a[0];
            oa[1] = (acc[2 * k][ni][1] - mu) * rs * gg[k][0].y * o2a[1];
            oa[2] = (acc[2 * k][ni][2] - mu) * rs * gg[k][0].z * o2a[2];
            oa[3] = (acc[2 * k][ni][3] - mu) * rs * gg[k][0].w * o2a[3];
            ob[0] = (acc[2 * k + 1][ni][0] - mu) * rs * gg[k][1].x * o2b[0];
            ob[1] = (acc[2 * k + 1][ni][1] - mu) * rs * gg[k][1].y * o2b[1];
            ob[2] = (acc[2 * k + 1][ni][2] - mu) * rs * gg[k][1].z * o2b[2];
            ob[3] = (acc[2 * k + 1][ni][3] - mu) * rs * gg[k][1].w * o2b[3];
            *(uint4*)(hm + tok * 1024 + ch_l + 32 * k) = pk8(oa, ob);
        }
    }
    __syncthreads();
}

struct EpiDown {
    const unsigned char *sga, *sgb; const bf16_t* yb; bf16_t* ymix;
    DI void operator()(const f32x4 (&acc)[2][2][4][2], const pg8::Unit& u, int wr, int wc, int fr, int fq) const {
        const size_t o0 = (size_t)(u.pm * 256 + wr * 64 + fr) * 1024 + u.pn * 256 + wc * 32 + 8 * fq;
#define TOFF(i) (o0 + (size_t)(TILE_AI(i) * 128 + TILE_M(i) * 16) * 1024 + TILE_BJ(i) * 128)
        uint2 A[2], B[2]; uint4 Y[2];
        A[0] = *(const uint2*)(sga + TOFF(0)); B[0] = *(const uint2*)(sgb + TOFF(0)); Y[0] = *(const uint4*)(yb + TOFF(0));
#pragma unroll
        for (int i = 0; i < 16; ++i) {
            if (i + 1 < 16) { A[(i + 1) & 1] = *(const uint2*)(sga + TOFF(i + 1)); B[(i + 1) & 1] = *(const uint2*)(sgb + TOFF(i + 1)); Y[(i + 1) & 1] = *(const uint4*)(yb + TOFF(i + 1)); }
            const uint4 y = Y[i & 1];
            const f32x4 a0 = un4u8(A[i & 1].x), a1 = un4u8(A[i & 1].y), b0 = un4u8(B[i & 1].x), b1 = un4u8(B[i & 1].y);
            const f32x4 v0 = acc[TILE_AI(i)][TILE_BJ(i)][TILE_M(i)][0], v1 = acc[TILE_AI(i)][TILE_BJ(i)][TILE_M(i)][1];
            f32x4 r0, r1;
            r0[0] = a0[0] * v0[0] + b0[0] * bf2f(y.x & 0xffff);
            r0[1] = a0[1] * v0[1] + b0[1] * bf2f(y.x >> 16);
            r0[2] = a0[2] * v0[2] + b0[2] * bf2f(y.y & 0xffff);
            r0[3] = a0[3] * v0[3] + b0[3] * bf2f(y.y >> 16);
            r1[0] = a1[0] * v1[0] + b1[0] * bf2f(y.z & 0xffff);
            r1[1] = a1[1] * v1[1] + b1[1] * bf2f(y.z >> 16);
            r1[2] = a1[2] * v1[2] + b1[2] * bf2f(y.w & 0xffff);
            r1[3] = a1[3] * v1[3] + b1[3] * bf2f(y.w >> 16);
            *(uint4*)(ymix + TOFF(i)) = pk8(r0, r1);
        }
    }
};
struct EpiRes {
    const float* res; const float* gmod; bf16_t* dst;
    DI void operator()(const f32x4 (&acc)[2][2][4][2], const pg8::Unit& u, int wr, int wc, int fr, int fq) const {
        const int t0 = u.pm * 256 + wr * 64 + fr, colb = u.pn * 256 + wc * 32 + 8 * fq;
        const size_t o0 = (size_t)t0 * 1024 + colb;
        f32x4 gg[2][2];
#pragma unroll
        for (int bj = 0; bj < 2; ++bj) { const float* gp = gmod + (t0 >> 13) * 6144 + colb + bj * 128; gg[bj][0] = *(const f32x4*)gp + 1.f; gg[bj][1] = *(const f32x4*)(gp + 4) + 1.f; }
        f32x4 X0[2], X1[2];
        X0[0] = *(const f32x4*)(res + TOFF(0)); X1[0] = *(const f32x4*)(res + TOFF(0) + 4);
#pragma unroll
        for (int i = 0; i < 16; ++i) {
            if (i + 1 < 16) { X0[(i + 1) & 1] = *(const f32x4*)(res + TOFF(i + 1)); X1[(i + 1) & 1] = *(const f32x4*)(res + TOFF(i + 1) + 4); }
            const int bj = TILE_BJ(i);
            const f32x4 r0 = X0[i & 1] * ALPHA_ + gg[bj][0] * acc[TILE_AI(i)][bj][TILE_M(i)][0];
            const f32x4 r1 = X1[i & 1] * ALPHA_ + gg[bj][1] * acc[TILE_AI(i)][bj][TILE_M(i)][1];
            *(uint4*)(dst + TOFF(i)) = pk8(r0, r1);
        }
    }
};

struct EpiRes2 {
    const bf16_t* r1; const float2* stats; const float* lg; const float* lb; const float* gmod; bf16_t* dst;
    DI void operator()(const f32x4 (&acc)[2][2][4][2], const pg8::Unit& u, int wr, int wc, int fr, int fq) const {
        const int t0 = u.pm * 256 + wr * 64 + fr, colb = u.pn * 256 + wc * 32 + 8 * fq;
        const size_t o0 = (size_t)t0 * 1024 + colb;
        f32x4 gg[2][2], la[2][2], lbv[2][2];
#pragma unroll
        for (int bj = 0; bj < 2; ++bj) {
            const float* gp = gmod + (t0 >> 13) * 6144 + colb + bj * 128;
            gg[bj][0] = *(const f32x4*)gp + 1.f; gg[bj][1] = *(const f32x4*)(gp + 4) + 1.f;
            la[bj][0] = *(const f32x4*)(lg + colb + bj * 128) * ALPHA_; la[bj][1] = *(const f32x4*)(lg + colb + bj * 128 + 4) * ALPHA_;
            lbv[bj][0] = *(const f32x4*)(lb + colb + bj * 128) * ALPHA_; lbv[bj][1] = *(const f32x4*)(lb + colb + bj * 128 + 4) * ALPHA_;
        }
        float2 st[8];
#pragma unroll
        for (int j = 0; j < 8; ++j) st[j] = stats[t0 + (j >> 2) * 128 + (j & 3) * 16];
        uint4 XR[2];
        XR[0] = *(const uint4*)(r1 + TOFF(0));
#pragma unroll
        for (int i = 0; i < 16; ++i) {
            if (i + 1 < 16) XR[(i + 1) & 1] = *(const uint4*)(r1 + TOFF(i + 1));
            const int bj = TILE_BJ(i);
            const float2 s2 = st[i >> 1];
            const uint4 xr = XR[i & 1];
            const f32x4 X0 = {bf2f(xr.x & 0xffff), bf2f(xr.x >> 16), bf2f(xr.y & 0xffff), bf2f(xr.y >> 16)};
            const f32x4 X1 = {bf2f(xr.z & 0xffff), bf2f(xr.z >> 16), bf2f(xr.w & 0xffff), bf2f(xr.w >> 16)};
            const f32x4 r0 = ((X0 - s2.x) * s2.y) * la[bj][0] + lbv[bj][0] + gg[bj][0] * acc[TILE_AI(i)][bj][TILE_M(i)][0];
            const f32x4 r1v = ((X1 - s2.x) * s2.y) * la[bj][1] + lbv[bj][1] + gg[bj][1] * acc[TILE_AI(i)][bj][TILE_M(i)][1];
            *(uint4*)(dst + TOFF(i)) = pk8(r0, r1v);
        }
    }
};
#undef TOFF

DI void phase10(const Params& p) {
    unsigned char* ws = p.ws;
    int ft_ = threadIdx.x; asm volatile("" : "+v"(ft_));
    const int lane = ft_ & 63, wid = ft_ >> 6;
    const float* mod = (const float*)(ws + OFF_MOD);
    const bf16_t* r1 = (const bf16_t*)(ws + 2 * U_);
    float2* stats = (float2*)(ws + OFF_STATS);
    bf16_t* h2 = (bf16_t*)(ws + 1 * U_);
    for (int row0 = (blockIdx.x * 8 + wid) * 4; row0 < T_; row0 += gridDim.x * 32) {
        float v[4][16];
#pragma unroll
        for (int rr = 0; rr < 4; ++rr)
#pragma unroll
            for (int i = 0; i < 4; ++i) { uint2 t = *(const uint2*)(r1 + (size_t)(row0 + rr) * 1024 + i * 256 + lane * 4); v[rr][4 * i] = bf2f(t.x & 0xffff); v[rr][4 * i + 1] = bf2f(t.x >> 16); v[rr][4 * i + 2] = bf2f(t.y & 0xffff); v[rr][4 * i + 3] = bf2f(t.y >> 16); }
#pragma unroll
        for (int rr = 0; rr < 4; ++rr) {
            const int row = row0 + rr;
            float mean, rstd; row_stats(v[rr], mean, rstd);
            if (lane == 0) stats[row] = make_float2(mean, rstd);
#pragma unroll
            for (int i = 0; i < 4; ++i) {
                int c = i * 256 + lane * 4;
                float4 g = *(const float4*)(p.in[22] + c), bb = *(const float4*)(p.in[23] + c);
                v[rr][4 * i] = (v[rr][4 * i] - mean) * rstd * g.x + bb.x;
                v[rr][4 * i + 1] = (v[rr][4 * i + 1] - mean) * rstd * g.y + bb.y;
                v[rr][4 * i + 2] = (v[rr][4 * i + 2] - mean) * rstd * g.z + bb.z;
                v[rr][4 * i + 3] = (v[rr][4 * i + 3] - mean) * rstd * g.w + bb.w;
            }
            row_stats(v[rr], mean, rstd);
            const float* mb = mod + (row >> 13) * 6144;
#pragma unroll
            for (int i = 0; i < 4; ++i) {
                int c = i * 256 + lane * 4;
                float4 sh = *(const float4*)(mb + 3072 + c), sc = *(const float4*)(mb + 4096 + c);
                f32x4 o;
                o[0] = (v[rr][4 * i] - mean) * rstd * (1.f + sc.x) + sh.x;
                o[1] = (v[rr][4 * i + 1] - mean) * rstd * (1.f + sc.y) + sh.y;
                o[2] = (v[rr][4 * i + 2] - mean) * rstd * (1.f + sc.z) + sh.z;
                o[3] = (v[rr][4 * i + 3] - mean) * rstd * (1.f + sc.w) + sh.w;
                *(uint2*)(h2 + (size_t)row * 1024 + c) = pk4(o);
            }
        }
    }
}

constexpr size_t HALO_ELEMS = (size_t)512 * 2 * FH;
struct EpiUpF {
    bf16_t* hid; const float* cw; const float* cb; float* glast; float* gfirst; float* vfirst;
    DI void operator()(const f32x4 (&acc)[2][2][4][2], const pg8::Unit& u, int wr, int wc, int fr, int fq) const {
        const int lane = fq * 16 + fr;
        const int src1 = (lane & 48) | ((fr + 15) & 15), src2 = (lane & 48) | ((fr + 14) & 15);
        float4 w0v[2], w1v[2], w2v[2], bbv[2];
#pragma unroll
        for (int bj = 0; bj < 2; ++bj) {
            const int hc = (u.pn * 256 + bj * 128 + wc * 32 + 8 * fq) >> 1;
            w0v[bj] = *(const float4*)(cw + hc); w1v[bj] = *(const float4*)(cw + FH + hc); w2v[bj] = *(const float4*)(cw + 2 * FH + hc); bbv[bj] = *(const float4*)(cb + hc);
        }
#pragma unroll
        for (int bj = 0; bj < 2; ++bj) {
            const int hc = (u.pn * 256 + bj * 128 + wc * 32 + 8 * fq) >> 1;
            const float4 w0 = w0v[bj], w1 = w1v[bj], w2 = w2v[bj], bb = bbv[bj];
#pragma unroll
            for (int ai = 0; ai < 2; ++ai) {
                f32x4 gprev = (f32x4){0.f, 0.f, 0.f, 0.f};
#pragma unroll
                for (int m = 0; m < 4; ++m) {
                    const f32x4 v = acc[ai][bj][m][0], g = acc[ai][bj][m][1];
                    f32x4 p1, p2;
#pragma unroll
                    for (int r = 0; r < 4; ++r) {
                        p1[r] = __builtin_bit_cast(float, __builtin_amdgcn_update_dpp(0, __builtin_bit_cast(int, (fr == 15) ? gprev[r] : g[r]), 0x121, 0xF, 0xF, false));
                        p2[r] = __builtin_bit_cast(float, __builtin_amdgcn_update_dpp(0, __builtin_bit_cast(int, (fr >= 14) ? gprev[r] : g[r]), 0x122, 0xF, 0xF, false));
                    }
                    const int row = u.pm * 256 + ai * 128 + wr * 64 + m * 16 + fr;
                    const int wb = row >> 6;
                    if (m == 0 && fr < 2) {
                        *(f32x4*)(gfirst + ((size_t)wb * 2 + fr) * FH + hc) = g;
                        *(f32x4*)(vfirst + ((size_t)wb * 2 + fr) * FH + hc) = v;
                    } else {
                        f32x4 o;
                        o[0] = gelu_t(bb.x + w0.x * p2[0] + w1.x * p1[0] + w2.x * g[0]) * v[0];
                        o[1] = gelu_t(bb.y + w0.y * p2[1] + w1.y * p1[1] + w2.y * g[1]) * v[1];
                        o[2] = gelu_t(bb.z + w0.z * p2[2] + w1.z * p1[2] + w2.z * g[2]) * v[2];
                        o[3] = gelu_t(bb.w + w0.w * p2[3] + w1.w * p1[3] + w2.w * g[3]) * v[3];
                        *(uint2*)(hid + (size_t)row * FH + hc) = pk4(o);
                    }
                    if (m == 3 && fr >= 14) *(f32x4*)(glast + ((size_t)wb * 2 + (fr - 14)) * FH + hc) = g;
                    gprev = g;
                }
            }
        }
    }
};

DI void phase12(const Params& p) {
    bf16_t* hid = (bf16_t*)(p.ws + 4 * U_);
    const float* glast = p.out;
    const float* gfirst = p.out + HALO_ELEMS;
    const float* vfirst = p.out + 2 * HALO_ELEMS;
    const float* cw = p.in[25];
    const float* cb = p.in[26];
    const int gtid = blockIdx.x * 512 + fresh_tid(), gstr = gridDim.x * 512;
    for (int idx = gtid; idx < 512 * 2 * (FH / 4); idx += gstr) {
        const int cgp = idx % (FH / 4), rr = (idx / (FH / 4)) & 1, wb = idx / (2 * (FH / 4));
        const int hc = cgp * 4;
        const bool seq_start = (wb & 127) == 0;
        const int pb = seq_start ? wb : wb - 1;
        const float pz = seq_start ? 0.f : 1.f;
        float4 la = *(const float4*)(glast + ((size_t)pb * 2 + 0) * FH + hc), lb = *(const float4*)(glast + ((size_t)pb * 2 + 1) * FH + hc);
        la.x *= pz; la.y *= pz; la.z *= pz; la.w *= pz; lb.x *= pz; lb.y *= pz; lb.z *= pz; lb.w *= pz;
        const float4 f0 = *(const float4*)(gfirst + ((size_t)wb * 2 + 0) * FH + hc), f1 = *(const float4*)(gfirst + ((size_t)wb * 2 + 1) * FH + hc);
        float4 gm2, gm1, g0;
        if (rr == 0) { gm2 = la; gm1 = lb; g0 = f0; } else { gm2 = lb; gm1 = f0; g0 = f1; }
        const float4 v = *(const float4*)(vfirst + ((size_t)wb * 2 + rr) * FH + hc);
        const float4 w0 = *(const float4*)(cw + hc), w1 = *(const float4*)(cw + FH + hc), w2 = *(const float4*)(cw + 2 * FH + hc), bb = *(const float4*)(cb + hc);
        f32x4 o;
        o[0] = gelu_t(bb.x + w0.x * gm2.x + w1.x * gm1.x + w2.x * g0.x) * v.x;
        o[1] = gelu_t(bb.y + w0.y * gm2.y + w1.y * gm1.y + w2.y * g0.y) * v.y;
        o[2] = gelu_t(bb.z + w0.z * gm2.z + w1.z * gm1.z + w2.z * g0.z) * v.z;
        o[3] = gelu_t(bb.w + w0.w * gm2.w + w1.w * gm1.w + w2.w * g0.w) * v.w;
        *(uint2*)(hid + ((size_t)wb * 64 + rr) * FH + hc) = pk4(o);
    }
}

DI void phase14(const Params& p) {
    int ft_ = threadIdx.x; asm volatile("" : "+v"(ft_));
    const int lane = ft_ & 63, wid = ft_ >> 6;
    for (int row0 = (blockIdx.x * 8 + wid) * 4; row0 < T_; row0 += gridDim.x * 32) {
        float v[4][16];
#pragma unroll
        for (int rr = 0; rr < 4; ++rr)
#pragma unroll
            for (int i = 0; i < 4; ++i) { uint2 t = *(const uint2*)((const bf16_t*)(p.ws + 1 * U_) + (size_t)(row0 + rr) * 1024 + i * 256 + lane * 4); v[rr][4 * i] = bf2f(t.x & 0xffff); v[rr][4 * i + 1] = bf2f(t.x >> 16); v[rr][4 * i + 2] = bf2f(t.y & 0xffff); v[rr][4 * i + 3] = bf2f(t.y >> 16); }
#pragma unroll
        for (int rr = 0; rr < 4; ++rr) {
            float* xr = p.out + (size_t)(row0 + rr) * 1024;
            float mean, rstd; row_stats(v[rr], mean, rstd);
#pragma unroll
            for (int i = 0; i < 4; ++i) {
                int c = i * 256 + lane * 4;
                float4 g = *(const float4*)(p.in[28] + c), bb = *(const float4*)(p.in[29] + c);
                *(float4*)(xr + c) = make_float4((v[rr][4 * i] - mean) * rstd * g.x + bb.x, (v[rr][4 * i + 1] - mean) * rstd * g.y + bb.y,
                                                 (v[rr][4 * i + 2] - mean) * rstd * g.z + bb.z, (v[rr][4 * i + 3] - mean) * rstd * g.w + bb.w);
            }
        }
    }
}

#define XB_TMO      128
#define XB_XCNT(j)  (256  + 64 * (j))
#define XB_XSUB(j)  (1280 + 64 * (j))
#define XB_XGEN(j)  (2304 + 64 * (j))
#define XB_TOP      3328
#define XB_TOPGEN   3392
#define XB_SPIN_CAP (1u << 22)
DI unsigned xb_ld(unsigned* p)              { return __hip_atomic_load(p, __ATOMIC_RELAXED, __HIP_MEMORY_SCOPE_AGENT); }
DI unsigned xb_add(unsigned* p, unsigned v) { return __hip_atomic_fetch_add(p, v, __ATOMIC_RELAXED, __HIP_MEMORY_SCOPE_AGENT); }
DI unsigned xb_xcc_id() { return (unsigned)__builtin_amdgcn_s_getreg((3 << 11) | 20) & 0xFu; }
#define XB_SPIN(cond, bar) do { unsigned _sp = 0; while (cond) { __builtin_amdgcn_s_sleep(1); \
    if ((++_sp & 255u) == 0u) { if (xb_ld(&(bar)[XB_TMO])) break; if (_sp > XB_SPIN_CAP) { atomicAdd(&(bar)[XB_TMO], 1u); break; } } } } while (0)
DI void xcd_barrier_complete(unsigned* bar, unsigned x, unsigned& nloc, unsigned& nx) {
    const unsigned G = gridDim.x;
    unsigned sum, cnt, mine, sp = 0u;
    for (;;) {
        sum = 0u; cnt = 0u; mine = 0u;
#pragma unroll
        for (unsigned j = 0; j < 16; ++j) { const unsigned c = xb_ld(&bar[XB_XCNT(j)]); sum += c; cnt += (c > 0u) ? 1u : 0u; mine = (j == x) ? c : mine; }
        if (sum == G) break;
        __builtin_amdgcn_s_sleep(1);
        if ((++sp & 255u) == 0u) { if (xb_ld(&bar[XB_TMO])) break; if (sp > XB_SPIN_CAP) { atomicAdd(&bar[XB_TMO], 1u); break; } }
    }
    nloc = mine > 0u ? mine : 1u; nx = cnt > 0u ? cnt : 1u;
}
DI void xcd_barrier(unsigned* bar, volatile __attribute__((address_space(3))) unsigned* st) {
    asm volatile("s_waitcnt vmcnt(0)" ::: "memory");
    __syncthreads();
    if (fresh_tid() == 0) {
        __builtin_amdgcn_s_waitcnt(0);
        const unsigned x = xb_xcc_id();
        unsigned nloc = st[0], nx = st[1];
        if (nloc == 0u) { xcd_barrier_complete(bar, x, nloc, nx); st[0] = nloc; st[1] = nx; }
        const unsigned old = xb_add(&bar[XB_XSUB(x)], 1u);
        const unsigned gen = old / nloc;
        if (old + 1u == (gen + 1u) * nloc) {
            __builtin_amdgcn_fence(__ATOMIC_RELEASE, "agent");
            asm volatile("s_waitcnt vmcnt(0)" ::: "memory");
            const unsigned og = xb_add(&bar[XB_TOP], 1u);
            const unsigned tg = og / nx;
            if (og + 1u == (tg + 1u) * nx) xb_add(&bar[XB_TOPGEN], 1u);
            else XB_SPIN(xb_ld(&bar[XB_TOPGEN]) == tg, bar);
            __builtin_amdgcn_fence(__ATOMIC_ACQUIRE, "agent");
            xb_add(&bar[XB_XGEN(x)], 1u);
            asm volatile("s_waitcnt vmcnt(0)" ::: "memory");
        } else {
            XB_SPIN(xb_ld(&bar[XB_XGEN(x)]) == gen, bar);
            __builtin_amdgcn_fence(__ATOMIC_ACQUIRE, "agent");
            asm volatile("s_waitcnt vmcnt(0)" ::: "memory");
        }
    }
    __syncthreads();
}

constexpr int LDS_BYTES = 131072;
__global__ void __launch_bounds__(512, 2) fwd_megakernel(Params p) {
    extern __shared__ __attribute__((aligned(16))) unsigned char lds[];
    cg::grid_group grid = cg::this_grid();
    unsigned* bar = (unsigned*)(p.ws + OFF_BAR);
    __shared__ __attribute__((aligned(16))) unsigned xb_st[4];
    volatile __attribute__((address_space(3))) unsigned* st = (volatile __attribute__((address_space(3))) unsigned*)xb_st;
    if (threadIdx.x < 4) xb_st[threadIdx.x] = 0u;
    __syncthreads();
    if (threadIdx.x == 0) (void)xb_add(&bar[XB_XCNT(xb_xcc_id())], 1u);
#define GSYNC() xcd_barrier(bar, st)
#define HALF_CTX int ft_ = threadIdx.x; asm volatile("" : "+v"(ft_)); const int half = ft_ >> 8, vtid = ft_ & 255; \
    const int vb = blockIdx.x * 2 + half, nvb = gridDim.x * 2; unsigned char* hsm = lds + half * 65536;
    PG8_LAS unsigned char* glds = (PG8_LAS unsigned char*)lds;
    unsigned char* ws = p.ws;
    pg8::StaticOrder S;
    if (p.out == nullptr) grid.sync();
    { HALF_CTX phase0(p, hsm, vtid, vb, nvb); }
    GSYNC();
    phase1(p, lds);
    GSYNC();
    {
        pg8::Gemm g{(const bf16_t*)(ws + 1 * U_), (const bf16_t*)(ws + OFF_WIN), 1024, 1024, 1024, 0};
        S.init(T_, 4608, gridDim.x, blockIdx.x);
        EpiIn E{p.in[5], (bf16_t*)(ws + 2 * U_), (bf16_t*)(ws + 3 * U_), (bf16_t*)(ws + 4 * U_), (bf16_t*)(ws + 5 * U_), (bf16_t*)(ws + 6 * U_), (bf16_t*)(ws + 7 * U_)};
        pg8::gemm_phase(glds, g, S, E);
    }
    GSYNC();
    { HALF_CTX phase3(p, hsm, vtid, vb, nvb); }
    GSYNC();
    phase4_small(p, lds);
    {
        bf16_t* q = (bf16_t*)((unsigned char*)p.out + U_);
        pg8::Gemm g{(const bf16_t*)(ws + 1 * U_), (const bf16_t*)(ws + OFF_WQK), 1024, 256, 256, 512};
        S.init(T_, 1024, gridDim.x, blockIdx.x);
        EpiQK E{q, q + (size_t)16 * 8192 * 128, (bf16_t*)(ws + 7 * U_ + U_ / 2)};
        pg8::gemm_phase(glds, g, S, E);
    }
    GSYNC();
    { HALF_CTX phase5(p, hsm, vtid, vb, nvb); }
    GSYNC();
    phase6_scan(p);
    {
        pg8::Gemm g{(const bf16_t*)p.out, (const bf16_t*)(ws + OFF_WGL), 512, 512, 512, 0};
        S.init(T_, 2048, gridDim.x, blockIdx.x);
        EpiGlu E{(bf16_t*)(ws + 7 * U_)};
        pg8::gemm_phase(glds, g, S, E);
    }
    GSYNC();
    { HALF_CTX for (int u = vb; u < 2048; u += nvb) mlstm_out_unit(p, hsm, vtid, u); }
    GSYNC();
    {
        pg8::Gemm g{(const bf16_t*)p.out, (const bf16_t*)(ws + OFF_WDN), 1024, 1024, 1024, 0};
        S.init(T_, 1024, gridDim.x, blockIdx.x);
        EpiDown E{(const unsigned char*)(ws + 5 * U_), (const unsigned char*)(ws + 6 * U_), (const bf16_t*)(ws + 7 * U_), (bf16_t*)(ws + 1 * U_)};
        pg8::gemm_phase(glds, g, S, E);
    }
    GSYNC();
    {
        pg8::Gemm g{(const bf16_t*)(ws + 1 * U_), (const bf16_t*)(ws + OFF_WMX), 1024, 1024, 1024, 0};
        S.init(T_, 1024, gridDim.x, blockIdx.x);
        EpiRes E{p.in[0], (const float*)(ws + OFF_MOD) + 2048, (bf16_t*)(ws + 2 * U_)};
        pg8::gemm_phase(glds, g, S, E);
    }
    GSYNC();
    phase10(p);
    GSYNC();
    {
        pg8::Gemm g{(const bf16_t*)(ws + 1 * U_), (const bf16_t*)(ws + OFF_WUP), 1024, 1024, 1024, 0};
        S.init(T_, 5632, gridDim.x, blockIdx.x);
        EpiUpF E{(bf16_t*)(ws + 4 * U_), p.in[25], p.in[26], p.out, p.out + HALO_ELEMS, p.out + 2 * HALO_ELEMS};
        pg8::gemm_phase(glds, g, S, E);
    }
    GSYNC();
    phase12(p);
    GSYNC();
    {
        pg8::Gemm g{(const bf16_t*)(ws + 4 * U_), (const bf16_t*)(ws + OFF_WFD), FH, FH, FH, 0};
        S.init(T_, 1024, gridDim.x, blockIdx.x);
        EpiRes2 E{(const bf16_t*)(ws + 2 * U_), (const float2*)(ws + OFF_STATS), p.in[22], p.in[23], (const float*)(ws + OFF_MOD) + 5120, (bf16_t*)(ws + 1 * U_)};
        pg8::gemm_phase(glds, g, S, E);
    }
    GSYNC();
    phase14(p);
}

extern "C" void kernel_launch(void* const* d_in, const int* in_sizes, int n_in, void* d_out, int out_size, void* d_ws, size_t ws_size, hipStream_t stream) {
    static int grid_blocks = 0;
    if (grid_blocks == 0) {
        if (n_in != 30 || out_size != T_ * 1024 || ws_size < 8 * U_) { fprintf(stderr, "kernel_launch: unexpected shapes (n_in %d out %d ws %zu)\n", n_in, out_size, ws_size); grid_blocks = -1; return; }
        int dev = 0, cus = 0, per_cu = 0;
        (void)hipGetDevice(&dev);
        (void)hipDeviceGetAttribute(&cus, hipDeviceAttributeMultiprocessorCount, dev);
        if (hipFuncSetAttribute((const void*)fwd_megakernel, hipFuncAttributeMaxDynamicSharedMemorySize, LDS_BYTES) != hipSuccess) { fprintf(stderr, "hipFuncSetAttribute failed\n"); grid_blocks = -1; return; }
        (void)hipOccupancyMaxActiveBlocksPerMultiprocessor(&per_cu, fwd_megakernel, 512, LDS_BYTES);
        if (per_cu < 1) { fprintf(stderr, "occupancy query says 0 blocks/CU\n"); per_cu = 1; }
        grid_blocks = cus;
    }
    if (grid_blocks < 0) return;
    Params p{};
    for (int i = 0; i < 30; ++i) p.in[i] = (const float*)d_in[i];
    p.out = (float*)d_out;
    p.ws = (unsigned char*)d_ws;
    if (hipMemsetAsync((unsigned char*)d_ws + OFF_BAR, 0, 16384, stream) != hipSuccess) { fprintf(stderr, "memset failed\n"); return; }
    void* args[] = {&p};
    hipError_t e = hipLaunchCooperativeKernel((const void*)fwd_megakernel, dim3(grid_blocks), dim3(512), args, LDS_BYTES, stream);
    if (e != hipSuccess) fprintf(stderr, "cooperative launch failed: %s (grid %d)\n", hipGetErrorString(e), grid_blocks);
}
```

```cpp
#include <hip/hip_runtime.h>
#include <hip/hip_cooperative_groups.h>
#include <cstdio>
#include <cstdint>
namespace cg = cooperative_groups;

#define DI __device__ __forceinline__
typedef unsigned short bf16_t;
typedef short bf16x8 __attribute__((ext_vector_type(8)));
typedef float f32x4 __attribute__((ext_vector_type(4)));

constexpr int T_ = 32768, S_ = 8192, FH = 2816;
constexpr size_t U_ = 67108864;
constexpr float ALPHA_ = 1.189207115002721f;

constexpr size_t OFF_WIN = 0;
constexpr size_t OFF_WQK = OFF_WIN + 9437184;
constexpr size_t OFF_WDN = OFF_WQK + 524288;
constexpr size_t OFF_WGL = OFF_WDN + 2097152;
constexpr size_t OFF_WMX = OFF_WGL + 2097152;
constexpr size_t OFF_WUP = OFF_WMX + 2097152;
constexpr size_t OFF_WFD = OFF_WUP + 11534336;
constexpr size_t OFF_MOD = OFF_WFD + 5767168;
constexpr size_t OFF_APOW = OFF_MOD + 98304;
constexpr size_t OFF_BBAR = OFF_APOW + 1064960;
constexpr size_t OFF_KC = OFF_BBAR + 262144;
constexpr size_t OFF_EMAT = OFF_KC + 1048576;
constexpr size_t OFF_CMAT = OFF_EMAT + 8388608;
constexpr size_t OFF_IG = OFF_CMAT + 8388608;
constexpr size_t OFF_LOGF = OFF_IG + 524288;
constexpr size_t OFF_BCUM = OFF_LOGF + 524288;
constexpr size_t OFF_AARR = OFF_BCUM + 524288;
constexpr size_t OFF_BLAST = OFF_AARR + 8192;
constexpr size_t OFF_MST = OFF_BLAST + 8192;
constexpr size_t OFF_NU = OFF_MST + 8448;
constexpr size_t OFF_BAR = OFF_NU + 1048576;
constexpr size_t OFF_STATS = OFF_BAR + 16384;
constexpr size_t OFF_END = OFF_STATS + 262144;
static_assert(OFF_END <= U_, "R0 overflow");

struct Params { const float* in[30]; float* out; unsigned char* ws; };

DI float bf2f(unsigned short h) { return __uint_as_float(((unsigned)h) << 16); }
typedef __bf16 bf16x2_t __attribute__((ext_vector_type(2)));
typedef float f32x2_t __attribute__((ext_vector_type(2)));
DI unsigned pk2(float lo, float hi) { f32x2_t v = {lo, hi}; bf16x2_t b = __builtin_convertvector(v, bf16x2_t); return __builtin_bit_cast(unsigned, b); }
DI unsigned short f2bf(float x) { return (unsigned short)(pk2(x, 0.f) & 0xffffu); }
DI uint2 pk4(f32x4 v) { return make_uint2(pk2(v[0], v[1]), pk2(v[2], v[3])); }
DI float sigm(float x) { return __builtin_amdgcn_rcpf(1.f + __expf(-x)); }
DI float gelu_t(float x) { float u = 1.5957691216057308f * (x + 0.044715f * x * x * x); return x * __builtin_amdgcn_rcpf(1.f + __expf(-u)); }
DI float logsig(float x) { return (x < 0.f) ? (x - log1pf(__expf(x))) : (-log1pf(__expf(-x))); }
DI bf16x8 ld16(const bf16_t* p) { return *reinterpret_cast<const bf16x8*>(p); }
DI f32x4 mfma16(bf16x8 a, bf16x8 b, f32x4 c) { return __builtin_amdgcn_mfma_f32_16x16x32_bf16(a, b, c, 0, 0, 0); }
DI int fresh_tid() { int t = threadIdx.x; asm volatile("" : "+v"(t)); return t; }
DI float dpp_f(float v, const int ctrl_sel) {
    int x = __builtin_bit_cast(int, v), r;
    if (ctrl_sel == 0) r = __builtin_amdgcn_update_dpp(0, x, 0xB1, 0xF, 0xF, false);
    else if (ctrl_sel == 1) r = __builtin_amdgcn_update_dpp(0, x, 0x4E, 0xF, 0xF, false);
    else if (ctrl_sel == 2) r = __builtin_amdgcn_update_dpp(0, x, 0x141, 0xF, 0xF, false);
    else r = __builtin_amdgcn_update_dpp(0, x, 0x140, 0xF, 0xF, false);
    return __builtin_bit_cast(float, r);
}
DI float wsum(float v) {
    v += dpp_f(v, 0); v += dpp_f(v, 1); v += dpp_f(v, 2); v += dpp_f(v, 3);
    const int x = __builtin_bit_cast(int, v);
    return __builtin_bit_cast(float, __builtin_amdgcn_readlane(x, 0)) + __builtin_bit_cast(float, __builtin_amdgcn_readlane(x, 16))
         + __builtin_bit_cast(float, __builtin_amdgcn_readlane(x, 32)) + __builtin_bit_cast(float, __builtin_amdgcn_readlane(x, 48));
}

template <class LA, class LB>
DI void gemm_tile(unsigned char* smem, const int tid, int nk, LA la, LB lb, f32x4 (&acc)[4][4]) {
    const int lane = tid & 63, wid = tid >> 6;
    const int wf = wid >> 1, wt = wid & 1;
    const int lr = tid >> 3, lc = tid & 7;
    unsigned char* sA = smem;
    unsigned char* sB = smem + 32768;
#pragma unroll
    for (int i = 0; i < 4; ++i)
#pragma unroll
        for (int j = 0; j < 4; ++j) acc[i][j] = f32x4{0.f, 0.f, 0.f, 0.f};
    uint4 ra[4], rb[4], na[4], nb[4];
#pragma unroll
    for (int i = 0; i < 4; ++i) { ra[i] = la(lr + 32 * i, lc * 8); rb[i] = lb(lr + 32 * i, lc * 8); }
    if (nk > 1) {
#pragma unroll
        for (int i = 0; i < 4; ++i) { na[i] = la(lr + 32 * i, 64 + lc * 8); nb[i] = lb(lr + 32 * i, 64 + lc * 8); }
    }
    const int woff = lr * 128 + ((lc ^ ((lr >> 1) & 7)) << 4);
#pragma unroll
    for (int i = 0; i < 4; ++i) { *(uint4*)(sA + woff + i * 4096) = ra[i]; *(uint4*)(sB + woff + i * 4096) = rb[i]; }
    __syncthreads();
    const int frow = lane & 15, fq = lane >> 4, fsw = (frow >> 1) & 7;
    for (int kt = 0; kt < nk; ++kt) {
        const int cur = kt & 1;
#pragma unroll
        for (int i = 0; i < 4; ++i) { ra[i] = na[i]; rb[i] = nb[i]; }
        if (kt + 2 < nk) {
#pragma unroll
            for (int i = 0; i < 4; ++i) { na[i] = la(lr + 32 * i, (kt + 2) * 64 + lc * 8); nb[i] = lb(lr + 32 * i, (kt + 2) * 64 + lc * 8); }
        }
        const unsigned char* cA = sA + cur * 16384 + (wf * 64 + frow) * 128;
        const unsigned char* cB = sB + cur * 16384 + (wt * 64 + frow) * 128;
#pragma unroll
        for (int ks = 0; ks < 2; ++ks) {
            const int ch = ((ks * 4 + fq) ^ fsw) << 4;
            bf16x8 af[4], bfr[4];
#pragma unroll
            for (int i = 0; i < 4; ++i) { af[i] = *(const bf16x8*)(cA + i * 2048 + ch); bfr[i] = *(const bf16x8*)(cB + i * 2048 + ch); }
#pragma unroll
            for (int i = 0; i < 4; ++i)
#pragma unroll
                for (int j = 0; j < 4; ++j) acc[i][j] = mfma16(af[i], bfr[j], acc[i][j]);
        }
        if (kt + 1 < nk) {
            const int nbuf = (cur ^ 1) * 16384;
#pragma unroll
            for (int i = 0; i < 4; ++i) { *(uint4*)(sA + nbuf + woff + i * 4096) = ra[i]; *(uint4*)(sB + nbuf + woff + i * 4096) = rb[i]; }
        }
        __syncthreads();
    }
}
template <class F>
DI void epi_loop(f32x4 (&acc)[4][4], const int vtid_, F f) {
    const int lane_ = vtid_ & 63, wid_ = vtid_ >> 6, wf_ = wid_ >> 1, wt_ = wid_ & 1;
#pragma unroll
    for (int fi = 0; fi < 4; ++fi)
#pragma unroll
        for (int ti = 0; ti < 4; ++ti) f(wf_ * 64 + fi * 16 + (lane_ >> 4) * 4, wt_ * 64 + ti * 16 + (lane_ & 15), acc[fi][ti]);
}


namespace pg8 {
#define PG8_LAS __attribute__((address_space(3)))
constexpr int BM = 256, BK = 64, HALF = 128, HTB = HALF * BK * 2, NXCD = 8, WGM = 4;
DI int lds_byte(int r, int c) { const int st = (r >> 4) * 2 + (c >> 5), rr = r & 15, cc = c & 31, ob = rr * 64 + cc * 2; return st * 1024 + (ob ^ (((ob >> 9) & 1) << 5)); }
DI void stage_rc(int b, int& R, int& C) { const int st = b / 1024, sb = b % 1024, swz = sb ^ (((sb >> 9) & 1) << 5); R = (st >> 1) * 16 + swz / 64; C = (st & 1) * 32 + (swz % 64) / 2; }
DI int perm32(int rho) { const int n = rho >> 4, i = rho & 15; return 8 * (i >> 2) + 4 * n + (i & 3); }
struct Unit { int pm, pn; };
struct Gemm { const bf16_t* A; const bf16_t* Bt; int lda, ldb, K, a_pn_off; };
struct StaticOrder {
    int nM, nN, nwg, G, c;
    DI void init(int M, int N, int G_, int c_) { nM = M / BM; nN = N / BM; nwg = nM * nN; G = G_; c = c_; }
    DI bool next(int i, Unit& u) const {
        const long L = (long)i * G + c; if (L >= nwg) return false;
        int wgid = (int)L; { const int q = nwg / NXCD, r = nwg % NXCD, xcd = wgid % NXCD, off = wgid / NXCD; wgid = (xcd < r ? xcd * (q + 1) : r * (q + 1) + (xcd - r) * q) + off; }
        const int nig = WGM * nN, gid = wgid / nig, fm = gid * WGM, gsz = (nM - fm) < WGM ? (nM - fm) : WGM;
        u.pm = fm + ((wgid % nig) % gsz); u.pn = (wgid % nig) / gsz; return true;
    }
};
template <class Epi>
DI void gemm_phase(PG8_LAS unsigned char* lds, const Gemm g, const StaticOrder& S, const Epi& E) {
    int tid = threadIdx.x; asm volatile("" : "+v"(tid));
    const int wid = __builtin_amdgcn_readfirstlane(tid >> 6), lane = tid & 63, wr = wid >> 2, wc = wid & 3, fr = lane & 15, fq = lane >> 4;
    const int nt = g.K / BK;
    unsigned voffA[2], voffB[2];
#pragma unroll
    for (int i = 0; i < 2; ++i) { int R, C; stage_rc(tid * 16 + i * 8192, R, C); const int Rb = (R & ~31) + perm32(R & 31);
        voffA[i] = (unsigned)(R * g.lda + C) * 2u; voffB[i] = (unsigned)(Rb * g.ldb + C) * 2u; }
    const size_t kstep = (size_t)(BK * 2);
    const size_t hstepA = (size_t)HALF * g.lda * 2, hstepB = (size_t)HALF * g.ldb * 2;
    const size_t tstepA = 2 * hstepA, tstepB = 2 * hstepB;
    const unsigned ldsw = (unsigned)wid * 1024u;
    const int aoff = lds_byte(wr * 64 + fr, fq * 8), boff = lds_byte(wc * 32 + fr, fq * 8);
#define PG8_SA(b, h) (((b) * 2 + (h)) * HTB)
#define PG8_SB(b, h) ((4 + (b) * 2 + (h)) * HTB)
#define PG8_STAGE(bufoff, gbase, voff) do { _Pragma("unroll") for (int _i = 0; _i < 2; ++_i) \
        __builtin_amdgcn_global_load_lds((const unsigned*)((const char*)(gbase) + (voff)[_i]), (PG8_LAS unsigned*)(lds + (bufoff) + ldsw + _i * 8192), 16, 0, 0); } while (0)
#define PG8_LDA(dst, b, h) do { _Pragma("unroll") for (int m = 0; m < 4; ++m) _Pragma("unroll") for (int k = 0; k < 2; ++k) dst[m][k] = *(const PG8_LAS bf16x8*)(lds + PG8_SA(b, h) + aoff + m * 2048 + k * 1024); } while (0)
#define PG8_LDB(dst, b, h) do { _Pragma("unroll") for (int n = 0; n < 2; ++n) _Pragma("unroll") for (int k = 0; k < 2; ++k) dst[n][k] = *(const PG8_LAS bf16x8*)(lds + PG8_SB(b, h) + boff + n * 2048 + k * 1024); } while (0)
#define PG8_MMA(ai, bj, At, Bt) do { __builtin_amdgcn_s_setprio(1); _Pragma("unroll") for (int m = 0; m < 4; ++m) _Pragma("unroll") for (int n = 0; n < 2; ++n) _Pragma("unroll") for (int k = 0; k < 2; ++k) \
        acc[ai][bj][m][n] = __builtin_amdgcn_mfma_f32_16x16x32_bf16(Bt[n][k], At[m][k], acc[ai][bj][m][n], 0, 0, 0); __builtin_amdgcn_s_setprio(0); } while (0)
#define PG8_WAIT_V(n) asm volatile("s_waitcnt vmcnt(" #n ")" ::: "memory")
#define PG8_WAIT_L(n) asm volatile("s_waitcnt lgkmcnt(" #n ")" ::: "memory")
#define PG8_BAR __builtin_amdgcn_s_barrier()
#define PG8_SCHED __builtin_amdgcn_sched_barrier(0)
    Unit cur, nxt; int ui = 0;
    if (!S.next(0, cur)) return;
    f32x4 acc[2][2][4][2];
#pragma unroll
    for (int a = 0; a < 2; ++a)
#pragma unroll
        for (int b = 0; b < 2; ++b)
#pragma unroll
            for (int m = 0; m < 4; ++m)
#pragma unroll
                for (int n = 0; n < 2; ++n) acc[a][b][m][n] = (f32x4){0.f, 0.f, 0.f, 0.f};
    bf16x8 At[4][2], B0[2][2], B1[2][2];
    const char* cA = (const char*)g.A + (size_t)cur.pm * tstepA + (size_t)cur.pn * g.a_pn_off; const char* cB = (const char*)g.Bt + (size_t)cur.pn * tstepB;
    PG8_STAGE(PG8_SB(0, 0), cB, voffB); PG8_STAGE(PG8_SB(0, 1), cB + hstepB, voffB); PG8_STAGE(PG8_SA(0, 0), cA, voffA); PG8_STAGE(PG8_SA(0, 1), cA + hstepA, voffA);
    if (wr == 1) PG8_BAR;
    PG8_WAIT_V(2); PG8_BAR;
    PG8_STAGE(PG8_SB(1, 0), cB + kstep, voffB); PG8_STAGE(PG8_SA(1, 0), cA + kstep, voffA); PG8_STAGE(PG8_SB(1, 1), cB + hstepB + kstep, voffB);
    PG8_WAIT_V(6); PG8_BAR;
    for (;;) {
        const bool has_next = S.next(ui + 1, nxt);
        const char* nA = has_next ? (const char*)g.A + (size_t)nxt.pm * tstepA + (size_t)nxt.pn * g.a_pn_off : cA; const char* nB = has_next ? (const char*)g.Bt + (size_t)nxt.pn * tstepB : cB;
        for (int t = 0; t < nt; t += 2) {
            const bool last = (t == nt - 2);
            const char* a1 = cA + (size_t)(t + 1) * kstep;
            const char* a2 = last ? nA : cA + (size_t)(t + 2) * kstep; const char* b2 = last ? nB : cB + (size_t)(t + 2) * kstep;
            const char* a3 = a2 + kstep; const char* b3 = b2 + kstep;
            PG8_LDB(B0, 0, 0); PG8_LDB(B1, 0, 1); PG8_SCHED; PG8_LDA(At, 0, 0); PG8_STAGE(PG8_SA(1, 1), a1 + hstepA, voffA);
            PG8_WAIT_V(8); PG8_WAIT_L(0); PG8_BAR; PG8_MMA(0, 0, At, B0); PG8_MMA(0, 1, At, B1); PG8_BAR; PG8_SCHED;
            PG8_LDA(At, 0, 1); PG8_STAGE(PG8_SB(0, 0), b2, voffB); PG8_STAGE(PG8_SB(0, 1), b2 + hstepB, voffB); PG8_STAGE(PG8_SA(0, 0), a2, voffA);
            PG8_WAIT_V(8); PG8_WAIT_L(0); PG8_BAR; PG8_MMA(1, 0, At, B0); PG8_MMA(1, 1, At, B1); PG8_BAR; PG8_SCHED;
            PG8_LDB(B0, 1, 0); PG8_LDB(B1, 1, 1); PG8_SCHED; PG8_LDA(At, 1, 0); PG8_STAGE(PG8_SA(0, 1), a2 + hstepA, voffA);
            PG8_WAIT_V(8); PG8_WAIT_L(0); PG8_BAR; PG8_MMA(0, 0, At, B0); PG8_MMA(0, 1, At, B1); PG8_BAR; PG8_SCHED;
            PG8_LDA(At, 1, 1); PG8_STAGE(PG8_SB(1, 0), b3, voffB); PG8_STAGE(PG8_SB(1, 1), b3 + hstepB, voffB); PG8_STAGE(PG8_SA(1, 0), a3, voffA);
            PG8_WAIT_V(8); PG8_WAIT_L(0); PG8_BAR; PG8_MMA(1, 0, At, B0); PG8_MMA(1, 1, At, B1); PG8_BAR; PG8_SCHED;
        }
        if (wr == 0) PG8_BAR;
        { int efr = fr, efq = fq; asm volatile("" : "+v"(efr), "+v"(efq)); E(acc, cur, wr, wc, efr, efq); }
        if (!has_next) break;
#pragma unroll
        for (int a = 0; a < 2; ++a)
#pragma unroll
            for (int b = 0; b < 2; ++b)
#pragma unroll
                for (int m = 0; m < 4; ++m)
#pragma unroll
                    for (int n = 0; n < 2; ++n) acc[a][b][m][n] = (f32x4){0.f, 0.f, 0.f, 0.f};
        cur = nxt; cA = nA; cB = nB; ++ui;
        if (wr == 1) PG8_BAR;
    }
    PG8_WAIT_V(0);
    PG8_BAR;
#undef PG8_SA
#undef PG8_SB
#undef PG8_STAGE
#undef PG8_LDA
#undef PG8_LDB
#undef PG8_MMA
#undef PG8_WAIT_V
#undef PG8_WAIT_L
#undef PG8_BAR
#undef PG8_SCHED
}
template <class F>
DI void epi8(const f32x4 (&acc)[2][2][4][2], const Unit& u, int wr, int wc, int fr, int fq, F f) {
#pragma unroll
    for (int ai = 0; ai < 2; ++ai)
#pragma unroll
        for (int m = 0; m < 4; ++m)
#pragma unroll
            for (int bj = 0; bj < 2; ++bj) f(u.pm * 256 + ai * 128 + wr * 64 + m * 16 + fr, u.pn * 256 + bj * 128 + wc * 32 + 8 * fq, acc[ai][bj][m][0], acc[ai][bj][m][1]);
}
}
#define TILE_AI(i) ((i) >> 3)
#define TILE_M(i)  (((i) >> 1) & 3)
#define TILE_BJ(i) ((i) & 1)
DI unsigned pk4u8(f32x4 v) {
    unsigned r = 0;
    r = __builtin_amdgcn_cvt_pk_u8_f32(v[0] * 255.f, 0, r); r = __builtin_amdgcn_cvt_pk_u8_f32(v[1] * 255.f, 1, r);
    r = __builtin_amdgcn_cvt_pk_u8_f32(v[2] * 255.f, 2, r); r = __builtin_amdgcn_cvt_pk_u8_f32(v[3] * 255.f, 3, r);
    return r;
}
DI f32x4 un4u8(unsigned w) {
    const float k = 1.f / 255.f;
    return (f32x4){(float)(w & 0xffu) * k, (float)((w >> 8) & 0xffu) * k, (float)((w >> 16) & 0xffu) * k, (float)(w >> 24) * k};
}
DI uint4 pk8(f32x4 a, f32x4 b) { return make_uint4(pk2(a[0], a[1]), pk2(a[2], a[3]), pk2(b[0], b[1]), pk2(b[2], b[3])); }

struct RowMajor {
    const bf16_t* base; int ld;
    DI uint4 operator()(int r, int k) const { return *(const uint4*)(base + (size_t)r * ld + k); }
};

DI void transpose_tile(unsigned char* smem, const int tid, const float* src, int K, int N, bf16_t* dst, int ldd, int permid, int kt, int nt) {
    float (*tile)[65] = (float (*)[65])smem;
    const int k0 = kt * 64, n0 = nt * 64;
    float tv[16];
#pragma unroll
    for (int i = 0; i < 16; ++i) {
        int kk = i * 4 + (tid >> 6), nn = tid & 63;
        tv[i] = (n0 + nn < N) ? src[(size_t)(k0 + kk) * N + n0 + nn] : 0.f;
    }
#pragma unroll
    for (int i = 0; i < 16; ++i) tile[tid & 63][i * 4 + (tid >> 6)] = tv[i];
    __syncthreads();
#pragma unroll 4
    for (int i = 0; i < 16; ++i) {
        int nn = i * 4 + (tid >> 6), kk = tid & 63;
        int n = n0 + nn;
        if (n < N) {
            int row = n;
            if (permid == 1) row = (n < 2048) ? n : ((n >= 2056) ? n - 8 : -1);
            else if (permid == 2) row = (n < 1024) ? ((n >> 2) * 8 + (n & 3)) : (((n - 1024) >> 2) * 8 + 4 + (n & 3));
            else if (permid == 3) row = (n < 2816) ? ((n >> 2) * 8 + (n & 3)) : (((n - 2816) >> 2) * 8 + 4 + (n & 3));
            if (row >= 0) dst[(size_t)row * ldd + k0 + kk] = f2bf(tile[nn][kk]);
        }
    }
    __syncthreads();
}

DI void phase0(const Params& p, unsigned char* smem, const int tid, const int vb, const int nvb) {
    unsigned char* ws = p.ws;
    const int NTR = 4112, NADA = 192, NS5 = 32;
    for (int it0 = vb; it0 < NTR + NADA + NS5; it0 += nvb) {
        const int it = (it0 < NADA + NS5) ? (NTR + it0) : (it0 - NADA - NS5);
        if (it < NTR) {
            int id = it;
            if (id < 1168) { transpose_tile(smem, tid, p.in[4], 1024, 4616, (bf16_t*)(ws + OFF_WIN), 1024, 1, id / 73, id % 73); continue; }
            id -= 1168;
            if (id < 64) {
                int isk = id >> 5, r = id & 31, h = r >> 3, t = r & 7;
                transpose_tile(smem, tid, (isk ? p.in[9] : p.in[8]) + (size_t)h * 256 * 128, 256, 128,
                               (bf16_t*)(ws + OFF_WQK) + (size_t)h * 65536 + (isk ? 128 * 256 : 0), 256, 0, t >> 1, t & 1);
                continue;
            }
            id -= 64;
            if (id < 256) { transpose_tile(smem, tid, p.in[11], 1024, 1024, (bf16_t*)(ws + OFF_WDN), 1024, 0, id >> 4, id & 15); continue; }
            id -= 256;
            if (id < 256) { transpose_tile(smem, tid, p.in[20], 512, 2048, (bf16_t*)(ws + OFF_WGL), 512, 2, id >> 5, id & 31); continue; }
            id -= 256;
            if (id < 256) { transpose_tile(smem, tid, p.in[21], 1024, 1024, (bf16_t*)(ws + OFF_WMX), 1024, 0, id >> 4, id & 15); continue; }
            id -= 256;
            if (id < 1408) { transpose_tile(smem, tid, p.in[24], 1024, 5632, (bf16_t*)(ws + OFF_WUP), 1024, 3, id / 88, id % 88); continue; }
            id -= 1408;
            transpose_tile(smem, tid, p.in[27], 2816, 1024, (bf16_t*)(ws + OFF_WFD), 2816, 0, id >> 4, id & 15);
        } else if (it < NTR + NADA) {
            const int a = it - NTR;
            float* sc = (float*)smem;
            float* red = (float*)(smem + 16384);
            for (int i = tid; i < 4096; i += 256) { float v = p.in[1][i]; sc[i] = v / (1.f + __expf(-v)); }
            __syncthreads();
            const int col = tid & 31, kg = tid >> 5, n0 = a * 32;
            float a0 = 0, a1 = 0, a2 = 0, a3 = 0;
            const float* wp = p.in[2] + (size_t)(kg * 128) * 6144 + n0 + col;
#pragma unroll 16
            for (int k = 0; k < 128; ++k) {
                float w = wp[(size_t)k * 6144];
                int kk = kg * 128 + k;
                a0 += sc[kk] * w; a1 += sc[1024 + kk] * w; a2 += sc[2048 + kk] * w; a3 += sc[3072 + kk] * w;
            }
            red[(kg * 4 + 0) * 32 + col] = a0; red[(kg * 4 + 1) * 32 + col] = a1; red[(kg * 4 + 2) * 32 + col] = a2; red[(kg * 4 + 3) * 32 + col] = a3;
            __syncthreads();
            if (tid < 128) {
                int b = tid >> 5, c2 = tid & 31;
                float sacc = p.in[3][n0 + c2];
                for (int g = 0; g < 8; ++g) sacc += red[(g * 4 + b) * 32 + c2];
                ((float*)(ws + OFF_MOD))[b * 6144 + n0 + c2] = sacc;
            }
            __syncthreads();
        } else {
            const int g = it - NTR - NADA;
            const float dtf = expf(p.in[14][g]);
            const double dt = (double)dtf;
            float2* apow = (float2*)(ws + OFF_APOW);
            for (int idx = tid; idx < 64 * 65; idx += 256) {
                int pp = idx / 65, tau = idx % 65;
                double lr = p.in[12][g * 64 + pp], li = p.in[13][g * 64 + pp];
                double rev = li * dt * (double)tau * 0.15915494309189535;
                rev -= rint(rev);
                float mag = expf((float)(lr * dt * (double)tau));
                apow[((size_t)g * 65 + tau) * 64 + pp] = make_float2(mag * __builtin_amdgcn_cosf((float)rev), mag * __builtin_amdgcn_sinf((float)rev));
            }
            if (tid < 64) {
                int pp = tid;
                float lr = p.in[12][g * 64 + pp], li = p.in[13][g * 64 + pp];
                float em1 = expm1f(lr * dtf), mag = em1 + 1.f;
                double rev = (double)li * dt * 0.15915494309189535;
                double revh = 0.5 * rev;
                rev -= rint(rev); revh -= rint(revh);
                float sh = __builtin_amdgcn_sinf((float)revh);
                float arm1 = em1 - 2.f * mag * sh * sh;
                float ai = mag * __builtin_amdgcn_sinf((float)rev);
                float den = lr * lr + li * li;
                float zr = (arm1 * lr + ai * li) / den, zi = (ai * lr - arm1 * li) / den;
                float2* bb = (float2*)(ws + OFF_BBAR);
                for (int c2 = 0; c2 < 16; ++c2) {
                    float br = p.in[15][(size_t)(g * 64 + pp) * 16 + c2], bi = p.in[16][(size_t)(g * 64 + pp) * 16 + c2];
                    bb[(size_t)(g * 64 + pp) * 16 + c2] = make_float2(zr * br - zi * bi, zr * bi + zi * br);
                }
            }
            __syncthreads();
            __syncthreads();
        }
    }
}

DI void row_stats(const float (&v)[16], float& mean, float& rstd) {
    float s = 0.f;
#pragma unroll
    for (int i = 0; i < 16; ++i) s += v[i];
    mean = wsum(s) * (1.f / 1024.f);
    float q = 0.f;
#pragma unroll
    for (int i = 0; i < 16; ++i) { float d = v[i] - mean; q += d * d; }
    rstd = rsqrtf(wsum(q) * (1.f / 1024.f) + 1e-5f);
}

DI void phase1(const Params& p, unsigned char* smem) {
    unsigned char* ws = p.ws;
    int ft_ = threadIdx.x; asm volatile("" : "+v"(ft_));
    const int lane = ft_ & 63, wid = ft_ >> 6;
    const float* mod = (const float*)(ws + OFF_MOD);
    bf16_t* h1 = (bf16_t*)(ws + 1 * U_);
    float4 gw0[16], gw1[16];
#pragma unroll
    for (int i = 0; i < 4; ++i)
#pragma unroll
        for (int e = 0; e < 4; ++e) {
            const float* wp = p.in[4] + (size_t)(i * 256 + lane * 4 + e) * 4616 + 2048;
            gw0[i * 4 + e] = *(const float4*)wp; gw1[i * 4 + e] = *(const float4*)(wp + 4);
        }
    float* ig = (float*)(ws + OFF_IG);
    float* lf = (float*)(ws + OFF_LOGF);
    for (int row0 = (blockIdx.x * 8 + wid) * 4; row0 < T_; row0 += gridDim.x * 32) {
        float vv[4][16];
#pragma unroll
        for (int rr = 0; rr < 4; ++rr)
#pragma unroll
            for (int i = 0; i < 4; ++i) { float4 t = *(const float4*)(p.in[0] + (size_t)(row0 + rr) * 1024 + i * 256 + lane * 4); vv[rr][4 * i] = t.x; vv[rr][4 * i + 1] = t.y; vv[rr][4 * i + 2] = t.z; vv[rr][4 * i + 3] = t.w; }
#pragma unroll
        for (int rr = 0; rr < 4; ++rr) {
            const int row = row0 + rr;
            float mean, rstd; row_stats(vv[rr], mean, rstd);
            const float* mb = mod + (row >> 13) * 6144;
            float ga[8];
#pragma unroll
            for (int j = 0; j < 8; ++j) ga[j] = 0.f;
#pragma unroll
            for (int i = 0; i < 4; ++i) {
                int c = i * 256 + lane * 4;
                float4 sh = *(const float4*)(mb + c), sc = *(const float4*)(mb + 1024 + c);
                f32x4 o;
                o[0] = (vv[rr][4 * i] - mean) * rstd * (1.f + sc.x) + sh.x;
                o[1] = (vv[rr][4 * i + 1] - mean) * rstd * (1.f + sc.y) + sh.y;
                o[2] = (vv[rr][4 * i + 2] - mean) * rstd * (1.f + sc.z) + sh.z;
                o[3] = (vv[rr][4 * i + 3] - mean) * rstd * (1.f + sc.w) + sh.w;
                *(uint2*)(h1 + (size_t)row * 1024 + c) = pk4(o);
#pragma unroll
                for (int e = 0; e < 4; ++e) {
                    const float4 w0 = gw0[i * 4 + e], w1 = gw1[i * 4 + e];
                    ga[0] += o[e] * w0.x; ga[1] += o[e] * w0.y; ga[2] += o[e] * w0.z; ga[3] += o[e] * w0.w;
                    ga[4] += o[e] * w1.x; ga[5] += o[e] * w1.y; ga[6] += o[e] * w1.z; ga[7] += o[e] * w1.w;
                }
            }
#pragma unroll
            for (int j = 0; j < 8; ++j) ga[j] = wsum(ga[j]);
            if (lane < 8) {
                float val = ga[0];
#pragma unroll
                for (int j = 1; j < 8; ++j) val = (lane == j) ? ga[j] : val;
                val += p.in[5][2048 + lane];
                const int b = row >> 13, sidx = row & 8191;
                if (lane < 4) ig[(size_t)(b * 4 + lane) * 8192 + sidx] = val;
                else lf[(size_t)(b * 4 + lane - 4) * 8192 + sidx] = logsig(val);
            }
        }
    }
    const float2* apow = (const float2*)(ws + OFF_APOW);
    const float2* bbar = (const float2*)(ws + OFF_BBAR);
    const float* cre = p.in[17];
    const float* cim = p.in[18];
    const int gtid = blockIdx.x * 512 + fresh_tid(), gstr = gridDim.x * 512;
    bf16_t* emat = (bf16_t*)(ws + OFF_EMAT);
    for (int idx = gtid; idx < 32 * 128 * 128; idx += gstr) {
        const int g = idx >> 14, m = (idx >> 7) & 127, k8 = idx & 127;
        const int pp = m & 63, j = k8 >> 1, c20 = (k8 & 1) * 8;
        const float2 a = apow[((size_t)g * 65 + (63 - j)) * 64 + pp];
        const float4* bp = (const float4*)(bbar + (size_t)(g * 64 + pp) * 16 + c20);
        float o[8];
#pragma unroll
        for (int e = 0; e < 4; ++e) {
            float4 b2 = bp[e];
            o[2 * e] = (m < 64) ? (a.x * b2.x - a.y * b2.y) : (a.x * b2.y + a.y * b2.x);
            o[2 * e + 1] = (m < 64) ? (a.x * b2.z - a.y * b2.w) : (a.x * b2.w + a.y * b2.z);
        }
        *(uint4*)(emat + (size_t)idx * 8) = make_uint4(pk2(o[0], o[1]), pk2(o[2], o[3]), pk2(o[4], o[5]), pk2(o[6], o[7]));
    }
}

struct EpiIn {
    const float* bin; bf16_t *xm, *xmT, *og, *sga, *sgb, *us;
    DI void operator()(const f32x4 (&acc)[2][2][4][2], const pg8::Unit& u, int wr, int wc, int fr, int fq) const {
        const int pn = u.pn;
        int boff, c0, slot;
        if (pn < 4) { boff = 0; c0 = 0; slot = 0; }
        else if (pn < 8) { boff = 1024; c0 = 1024; slot = 0; }
        else if (pn < 10) { boff = 2056; c0 = 2048; slot = 0; }
        else if (pn < 14) { boff = 2568; c0 = 2560; slot = 1; }
        else { boff = 3592; c0 = 3584; slot = 2; }
        const int colb = pn * 256 + wc * 32 + 8 * fq - c0;
        f32x4 bia[2][2];
#pragma unroll
        for (int bj = 0; bj < 2; ++bj) { bia[bj][0] = *(const f32x4*)(bin + boff + colb + bj * 128); bia[bj][1] = *(const f32x4*)(bin + boff + colb + bj * 128 + 4); }
        const int t0 = u.pm * 256 + wr * 64 + fr;
        if (pn < 4) {
#pragma unroll
            for (int i = 0; i < 16; ++i) {
                const int ai = TILE_AI(i), m = TILE_M(i), bj = TILE_BJ(i);
                const int t = t0 + ai * 128 + m * 16, col = colb + bj * 128;
                const f32x4 v0 = acc[ai][bj][m][0] + bia[bj][0], v1 = acc[ai][bj][m][1] + bia[bj][1];
                *(uint4*)(xm + (size_t)t * 1024 + col) = pk8(v0, v1);
                const int b = t >> 13, sidx = t & 8191;
                bf16_t* tp = xmT + ((((size_t)(b * 4 + (col >> 8)) * 128 + (sidx >> 6)) * 256 + (col & 255)) * 64) + (sidx & 63);
#pragma unroll
                for (int r = 0; r < 4; ++r) { *tp = f2bf(v0[r]); tp += 64; asm volatile("" : "+v"(tp)); }
#pragma unroll
                for (int r = 0; r < 4; ++r) { *tp = f2bf(v1[r]); tp += 64; asm volatile("" : "+v"(tp)); }
            }
        } else if (pn == 8 || pn == 9) {
#pragma unroll
            for (int i = 0; i < 16; ++i) {
                const int ai = TILE_AI(i), m = TILE_M(i), bj = TILE_BJ(i);
                const int t = t0 + ai * 128 + m * 16, col = colb + bj * 128;
                *(uint4*)(us + ((((size_t)(col >> 4) * 512 + (t >> 6)) * 64 + (t & 63)) * 16 + (col & 15))) = pk8(acc[ai][bj][m][0] + bia[bj][0], acc[ai][bj][m][1] + bia[bj][1]);
            }
        } else {
            unsigned char* dst = (unsigned char*)og + (size_t)slot * U_;
#pragma unroll
            for (int i = 0; i < 16; ++i) {
                const int ai = TILE_AI(i), m = TILE_M(i), bj = TILE_BJ(i);
                const int t = t0 + ai * 128 + m * 16, col = colb + bj * 128;
                f32x4 v0 = acc[ai][bj][m][0] + bia[bj][0], v1 = acc[ai][bj][m][1] + bia[bj][1];
#pragma unroll
                for (int r = 0; r < 4; ++r) { v0[r] = sigm(v0[r]); v1[r] = sigm(v1[r]); }
                *(uint2*)(dst + (size_t)t * 1024 + col) = make_uint2(pk4u8(v0), pk4u8(v1));
            }
        }
    }
};

DI void s5_tables_late(const Params& p, const int gtid, const int gstr) {
    unsigned char* ws = p.ws;
    const float2* apow = (const float2*)(ws + OFF_APOW);
    const float2* bbar = (const float2*)(ws + OFF_BBAR);
    const float* cre = p.in[17];
    const float* cim = p.in[18];
    bf16_t* kc = (bf16_t*)(ws + OFF_KC);
    for (int idx = gtid; idx < 32 * 64 * 16 * 2; idx += gstr) {
        const int g = idx >> 11, tau = (idx >> 5) & 63, c = (idx >> 1) & 15, c20 = (idx & 1) * 8;
        float sacc[8];
#pragma unroll
        for (int e = 0; e < 8; ++e) sacc[e] = 0.f;
#pragma unroll 4
        for (int pp = 0; pp < 64; ++pp) {
            const float cr = cre[(size_t)(g * 16 + c) * 64 + pp], ci = cim[(size_t)(g * 16 + c) * 64 + pp];
            const float2 a = apow[((size_t)g * 65 + tau) * 64 + pp];
            const float wr_ = cr * a.x - ci * a.y, wi_ = cr * a.y + ci * a.x;
            const float4* bp = (const float4*)(bbar + (size_t)(g * 64 + pp) * 16 + c20);
#pragma unroll
            for (int e = 0; e < 4; ++e) { float4 b2 = bp[e]; sacc[2 * e] += wr_ * b2.x - wi_ * b2.y; sacc[2 * e + 1] += wr_ * b2.z - wi_ * b2.w; }
        }
        *(uint4*)(kc + (((size_t)(g * 64 + tau) * 16 + c) * 16 + c20)) = make_uint4(pk2(sacc[0], sacc[1]), pk2(sacc[2], sacc[3]), pk2(sacc[4], sacc[5]), pk2(sacc[6], sacc[7]));
    }
    bf16_t* cmat = (bf16_t*)(ws + OFF_CMAT);
    for (int idx = gtid; idx < 32 * 1024 * 16; idx += gstr) {
        const int g = idx >> 14, m = (idx >> 4) & 1023, kk0 = (idx & 15) * 8;
        const int t = m >> 4, c = m & 15, p0 = kk0 & 63;
        const float4* crp = (const float4*)(cre + (size_t)(g * 16 + c) * 64 + p0);
        const float4* cip = (const float4*)(cim + (size_t)(g * 16 + c) * 64 + p0);
        float4 cr0 = crp[0], cr1 = crp[1], ci0 = cip[0], ci1 = cip[1];
        const float crv[8] = {cr0.x, cr0.y, cr0.z, cr0.w, cr1.x, cr1.y, cr1.z, cr1.w};
        const float civ[8] = {ci0.x, ci0.y, ci0.z, ci0.w, ci1.x, ci1.y, ci1.z, ci1.w};
        float o[8];
#pragma unroll
        for (int e = 0; e < 8; ++e) {
            const float2 a = apow[((size_t)g * 65 + t + 1) * 64 + p0 + e];
            o[e] = (kk0 < 64) ? (crv[e] * a.x - civ[e] * a.y) : -(crv[e] * a.y + civ[e] * a.x);
        }
        *(uint4*)(cmat + (size_t)idx * 8) = make_uint4(pk2(o[0], o[1]), pk2(o[2], o[3]), pk2(o[4], o[5]), pk2(o[6], o[7]));
    }
}

DI void phase3(const Params& p, unsigned char* smem, const int tid, const int vb, const int nvb) {
    unsigned char* ws = p.ws;
    const bf16_t* us = (const bf16_t*)(ws + 7 * U_);
    const bf16_t* emat = (const bf16_t*)(ws + OFF_EMAT);
    float* ebuf = (float*)((unsigned char*)p.out + (size_t)48 * 1048576);
    const bf16_t* xm = (const bf16_t*)(ws + 2 * U_);
    bf16_t* xc = (bf16_t*)(ws + 1 * U_);
    for (int it = vb; it < 256; it += nvb) {
        const int g = it >> 3, nt = (it >> 1) & 3, kh = it & 1;
        f32x4 acc[4][4];
        auto lb = [=](int r, int k) -> uint4 { return *(const uint4*)(us + ((size_t)g * 512 + nt * 128 + r) * 1024 + kh * 512 + k); };
        gemm_tile(smem, tid, 8, RowMajor{emat + (size_t)g * 128 * 1024 + kh * 512, 1024}, lb, acc);
        epi_loop(acc, tid, [&](const int epi_f, const int epi_t, const f32x4 accv) __attribute__((always_inline)) {
            const int f = epi_f, n = nt * 128 + epi_t;
            *(f32x4*)(ebuf + (size_t)kh * 2097152 + ((size_t)n * 32 + g) * 128 + f) = accv;
        });
    }
    if (blockIdx.x >= 128) s5_tables_late(p, (blockIdx.x - 128) * 512 + fresh_tid(), (gridDim.x - 128) * 512);
    for (int i0 = vb; i0 < 512; i0 += nvb) {
        const int cgp = tid & 127, half = tid >> 7;
        const int t0 = i0 * 64 + half * 32, s0 = t0 & 8191;
        const int c0 = cgp * 8;
        float w[4][8], bb[8];
#pragma unroll
        for (int j = 0; j < 4; ++j)
#pragma unroll
            for (int e = 0; e < 8; ++e) w[j][e] = p.in[6][j * 1024 + c0 + e];
#pragma unroll
        for (int e = 0; e < 8; ++e) bb[e] = p.in[7][c0 + e];
        float r0[8], r1[8], r2[8];
#pragma unroll
        for (int e = 0; e < 8; ++e) { r0[e] = 0.f; r1[e] = 0.f; r2[e] = 0.f; }
        if (s0 > 0) {
            uint4 a = *(const uint4*)(xm + (size_t)(t0 - 3) * 1024 + c0), b = *(const uint4*)(xm + (size_t)(t0 - 2) * 1024 + c0), c = *(const uint4*)(xm + (size_t)(t0 - 1) * 1024 + c0);
            const unsigned* pa = (const unsigned*)&a; const unsigned* pb = (const unsigned*)&b; const unsigned* pc = (const unsigned*)&c;
#pragma unroll
            for (int e = 0; e < 4; ++e) {
                r0[2 * e] = bf2f(pa[e] & 0xffff); r0[2 * e + 1] = bf2f(pa[e] >> 16);
                r1[2 * e] = bf2f(pb[e] & 0xffff); r1[2 * e + 1] = bf2f(pb[e] >> 16);
                r2[2 * e] = bf2f(pc[e] & 0xffff); r2[2 * e + 1] = bf2f(pc[e] >> 16);
            }
        }
        for (int tb = 0; tb < 32; tb += 8) {
            uint4 av[8];
#pragma unroll
            for (int i = 0; i < 8; ++i) av[i] = *(const uint4*)(xm + (size_t)(t0 + tb + i) * 1024 + c0);
#pragma unroll
            for (int i = 0; i < 8; ++i) {
                const unsigned* pa = (const unsigned*)&av[i];
                float cur[8], y[8];
#pragma unroll
                for (int e = 0; e < 4; ++e) { cur[2 * e] = bf2f(pa[e] & 0xffff); cur[2 * e + 1] = bf2f(pa[e] >> 16); }
#pragma unroll
                for (int e = 0; e < 8; ++e) {
                    float z = bb[e] + w[0][e] * r0[e] + w[1][e] * r1[e] + w[2][e] * r2[e] + w[3][e] * cur[e];
                    y[e] = z * sigm(z);
                    r0[e] = r1[e]; r1[e] = r2[e]; r2[e] = cur[e];
                }
                *(uint4*)(xc + (size_t)(t0 + tb + i) * 1024 + c0) = make_uint4(pk2(y[0], y[1]), pk2(y[2], y[3]), pk2(y[4], y[5]), pk2(y[6], y[7]));
            }
        }
    }
    for (int u = vb * 4 + (tid >> 6); u < 2048; u += nvb * 4) {
        const int lane = tid & 63;
        const int bh = u >> 7, c = u & 127;
        const size_t o = (size_t)bh * 8192 + c * 64 + lane;
        float b = ((const float*)(ws + OFF_LOGF))[o];
        float ii = ((const float*)(ws + OFF_IG))[o];
        for (int d = 1; d < 64; d <<= 1) { float t = __shfl_up(b, d, 64); if (lane >= d) b += t; }
        float bl = __shfl(b, 63, 64);
        float g = bl - b + ii;
        for (int o2 = 32; o2 > 0; o2 >>= 1) g = fmaxf(g, __shfl_xor(g, o2, 64));
        ((float*)(ws + OFF_BCUM))[o] = b;
        if (lane == 0) { ((float*)(ws + OFF_AARR))[u] = g; ((float*)(ws + OFF_BLAST))[u] = bl; }
    }
}

DI void phase4_small(const Params& p, unsigned char* smem) {
    unsigned char* ws = p.ws;
    const int tid = fresh_tid();
    const int lane = tid & 63, wid = tid >> 6;
    if (blockIdx.x >= gridDim.x - 2) {
        const int bh = (blockIdx.x - (gridDim.x - 2)) * 8 + wid;
        const float* aa = (const float*)(ws + OFF_AARR) + bh * 128;
        const float* bl = (const float*)(ws + OFF_BLAST) + bh * 128;
        float* ms = (float*)(ws + OFF_MST) + bh * 132;
        const float p0 = bl[2 * lane], q0 = aa[2 * lane], p1 = bl[2 * lane + 1], q1 = aa[2 * lane + 1];
        float P = p0 + p1, Q = fmaxf(q0 + p1, q1);
#pragma unroll
        for (int d = 1; d < 64; d <<= 1) {
            const float Pp = __shfl_up(P, d, 64), Qp = __shfl_up(Q, d, 64);
            if (lane >= d) { Q = fmaxf(Qp + P, Q); P = Pp + P; }
        }
        float Pe = __shfl_up(P, 1, 64), Qe = __shfl_up(Q, 1, 64);
        const float m_even = (lane == 0) ? 0.f : fmaxf(Pe, Qe);
        const float m_odd = fmaxf(m_even + p0, q0);
        ms[2 * lane] = m_even; ms[2 * lane + 1] = m_odd;
        if (lane == 63) ms[128] = fmaxf(P, Q);
    }
    if (blockIdx.x < 128) {
        const int b = blockIdx.x >> 5, g = blockIdx.x & 31, pp = lane, seg = wid;
        const float2 a64 = ((const float2*)(ws + OFF_APOW))[((size_t)g * 65 + 64) * 64 + pp];
        const float* ebuf = (const float*)((unsigned char*)p.out + (size_t)48 * 1048576);
        bf16_t* xcar = (bf16_t*)((unsigned char*)p.out + (size_t)40 * 1048576);
        float2* L = (float2*)smem;
        float erv[16], eiv[16];
#pragma unroll
        for (int i = 0; i < 16; ++i) { size_t o = ((size_t)(b * 128 + seg * 16 + i) * 32 + g) * 128 + pp; erv[i] = ebuf[o] + ebuf[o + 2097152]; eiv[i] = ebuf[o + 64] + ebuf[o + 2097152 + 64]; }
        float xr = 0.f, xi = 0.f;
#pragma unroll
        for (int i = 0; i < 16; ++i) { const float nr = a64.x * xr - a64.y * xi + erv[i], ni = a64.x * xi + a64.y * xr + eiv[i]; xr = nr; xi = ni; }
        L[seg * 64 + pp] = make_float2(xr, xi);
        float ar = a64.x, ai = a64.y;
#pragma unroll
        for (int k = 0; k < 4; ++k) { const float nr = ar * ar - ai * ai, ni = 2.f * ar * ai; ar = nr; ai = ni; }
        __syncthreads();
        xr = 0.f; xi = 0.f;
        for (int s2 = 0; s2 < seg; ++s2) { const float2 l = L[s2 * 64 + pp]; const float nr = ar * xr - ai * xi + l.x, ni = ar * xi + ai * xr + l.y; xr = nr; xi = ni; }
#pragma unroll
        for (int i = 0; i < 16; ++i) {
            size_t o = ((size_t)(b * 128 + seg * 16 + i) * 32 + g) * 128 + pp;
            xcar[o] = f2bf(xr); xcar[o + 64] = f2bf(xi);
            const float nr = a64.x * xr - a64.y * xi + erv[i], ni = a64.x * xi + a64.y * xr + eiv[i]; xr = nr; xi = ni;
        }
        __syncthreads();
    }
}
struct EpiQK {
    bf16_t *q, *k, *kT;
    DI void operator()(const f32x4 (&acc)[2][2][4][2], const pg8::Unit& u, int wr, int wc, int fr, int fq) const {
        const int h = u.pn;
        const int d = wc * 32 + 8 * fq;
        const int t0 = u.pm * 256 + wr * 64 + fr;
        const int b = t0 >> 13, bh = b * 4 + h, s0 = t0 & 8191;
        bf16_t* qp = q + ((size_t)bh * 8192 + s0) * 128 + d;
#pragma unroll
        for (int ai = 0; ai < 2; ++ai)
#pragma unroll
            for (int m = 0; m < 4; ++m) {
                f32x4 q0 = acc[ai][0][m][0] * 0.08838834764831845f, q1 = acc[ai][0][m][1] * 0.08838834764831845f;
                *(uint4*)(qp + (size_t)(ai * 128 + m * 16) * 128) = pk8(q0, q1);
            }
        bf16_t* kp = k + ((size_t)bh * 8192 + s0) * 128 + d;
#pragma unroll
        for (int ai = 0; ai < 2; ++ai)
#pragma unroll
            for (int m = 0; m < 4; ++m) *(uint4*)(kp + (size_t)(ai * 128 + m * 16) * 128) = pk8(acc[ai][1][m][0], acc[ai][1][m][1]);
        bf16_t* tp0 = kT + (((size_t)bh * 128 + (s0 >> 6)) * 128 + d) * 64 + (s0 & 63);
#pragma unroll
        for (int ai = 0; ai < 2; ++ai)
#pragma unroll
            for (int m = 0; m < 4; ++m) {
                bf16_t* tp = tp0 + (size_t)(ai * 2 + (m >> 2)) * 0 + ((ai * 128 + m * 16) >> 6) * (128 * 64) + ((ai * 128 + m * 16) & 63);
                asm volatile("" : "+v"(tp));
#pragma unroll
                for (int r = 0; r < 4; ++r) { *tp = f2bf(acc[ai][1][m][0][r]); tp += 64; asm volatile("" : "+v"(tp)); }
#pragma unroll
                for (int r = 0; r < 4; ++r) { *tp = f2bf(acc[ai][1][m][1][r]); tp += 64; asm volatile("" : "+v"(tp)); }
            }
    }
};

DI void mlstm_u_unit(const Params& p, unsigned char* smem, const int tid, int u) {
    unsigned char* ws = p.ws;
    const int lane = tid & 63, w = tid >> 6;
    const int bh = u >> 7, c = u & 127, b = bh >> 2, h = bh & 3;
    float* wk = (float*)smem;
    const bf16_t* kT = (const bf16_t*)(ws + 7 * U_ + U_ / 2);
    const bf16_t* vT = (const bf16_t*)(ws + 3 * U_);
    bf16_t* UT = (bf16_t*)(ws + 1 * U_);
    bf16x8 vfr[2][8][2];
#pragma unroll
    for (int nh = 0; nh < 2; ++nh)
#pragma unroll
        for (int ni = 0; ni < 8; ++ni) {
            const bf16_t* vr = vT + (((size_t)bh * 128 + c) * 256 + nh * 128 + ni * 16 + (lane & 15)) * 64 + (lane >> 4) * 8;
            vfr[nh][ni][0] = ld16(vr); vfr[nh][ni][1] = ld16(vr + 32);
        }
    if (tid < 64) {
        const size_t o = (size_t)bh * 8192 + c * 64 + tid;
        float bl = ((const float*)(ws + OFF_BLAST))[u];
        float mn = ((const float*)(ws + OFF_MST))[bh * 132 + c + 1];
        wk[tid] = __expf(bl - ((const float*)(ws + OFF_BCUM))[o] + ((const float*)(ws + OFF_IG))[o] - mn);
    }
    __syncthreads();
    {
        const int d = tid >> 1, hf = tid & 1;
        const bf16_t* kr = kT + (((size_t)bh * 128 + c) * 128 + d) * 64 + hf * 32;
        float s = 0.f;
#pragma unroll
        for (int i = 0; i < 4; ++i) {
            uint4 a = *(const uint4*)(kr + i * 8);
            const unsigned* pa = (const unsigned*)&a;
#pragma unroll
            for (int e = 0; e < 4; ++e) { s += bf2f(pa[e] & 0xffff) * wk[hf * 32 + i * 8 + 2 * e] + bf2f(pa[e] >> 16) * wk[hf * 32 + i * 8 + 2 * e + 1]; }
        }
        s += __shfl_xor(s, 1, 64);
        if (hf == 0) ((float*)(ws + OFF_NU))[((size_t)bh * 128 + c) * 128 + d] = s;
    }
    bf16x8 af[2][2];
#pragma unroll
    for (int mi = 0; mi < 2; ++mi)
#pragma unroll
        for (int ks = 0; ks < 2; ++ks) {
            const int j0 = ks * 32 + (lane >> 4) * 8;
            uint4 a = *(const uint4*)(kT + (((size_t)bh * 128 + c) * 128 + 32 * w + ((lane & 15) >> 2) * 8 + mi * 4 + (lane & 3)) * 64 + j0);
            const unsigned* pa = (const unsigned*)&a;
            uint4 o;
            unsigned* po = (unsigned*)&o;
#pragma unroll
            for (int e = 0; e < 4; ++e) po[e] = pk2(bf2f(pa[e] & 0xffff) * wk[j0 + 2 * e], bf2f(pa[e] >> 16) * wk[j0 + 2 * e + 1]);
            af[mi][ks] = __builtin_bit_cast(bf16x8, o);
        }
#pragma unroll
    for (int nh = 0; nh < 2; ++nh) {
        f32x4 acc[2][8];
#pragma unroll
        for (int mi = 0; mi < 2; ++mi)
#pragma unroll
            for (int ni = 0; ni < 8; ++ni) acc[mi][ni] = f32x4{0.f, 0.f, 0.f, 0.f};
#pragma unroll
        for (int ni = 0; ni < 8; ++ni)
#pragma unroll
            for (int ks = 0; ks < 2; ++ks)
#pragma unroll
                for (int mi = 0; mi < 2; ++mi) acc[mi][ni] = mfma16(af[mi][ks], vfr[nh][ni][ks], acc[mi][ni]);
#pragma unroll
        for (int ni = 0; ni < 8; ++ni) {
            const int dv = nh * 128 + ni * 16 + (lane & 15), d = 32 * w + (lane >> 4) * 8;
            *(uint4*)(UT + (((size_t)bh * 128 + c) * 256 + dv) * 128 + d) = pk8(acc[0][ni], acc[1][ni]);
        }
    }
    __syncthreads();
}

DI void phase5(const Params& p, unsigned char* smem, const int tid, const int vb, const int nvb) {
    unsigned char* ws = p.ws;
    const bf16_t* us = (const bf16_t*)(ws + 7 * U_);
    const bf16_t* kc = (const bf16_t*)(ws + OFF_KC);
    const bf16_t* cmat = (const bf16_t*)(ws + OFF_CMAT);
    const bf16_t* xcar = (const bf16_t*)((unsigned char*)p.out + (size_t)40 * 1048576);
    bf16_t* ys = (bf16_t*)p.out;
    const float* dsk = p.in[19];
    for (int it = vb; it < 1024; it += nvb) {
        const int g = it >> 5, mt = (it < 512) ? (7 - ((it >> 2) & 7)) : ((it >> 2) & 7), nt = it & 3;
        const int ktz = 128 * (mt + 1);
        const int nk = 2 * (mt + 1) + 2;
        auto la = [=](int r, int kv) -> uint4 {
            const int m = mt * 128 + r;
            if (kv < ktz) {
                const int t = m >> 4, c = m & 15, j = kv >> 4, c0 = kv & 15;
                if (j > t) return make_uint4(0, 0, 0, 0);
                return *(const uint4*)(kc + (((size_t)(g * 64 + (t - j)) * 16 + c) * 16 + c0));
            }
            return *(const uint4*)(cmat + ((size_t)(g * 1024 + m)) * 128 + (kv - ktz));
        };
        auto lb = [=](int r, int kv) -> uint4 {
            const int n = nt * 128 + r;
            if (kv < ktz) return *(const uint4*)(us + ((size_t)g * 512 + n) * 1024 + kv);
            return *(const uint4*)(xcar + ((size_t)n * 32 + g) * 128 + (kv - ktz));
        };
        f32x4 acc[4][4];
        gemm_tile(smem, tid, nk, la, lb, acc);
        epi_loop(acc, tid, [&](const int epi_f, const int epi_t, const f32x4 accv) __attribute__((always_inline)) {
            const int m = mt * 128 + epi_f, n = nt * 128 + epi_t;
            const int t = m >> 4, c = m & 15;
            const size_t tok = (size_t)n * 64 + t;
            const int ch = g * 16 + c;
            uint2 uu = *(const uint2*)(us + (((size_t)g * 512 + n) * 64 + t) * 16 + c);
            float4 dd = *(const float4*)(dsk + ch);
            f32x4 v = accv;
            v[0] = gelu_t(v[0] + dd.x * bf2f(uu.x & 0xffff));
            v[1] = gelu_t(v[1] + dd.y * bf2f(uu.x >> 16));
            v[2] = gelu_t(v[2] + dd.z * bf2f(uu.y & 0xffff));
            v[3] = gelu_t(v[3] + dd.w * bf2f(uu.y >> 16));
            *(uint2*)(ys + tok * 512 + ch) = pk4(v);
        });
    }
    for (int u = vb; u < 2048; u += nvb) mlstm_u_unit(p, smem, tid, u);
}

DI void phase6_scan(const Params& p) {
    unsigned char* ws = p.ws;
    const int tid = fresh_tid();
    for (int it = blockIdx.x; it < 256; it += gridDim.x) {
        const int e4 = it * 512 + tid;
        const int bh = e4 >> 13;
        const size_t off = (size_t)(e4 & 8191) * 4;
        bf16_t* base = (bf16_t*)(ws + 1 * U_) + (size_t)bh * 128 * 32768 + off;
        const float* bl = (const float*)(ws + OFF_BLAST) + bh * 128;
        const float* ms = (const float*)(ws + OFF_MST) + bh * 132;
        float C[4] = {0.f, 0.f, 0.f, 0.f};
        uint2 nxt[16];
#pragma unroll
        for (int i = 0; i < 16; ++i) nxt[i] = *(const uint2*)(base + (size_t)i * 32768);
        for (int c8 = 0; c8 < 128; c8 += 16) {
            float decv[16];
#pragma unroll
            for (int i = 0; i < 16; ++i) decv[i] = __expf(bl[c8 + i] + ms[c8 + i] - ms[c8 + i + 1]);
#pragma unroll
            for (int i = 0; i < 16; ++i) {
                const int c = c8 + i;
                uint2 v = nxt[i];
                if (c + 16 < 128) nxt[i] = *(const uint2*)(base + (size_t)(c + 16) * 32768);
                *(uint2*)(base + (size_t)c * 32768) = make_uint2(pk2(C[0], C[1]), pk2(C[2], C[3]));
                const float dec = decv[i];
                C[0] = dec * C[0] + bf2f(v.x & 0xffff); C[1] = dec * C[1] + bf2f(v.x >> 16);
                C[2] = dec * C[2] + bf2f(v.y & 0xffff); C[3] = dec * C[3] + bf2f(v.y >> 16);
            }
        }
    }
    if (blockIdx.x >= gridDim.x - 4) {
        const int e = (blockIdx.x - (gridDim.x - 4)) * 512 + tid;
        const int bh = e >> 7, d = e & 127;
        float* nb = (float*)(ws + OFF_NU) + (size_t)bh * 128 * 128 + d;
        const float* bl = (const float*)(ws + OFF_BLAST) + bh * 128;
        const float* ms = (const float*)(ws + OFF_MST) + bh * 132;
        float n = 0.f;
        for (int c0 = 0; c0 < 128; c0 += 16) {
            float vv[16], dd[16];
#pragma unroll
            for (int i = 0; i < 16; ++i) { vv[i] = nb[(c0 + i) * 128]; dd[i] = __expf(bl[c0 + i] + ms[c0 + i] - ms[c0 + i + 1]); }
#pragma unroll
            for (int i = 0; i < 16; ++i) { nb[(c0 + i) * 128] = n; n = dd[i] * n + vv[i]; }
        }
    }
}
struct EpiGlu {
    bf16_t* yb;
    DI void operator()(const f32x4 (&acc)[2][2][4][2], const pg8::Unit& u, int wr, int wc, int fr, int fq) const {
        pg8::epi8(acc, u, wr, wc, fr, fq, [&](int t, int col8, f32x4 v0, f32x4 v1) __attribute__((always_inline)) {
            f32x4 o;
#pragma unroll
            for (int r = 0; r < 4; ++r) o[r] = v0[r] * sigm(v1[r]);
            *(uint2*)(yb + (size_t)t * 1024 + (col8 >> 1)) = pk4(o);
        });
    }
};

DI void mlstm_out_unit(const Params& p, unsigned char* smem, const int tid, int u) {
    unsigned char* ws = p.ws;
    const int lane = tid & 63, w = tid >> 6;
    const int bh = u >> 7, c = u & 127, b = bh >> 2, h = bh & 3;
    float* gk = (float*)smem;
    float* bq = gk + 64;
    float* sci = bq + 64;
    float* emt = sci + 64;
    float* qn = emt + 64;
    float* rden = qn + 64;
    float* part = rden + 64;
    float* mean_s = part + 256;
    float* rstd_s = mean_s + 64;
    uint4* xs = (uint4*)(smem + 4096);
    const bf16_t* q = (const bf16_t*)((unsigned char*)p.out + U_);
    const bf16_t* k = q + (size_t)16 * 8192 * 128;
    const bf16_t* vT = (const bf16_t*)(ws + 3 * U_);
    const bf16_t* CT = (const bf16_t*)(ws + 1 * U_);
    const bf16_t* og = (const bf16_t*)(ws + 4 * U_);
    bf16_t* hm = (bf16_t*)p.out;
    const float mc = ((const float*)(ws + OFF_MST))[bh * 132 + c];
    const size_t tok0 = (size_t)bh * 8192 + c * 64;
    bf16x8 ctf[4][4];
    {
        const int i16 = lane & 15;
        const bf16_t* ctb0 = CT + (((size_t)bh * 128 + c) * 256 + 64 * w + (i16 >> 2) * 8 + (i16 & 3)) * 128 + (lane >> 4) * 8;
#pragma unroll
        for (int ks = 0; ks < 4; ++ks)
#pragma unroll
            for (int i = 0; i < 4; ++i) ctf[ks][i] = ld16(ctb0 + (size_t)((i >> 1) * 32 + (i & 1) * 4) * 128 + ks * 32);
    }
    if (w == 0) {
        float bj = ((const float*)(ws + OFF_BCUM))[tok0 + lane], ij = ((const float*)(ws + OFF_IG))[tok0 + lane];
        float g = ij - bj, pm = g;
        for (int d = 1; d < 64; d <<= 1) { float o = __shfl_up(pm, d, 64); if (lane >= d) pm = fmaxf(pm, o); }
        float mt = bj + fmaxf(mc, pm);
        gk[lane] = g; bq[lane] = bj - mt; sci[lane] = __expf(bj + mc - mt); emt[lane] = __expf(-mt);
    }
    {
        const int t = tid >> 2, p4 = tid & 3;
        const bf16_t* qr = q + (tok0 + t) * 128 + p4 * 32;
        const float* nr = (const float*)(ws + OFF_NU) + ((size_t)bh * 128 + c) * 128 + p4 * 32;
        float s = 0.f;
#pragma unroll
        for (int i = 0; i < 4; ++i) {
            uint4 a = *(const uint4*)(qr + i * 8);
            const unsigned* pa = (const unsigned*)&a;
#pragma unroll
            for (int e = 0; e < 4; ++e) s += bf2f(pa[e] & 0xffff) * nr[i * 8 + 2 * e] + bf2f(pa[e] >> 16) * nr[i * 8 + 2 * e + 1];
        }
        s += __shfl_xor(s, 1, 64); s += __shfl_xor(s, 2, 64);
        if (p4 == 0) qn[t] = s;
    }
    __syncthreads();
    {
        f32x4 X[4];
#pragma unroll
        for (int jt = 0; jt < 4; ++jt) X[jt] = f32x4{0.f, 0.f, 0.f, 0.f};
        const bf16_t* qb = q + (tok0 + 16 * w + (lane & 15)) * 128 + (lane >> 4) * 8;
        bf16x8 qf[4];
#pragma unroll
        for (int ks = 0; ks < 4; ++ks) qf[ks] = ld16(qb + ks * 32);
#pragma unroll
        for (int jt = 0; jt < 4; ++jt) {
            if (jt <= w) {
                const bf16_t* kb = k + (tok0 + 16 * jt + (lane & 15)) * 128 + (lane >> 4) * 8;
#pragma unroll
                for (int ks = 0; ks < 4; ++ks) X[jt] = mfma16(ld16(kb + ks * 32), qf[ks], X[jt]);
            }
        }
        const int t = 16 * w + (lane & 15);
        const float bqt = bq[t];
        float dsum = 0.f;
#pragma unroll
        for (int jt = 0; jt < 4; ++jt)
#pragma unroll
            for (int r = 0; r < 4; ++r) {
                const int j = 16 * jt + (lane >> 4) * 4 + r;
                float v = (j <= t) ? X[jt][r] * __expf(bqt + gk[j]) : 0.f;
                X[jt][r] = v; dsum += v;
            }
        dsum += __shfl_xor(dsum, 16, 64); dsum += __shfl_xor(dsum, 32, 64);
        if (lane < 16) { float den = dsum + sci[t] * qn[t]; rden[t] = 1.f / fmaxf(fabsf(den), emt[t]); }
#pragma unroll
        for (int pr = 0; pr < 2; ++pr) {
            uint2 lo = pk4(X[2 * pr]), hi = pk4(X[2 * pr + 1]);
            xs[(w * 2 + pr) * 64 + lane] = make_uint4(lo.x, lo.y, hi.x, hi.y);
        }
    }
    __syncthreads();
    f32x4 acc[4][4];
#pragma unroll
    for (int i = 0; i < 4; ++i)
#pragma unroll
        for (int j = 0; j < 4; ++j) acc[i][j] = f32x4{0.f, 0.f, 0.f, 0.f};
    {
        const bf16_t* qb = q + (tok0 + (lane & 15)) * 128 + (lane >> 4) * 8;
#pragma unroll
        for (int ks = 0; ks < 4; ++ks) {
            bf16x8 bfr[4];
#pragma unroll
            for (int i = 0; i < 4; ++i) bfr[i] = ld16(qb + (size_t)i * 16 * 128 + ks * 32);
#pragma unroll
            for (int i = 0; i < 4; ++i)
#pragma unroll
                for (int j = 0; j < 4; ++j) acc[i][j] = mfma16(ctf[ks][i], bfr[j], acc[i][j]);
        }
    }
#pragma unroll
    for (int ni = 0; ni < 4; ++ni) {
        const float s = sci[16 * ni + (lane & 15)];
#pragma unroll
        for (int mi = 0; mi < 4; ++mi) { acc[mi][ni][0] *= s; acc[mi][ni][1] *= s; acc[mi][ni][2] *= s; acc[mi][ni][3] *= s; }
    }
    {
        const bf16_t* vb = vT + (((size_t)bh * 128 + c) * 256 + 64 * w + ((lane & 15) >> 2) * 8 + (lane & 3)) * 64 + (lane >> 4) * 4;
#pragma unroll
        for (int pr = 0; pr < 2; ++pr) {
            bf16x8 af[4];
#pragma unroll
            for (int mi = 0; mi < 4; ++mi) {
                uint2 lo = *(const uint2*)(vb + (size_t)((mi >> 1) * 32 + (mi & 1) * 4) * 64 + pr * 32);
                uint2 hi = *(const uint2*)(vb + (size_t)((mi >> 1) * 32 + (mi & 1) * 4) * 64 + pr * 32 + 16);
                af[mi] = __builtin_bit_cast(bf16x8, make_uint4(lo.x, lo.y, hi.x, hi.y));
            }
#pragma unroll
            for (int ni = 0; ni < 4; ++ni) {
                if (ni >= 2 * pr) {
                    bf16x8 xb = __builtin_bit_cast(bf16x8, xs[(ni * 2 + pr) * 64 + lane]);
#pragma unroll
                    for (int mi = 0; mi < 4; ++mi) acc[mi][ni] = mfma16(af[mi], xb, acc[mi][ni]);
                }
            }
        }
    }
#pragma unroll
    for (int ni = 0; ni < 4; ++ni) {
        const float rd = rden[16 * ni + (lane & 15)];
        float s = 0.f;
#pragma unroll
        for (int mi = 0; mi < 4; ++mi) { acc[mi][ni][0] *= rd; acc[mi][ni][1] *= rd; acc[mi][ni][2] *= rd; acc[mi][ni][3] *= rd;
            s += acc[mi][ni][0] + acc[mi][ni][1] + acc[mi][ni][2] + acc[mi][ni][3]; }
        s += __shfl_xor(s, 16, 64); s += __shfl_xor(s, 32, 64);
        if (lane < 16) part[w * 64 + 16 * ni + lane] = s;
    }
    __syncthreads();
    if (tid < 64) mean_s[tid] = (part[tid] + part[64 + tid] + part[128 + tid] + part[192 + tid]) * (1.f / 256.f);
    __syncthreads();
#pragma unroll
    for (int ni = 0; ni < 4; ++ni) {
        const float mu = mean_s[16 * ni + (lane & 15)];
        float s = 0.f;
#pragma unroll
        for (int mi = 0; mi < 4; ++mi)
#pragma unroll
            for (int r = 0; r < 4; ++r) { float d = acc[mi][ni][r] - mu; s += d * d; }
        s += __shfl_xor(s, 16, 64); s += __shfl_xor(s, 32, 64);
        if (lane < 16) part[w * 64 + 16 * ni + lane] = s;
    }
    __syncthreads();
    if (tid < 64) rstd_s[tid] = rsqrtf((part[tid] + part[64 + tid] + part[128 + tid] + part[192 + tid]) * (1.f / 256.f) + 1e-5f);
    __syncthreads();
    const float* gain = p.in[10];
    float4 gg[2][2];
    uint2 ogv[4][2];
    const int ch_l = h * 256 + 64 * w + (lane >> 4) * 8;
#pragma unroll
    for (int k = 0; k < 2; ++k) { gg[k][0] = *(const float4*)(gain + ch_l + 32 * k); gg[k][1] = *(const float4*)(gain + ch_l + 32 * k + 4); }
#pragma unroll
    for (int ni = 0; ni < 4; ++ni)
#pragma unroll
        for (int k = 0; k < 2; ++k)
            ogv[ni][k] = *(const uint2*)((const unsigned char*)og + ((size_t)b * 8192 + c * 64 + 16 * ni + (lane & 15)) * 1024 + ch_l + 32 * k);
#pragma unroll
    for (int ni = 0; ni < 4; ++ni) {
        const int t = 16 * ni + (lane & 15);
        const float mu = mean_s[t], rs = rstd_s[t];
        const size_t tok = (size_t)b * 8192 + c * 64 + t;
#pragma unroll
        for (int k = 0; k < 2; ++k) {
            const f32x4 o2a = un4u8(ogv[ni][k].x), o2b = un4u8(ogv[ni][k].y);
            f32x4 oa, ob;
            oa[0] = (acc[2 * k][ni][0] - mu) * rs * gg[k][0].x * o2a[0];
            oa[1] = (acc[2 * k][ni][1] - mu) * rs * gg[k][0].y * o2a[1];
            oa[2] = (acc[2 * k][ni][2] - mu) * rs * gg[k][0].z * o2a[2];
            oa[3] = (acc[2 * k][ni][3] - mu) * rs * gg[k][0].w * o2a[3];
            ob[0] = (acc[2 * k + 1][ni][0] - mu) * rs * gg[k][1].x * o2b[0];
            ob[1] = (acc[2 * k + 1][ni][1] - mu) * rs * gg[k][1].y * o2b[1];
            ob[2] = (acc[2 * k + 1][ni][2] - mu) * rs * gg[k][1].z * o2b[2];
            ob[3] = (acc[2 * k + 1][ni][3] - mu) * rs * gg[k][1].w * o2b[3];
            *(uint4*)(hm + tok * 1024 + ch_l + 32 * k) = pk8(oa, ob);
        }
    }
    __syncthreads();
}

struct EpiDown {
    const unsigned char *sga, *sgb; const bf16_t* yb; bf16_t* ymix;
    DI void operator()(const f32x4 (&acc)[2][2][4][2], const pg8::Unit& u, int wr, int wc, int fr, int fq) const {
        const size_t o0 = (size_t)(u.pm * 256 + wr * 64 + fr) * 1024 + u.pn * 256 + wc * 32 + 8 * fq;
#define TOFF(i) (o0 + (size_t)(TILE_AI(i) * 128 + TILE_M(i) * 16) * 1024 + TILE_BJ(i) * 128)
        uint2 A[2], B[2]; uint4 Y[2];
        A[0] = *(const uint2*)(sga + TOFF(0)); B[0] = *(const uint2*)(sgb + TOFF(0)); Y[0] = *(const uint4*)(yb + TOFF(0));
#pragma unroll
        for (int i = 0; i < 16; ++i) {
            if (i + 1 < 16) { A[(i + 1) & 1] = *(const uint2*)(sga + TOFF(i + 1)); B[(i + 1) & 1] = *(const uint2*)(sgb + TOFF(i + 1)); Y[(i + 1) & 1] = *(const uint4*)(yb + TOFF(i + 1)); }
            const uint4 y = Y[i & 1];
            const f32x4 a0 = un4u8(A[i & 1].x), a1 = un4u8(A[i & 1].y), b0 = un4u8(B[i & 1].x), b1 = un4u8(B[i & 1].y);
            const f32x4 v0 = acc[TILE_AI(i)][TILE_BJ(i)][TILE_M(i)][0], v1 = acc[TILE_AI(i)][TILE_BJ(i)][TILE_M(i)][1];
            f32x4 r0, r1;
            r0[0] = a0[0] * v0[0] + b0[0] * bf2f(y.x & 0xffff);
            r0[1] = a0[1] * v0[1] + b0[1] * bf2f(y.x >> 16);
            r0[2] = a0[2] * v0[2] + b0[2] * bf2f(y.y & 0xffff);
            r0[3] = a0[3] * v0[3] + b0[3] * bf2f(y.y >> 16);
            r1[0] = a1[0] * v1[0] + b1[0] * bf2f(y.z & 0xffff);
            r1[1] = a1[1] * v1[1] + b1[1] * bf2f(y.z >> 16);
            r1[2] = a1[2] * v1[2] + b1[2] * bf2f(y.w & 0xffff);
            r1[3] = a1[3] * v1[3] + b1[3] * bf2f(y.w >> 16);
            *(uint4*)(ymix + TOFF(i)) = pk8(r0, r1);
        }
    }
};
struct EpiRes {
    const float* res; const float* gmod; bf16_t* dst;
    DI void operator()(const f32x4 (&acc)[2][2][4][2], const pg8::Unit& u, int wr, int wc, int fr, int fq) const {
        const int t0 = u.pm * 256 + wr * 64 + fr, colb = u.pn * 256 + wc * 32 + 8 * fq;
        const size_t o0 = (size_t)t0 * 1024 + colb;
        f32x4 gg[2][2];
#pragma unroll
        for (int bj = 0; bj < 2; ++bj) { const float* gp = gmod + (t0 >> 13) * 6144 + colb + bj * 128; gg[bj][0] = *(const f32x4*)gp + 1.f; gg[bj][1] = *(const f32x4*)(gp + 4) + 1.f; }
        f32x4 X0[2], X1[2];
        X0[0] = *(const f32x4*)(res + TOFF(0)); X1[0] = *(const f32x4*)(res + TOFF(0) + 4);
#pragma unroll
        for (int i = 0; i < 16; ++i) {
            if (i + 1 < 16) { X0[(i + 1) & 1] = *(const f32x4*)(res + TOFF(i + 1)); X1[(i + 1) & 1] = *(const f32x4*)(res + TOFF(i + 1) + 4); }
            const int bj = TILE_BJ(i);
            const f32x4 r0 = X0[i & 1] * ALPHA_ + gg[bj][0] * acc[TILE_AI(i)][bj][TILE_M(i)][0];
            const f32x4 r1 = X1[i & 1] * ALPHA_ + gg[bj][1] * acc[TILE_AI(i)][bj][TILE_M(i)][1];
            *(uint4*)(dst + TOFF(i)) = pk8(r0, r1);
        }
    }
};

struct EpiRes2 {
    const bf16_t* r1; const float2* stats; const float* lg; const float* lb; const float* gmod; bf16_t* dst;
    DI void operator()(const f32x4 (&acc)[2][2][4][2], const pg8::Unit& u, int wr, int wc, int fr, int fq) const {
        const int t0 = u.pm * 256 + wr * 64 + fr, colb = u.pn * 256 + wc * 32 + 8 * fq;
        const size_t o0 = (size_t)t0 * 1024 + colb;
        f32x4 gg[2][2], la[2][2], lbv[2][2];
#pragma unroll
        for (int bj = 0; bj < 2; ++bj) {
            const float* gp = gmod + (t0 >> 13) * 6144 + colb + bj * 128;
            gg[bj][0] = *(const f32x4*)gp + 1.f; gg[bj][1] = *(const f32x4*)(gp + 4) + 1.f;
            la[bj][0] = *(const f32x4*)(lg + colb + bj * 128) * ALPHA_; la[bj][1] = *(const f32x4*)(lg + colb + bj * 128 + 4) * ALPHA_;
            lbv[bj][0] = *(const f32x4*)(lb + colb + bj * 128) * ALPHA_; lbv[bj][1] = *(const f32x4*)(lb + colb + bj * 128 + 4) * ALPHA_;
        }
        float2 st[8];
#pragma unroll
        for (int j = 0; j < 8; ++j) st[j] = stats[t0 + (j >> 2) * 128 + (j & 3) * 16];
        uint4 XR[2];
        XR[0] = *(const uint4*)(r1 + TOFF(0));
#pragma unroll
        for (int i = 0; i < 16; ++i) {
            if (i + 1 < 16) XR[(i + 1) & 1] = *(const uint4*)(r1 + TOFF(i + 1));
            const int bj = TILE_BJ(i);
            const float2 s2 = st[i >> 1];
            const uint4 xr = XR[i & 1];
            const f32x4 X0 = {bf2f(xr.x & 0xffff), bf2f(xr.x >> 16), bf2f(xr.y & 0xffff), bf2f(xr.y >> 16)};
            const f32x4 X1 = {bf2f(xr.z & 0xffff), bf2f(xr.z >> 16), bf2f(xr.w & 0xffff), bf2f(xr.w >> 16)};
            const f32x4 r0 = ((X0 - s2.x) * s2.y) * la[bj][0] + lbv[bj][0] + gg[bj][0] * acc[TILE_AI(i)][bj][TILE_M(i)][0];
            const f32x4 r1v = ((X1 - s2.x) * s2.y) * la[bj][1] + lbv[bj][1] + gg[bj][1] * acc[TILE_AI(i)][bj][TILE_M(i)][1];
            *(uint4*)(dst + TOFF(i)) = pk8(r0, r1v);
        }
    }
};
#undef TOFF

DI void phase10(const Params& p) {
    unsigned char* ws = p.ws;
    int ft_ = threadIdx.x; asm volatile("" : "+v"(ft_));
    const int lane = ft_ & 63, wid = ft_ >> 6;
    const float* mod = (const float*)(ws + OFF_MOD);
    const bf16_t* r1 = (const bf16_t*)(ws + 2 * U_);
    float2* stats = (float2*)(ws + OFF_STATS);
    bf16_t* h2 = (bf16_t*)(ws + 1 * U_);
    for (int row0 = (blockIdx.x * 8 + wid) * 4; row0 < T_; row0 += gridDim.x * 32) {
        float v[4][16];
#pragma unroll
        for (int rr = 0; rr < 4; ++rr)
#pragma unroll
            for (int i = 0; i < 4; ++i) { uint2 t = *(const uint2*)(r1 + (size_t)(row0 + rr) * 1024 + i * 256 + lane * 4); v[rr][4 * i] = bf2f(t.x & 0xffff); v[rr][4 * i + 1] = bf2f(t.x >> 16); v[rr][4 * i + 2] = bf2f(t.y & 0xffff); v[rr][4 * i + 3] = bf2f(t.y >> 16); }
#pragma unroll
        for (int rr = 0; rr < 4; ++rr) {
            const int row = row0 + rr;
            float mean, rstd; row_stats(v[rr], mean, rstd);
            if (lane == 0) stats[row] = make_float2(mean, rstd);
#pragma unroll
            for (int i = 0; i < 4; ++i) {
                int c = i * 256 + lane * 4;
                float4 g = *(const float4*)(p.in[22] + c), bb = *(const float4*)(p.in[23] + c);
                v[rr][4 * i] = (v[rr][4 * i] - mean) * rstd * g.x + bb.x;
                v[rr][4 * i + 1] = (v[rr][4 * i + 1] - mean) * rstd * g.y + bb.y;
                v[rr][4 * i + 2] = (v[rr][4 * i + 2] - mean) * rstd * g.z + bb.z;
                v[rr][4 * i + 3] = (v[rr][4 * i + 3] - mean) * rstd * g.w + bb.w;
            }
            row_stats(v[rr], mean, rstd);
            const float* mb = mod + (row >> 13) * 6144;
#pragma unroll
            for (int i = 0; i < 4; ++i) {
                int c = i * 256 + lane * 4;
                float4 sh = *(const float4*)(mb + 3072 + c), sc = *(const float4*)(mb + 4096 + c);
                f32x4 o;
                o[0] = (v[rr][4 * i] - mean) * rstd * (1.f + sc.x) + sh.x;
                o[1] = (v[rr][4 * i + 1] - mean) * rstd * (1.f + sc.y) + sh.y;
                o[2] = (v[rr][4 * i + 2] - mean) * rstd * (1.f + sc.z) + sh.z;
                o[3] = (v[rr][4 * i + 3] - mean) * rstd * (1.f + sc.w) + sh.w;
                *(uint2*)(h2 + (size_t)row * 1024 + c) = pk4(o);
            }
        }
    }
}

constexpr size_t HALO_ELEMS = (size_t)512 * 2 * FH;
struct EpiUpF {
    bf16_t* hid; const float* cw; const float* cb; float* glast; float* gfirst; float* vfirst;
    DI void operator()(const f32x4 (&acc)[2][2][4][2], const pg8::Unit& u, int wr, int wc, int fr, int fq) const {
        const int lane = fq * 16 + fr;
        const int src1 = (lane & 48) | ((fr + 15) & 15), src2 = (lane & 48) | ((fr + 14) & 15);
        float4 w0v[2], w1v[2], w2v[2], bbv[2];
#pragma unroll
        for (int bj = 0; bj < 2; ++bj) {
            const int hc = (u.pn * 256 + bj * 128 + wc * 32 + 8 * fq) >> 1;
            w0v[bj] = *(const float4*)(cw + hc); w1v[bj] = *(const float4*)(cw + FH + hc); w2v[bj] = *(const float4*)(cw + 2 * FH + hc); bbv[bj] = *(const float4*)(cb + hc);
        }
#pragma unroll
        for (int bj = 0; bj < 2; ++bj) {
            const int hc = (u.pn * 256 + bj * 128 + wc * 32 + 8 * fq) >> 1;
            const float4 w0 = w0v[bj], w1 = w1v[bj], w2 = w2v[bj], bb = bbv[bj];
#pragma unroll
            for (int ai = 0; ai < 2; ++ai) {
                f32x4 gprev = (f32x4){0.f, 0.f, 0.f, 0.f};
#pragma unroll
                for (int m = 0; m < 4; ++m) {
                    const f32x4 v = acc[ai][bj][m][0], g = acc[ai][bj][m][1];
                    f32x4 p1, p2;
#pragma unroll
                    for (int r = 0; r < 4; ++r) {
                        p1[r] = __builtin_bit_cast(float, __builtin_amdgcn_update_dpp(0, __builtin_bit_cast(int, (fr == 15) ? gprev[r] : g[r]), 0x121, 0xF, 0xF, false));
                        p2[r] = __builtin_bit_cast(float, __builtin_amdgcn_update_dpp(0, __builtin_bit_cast(int, (fr >= 14) ? gprev[r] : g[r]), 0x122, 0xF, 0xF, false));
                    }
                    const int row = u.pm * 256 + ai * 128 + wr * 64 + m * 16 + fr;
                    const int wb = row >> 6;
                    if (m == 0 && fr < 2) {
                        *(f32x4*)(gfirst + ((size_t)wb * 2 + fr) * FH + hc) = g;
                        *(f32x4*)(vfirst + ((size_t)wb * 2 + fr) * FH + hc) = v;
                    } else {
                        f32x4 o;
                        o[0] = gelu_t(bb.x + w0.x * p2[0] + w1.x * p1[0] + w2.x * g[0]) * v[0];
                        o[1] = gelu_t(bb.y + w0.y * p2[1] + w1.y * p1[1] + w2.y * g[1]) * v[1];
                        o[2] = gelu_t(bb.z + w0.z * p2[2] + w1.z * p1[2] + w2.z * g[2]) * v[2];
                        o[3] = gelu_t(bb.w + w0.w * p2[3] + w1.w * p1[3] + w2.w * g[3]) * v[3];
                        *(uint2*)(hid + (size_t)row * FH + hc) = pk4(o);
                    }
                    if (m == 3 && fr >= 14) *(f32x4*)(glast + ((size_t)wb * 2 + (fr - 14)) * FH + hc) = g;
                    gprev = g;
                }
            }
        }
    }
};

DI void phase12(const Params& p) {
    bf16_t* hid = (bf16_t*)(p.ws + 4 * U_);
    const float* glast = p.out;
    const float* gfirst = p.out + HALO_ELEMS;
    const float* vfirst = p.out + 2 * HALO_ELEMS;
    const float* cw = p.in[25];
    const float* cb = p.in[26];
    const int gtid = blockIdx.x * 512 + fresh_tid(), gstr = gridDim.x * 512;
    for (int idx = gtid; idx < 512 * 2 * (FH / 4); idx += gstr) {
        const int cgp = idx % (FH / 4), rr = (idx / (FH / 4)) & 1, wb = idx / (2 * (FH / 4));
        const int hc = cgp * 4;
        const bool seq_start = (wb & 127) == 0;
        const int pb = seq_start ? wb : wb - 1;
        const float pz = seq_start ? 0.f : 1.f;
        float4 la = *(const float4*)(glast + ((size_t)pb * 2 + 0) * FH + hc), lb = *(const float4*)(glast + ((size_t)pb * 2 + 1) * FH + hc);
        la.x *= pz; la.y *= pz; la.z *= pz; la.w *= pz; lb.x *= pz; lb.y *= pz; lb.z *= pz; lb.w *= pz;
        const float4 f0 = *(const float4*)(gfirst + ((size_t)wb * 2 + 0) * FH + hc), f1 = *(const float4*)(gfirst + ((size_t)wb * 2 + 1) * FH + hc);
        float4 gm2, gm1, g0;
        if (rr == 0) { gm2 = la; gm1 = lb; g0 = f0; } else { gm2 = lb; gm1 = f0; g0 = f1; }
        const float4 v = *(const float4*)(vfirst + ((size_t)wb * 2 + rr) * FH + hc);
        const float4 w0 = *(const float4*)(cw + hc), w1 = *(const float4*)(cw + FH + hc), w2 = *(const float4*)(cw + 2 * FH + hc), bb = *(const float4*)(cb + hc);
        f32x4 o;
        o[0] = gelu_t(bb.x + w0.x * gm2.x + w1.x * gm1.x + w2.x * g0.x) * v.x;
        o[1] = gelu_t(bb.y + w0.y * gm2.y + w1.y * gm1.y + w2.y * g0.y) * v.y;
        o[2] = gelu_t(bb.z + w0.z * gm2.z + w1.z * gm1.z + w2.z * g0.z) * v.z;
        o[3] = gelu_t(bb.w + w0.w * gm2.w + w1.w * gm1.w + w2.w * g0.w) * v.w;
        *(uint2*)(hid + ((size_t)wb * 64 + rr) * FH + hc) = pk4(o);
    }
}

DI void phase14(const Params& p) {
    int ft_ = threadIdx.x; asm volatile("" : "+v"(ft_));
    const int lane = ft_ & 63, wid = ft_ >> 6;
    for (int row0 = (blockIdx.x * 8 + wid) * 4; row0 < T_; row0 += gridDim.x * 32) {
        float v[4][16];
#pragma unroll
        for (int rr = 0; rr < 4; ++rr)
#pragma unroll
            for (int i = 0; i < 4; ++i) { uint2 t = *(const uint2*)((const bf16_t*)(p.ws + 1 * U_) + (size_t)(row0 + rr) * 1024 + i * 256 + lane * 4); v[rr][4 * i] = bf2f(t.x & 0xffff); v[rr][4 * i + 1] = bf2f(t.x >> 16); v[rr][4 * i + 2] = bf2f(t.y & 0xffff); v[rr][4 * i + 3] = bf2f(t.y >> 16); }
#pragma unroll
        for (int rr = 0; rr < 4; ++rr) {
            float* xr = p.out + (size_t)(row0 + rr) * 1024;
            float mean, rstd; row_stats(v[rr], mean, rstd);
#pragma unroll
            for (int i = 0; i < 4; ++i) {
                int c = i * 256 + lane * 4;
                float4 g = *(const float4*)(p.in[28] + c), bb = *(const float4*)(p.in[29] + c);
                *(float4*)(xr + c) = make_float4((v[rr][4 * i] - mean) * rstd * g.x + bb.x, (v[rr][4 * i + 1] - mean) * rstd * g.y + bb.y,
                                                 (v[rr][4 * i + 2] - mean) * rstd * g.z + bb.z, (v[rr][4 * i + 3] - mean) * rstd * g.w + bb.w);
            }
        }
    }
}

#define XB_TMO      128
#define XB_XCNT(j)  (256  + 64 * (j))
#define XB_XSUB(j)  (1280 + 64 * (j))
#define XB_XGEN(j)  (2304 + 64 * (j))
#define XB_TOP      3328
#define XB_TOPGEN   3392
#define XB_SPIN_CAP (1u << 22)
DI unsigned xb_ld(unsigned* p)              { return __hip_atomic_load(p, __ATOMIC_RELAXED, __HIP_MEMORY_SCOPE_AGENT); }
DI unsigned xb_add(unsigned* p, unsigned v) { return __hip_atomic_fetch_add(p, v, __ATOMIC_RELAXED, __HIP_MEMORY_SCOPE_AGENT); }
DI unsigned xb_xcc_id() { return (unsigned)__builtin_amdgcn_s_getreg((3 << 11) | 20) & 0xFu; }
#define XB_SPIN(cond, bar) do { unsigned _sp = 0; while (cond) { __builtin_amdgcn_s_sleep(1); \
    if ((++_sp & 255u) == 0u) { if (xb_ld(&(bar)[XB_TMO])) break; if (_sp > XB_SPIN_CAP) { atomicAdd(&(bar)[XB_TMO], 1u); break; } } } } while (0)
DI void xcd_barrier_complete(unsigned* bar, unsigned x, unsigned& nloc, unsigned& nx) {
    const unsigned G = gridDim.x;
    unsigned sum, cnt, mine, sp = 0u;
    for (;;) {
        sum = 0u; cnt = 0u; mine = 0u;
#pragma unroll
        for (unsigned j = 0; j < 16; ++j) { const unsigned c = xb_ld(&bar[XB_XCNT(j)]); sum += c; cnt += (c > 0u) ? 1u : 0u; mine = (j == x) ? c : mine; }
        if (sum == G) break;
        __builtin_amdgcn_s_sleep(1);
        if ((++sp & 255u) == 0u) { if (xb_ld(&bar[XB_TMO])) break; if (sp > XB_SPIN_CAP) { atomicAdd(&bar[XB_TMO], 1u); break; } }
    }
    nloc = mine > 0u ? mine : 1u; nx = cnt > 0u ? cnt : 1u;
}
DI void xcd_barrier(unsigned* bar, volatile __attribute__((address_space(3))) unsigned* st) {
    asm volatile("s_waitcnt vmcnt(0)" ::: "memory");
    __syncthreads();
    if (fresh_tid() == 0) {
        __builtin_amdgcn_s_waitcnt(0);
        const unsigned x = xb_xcc_id();
        unsigned nloc = st[0], nx = st[1];
        if (nloc == 0u) { xcd_barrier_complete(bar, x, nloc, nx); st[0] = nloc; st[1] = nx; }
        const unsigned old = xb_add(&bar[XB_XSUB(x)], 1u);
        const unsigned gen = old / nloc;
        if (old + 1u == (gen + 1u) * nloc) {
            __builtin_amdgcn_fence(__ATOMIC_RELEASE, "agent");
            asm volatile("s_waitcnt vmcnt(0)" ::: "memory");
            const unsigned og = xb_add(&bar[XB_TOP], 1u);
            const unsigned tg = og / nx;
            if (og + 1u == (tg + 1u) * nx) xb_add(&bar[XB_TOPGEN], 1u);
            else XB_SPIN(xb_ld(&bar[XB_TOPGEN]) == tg, bar);
            __builtin_amdgcn_fence(__ATOMIC_ACQUIRE, "agent");
            xb_add(&bar[XB_XGEN(x)], 1u);
            asm volatile("s_waitcnt vmcnt(0)" ::: "memory");
        } else {
            XB_SPIN(xb_ld(&bar[XB_XGEN(x)]) == gen, bar);
            __builtin_amdgcn_fence(__ATOMIC_ACQUIRE, "agent");
            asm volatile("s_waitcnt vmcnt(0)" ::: "memory");
        }
    }
    __syncthreads();
}

constexpr int LDS_BYTES = 131072;
__global__ void __launch_bounds__(512, 2) fwd_megakernel(Params p) {
    extern __shared__ __attribute__((aligned(16))) unsigned char lds[];
    cg::grid_group grid = cg::this_grid();
    unsigned* bar = (unsigned*)(p.ws + OFF_BAR);
    __shared__ __attribute__((aligned(16))) unsigned xb_st[4];
    volatile __attribute__((address_space(3))) unsigned* st = (volatile __attribute__((address_space(3))) unsigned*)xb_st;
    if (threadIdx.x < 4) xb_st[threadIdx.x] = 0u;
    __syncthreads();
    if (threadIdx.x == 0) (void)xb_add(&bar[XB_XCNT(xb_xcc_id())], 1u);
#define GSYNC() xcd_barrier(bar, st)
#define HALF_CTX int ft_ = threadIdx.x; asm volatile("" : "+v"(ft_)); const int half = ft_ >> 8, vtid = ft_ & 255; \
    const int vb = blockIdx.x * 2 + half, nvb = gridDim.x * 2; unsigned char* hsm = lds + half * 65536;
    PG8_LAS unsigned char* glds = (PG8_LAS unsigned char*)lds;
    unsigned char* ws = p.ws;
    pg8::StaticOrder S;
    if (p.out == nullptr) grid.sync();
    { HALF_CTX phase0(p, hsm, vtid, vb, nvb); }
    GSYNC();
    phase1(p, lds);
    GSYNC();
    {
        pg8::Gemm g{(const bf16_t*)(ws + 1 * U_), (const bf16_t*)(ws + OFF_WIN), 1024, 1024, 1024, 0};
        S.init(T_, 4608, gridDim.x, blockIdx.x);
        EpiIn E{p.in[5], (bf16_t*)(ws + 2 * U_), (bf16_t*)(ws + 3 * U_), (bf16_t*)(ws + 4 * U_), (bf16_t*)(ws + 5 * U_), (bf16_t*)(ws + 6 * U_), (bf16_t*)(ws + 7 * U_)};
        pg8::gemm_phase(glds, g, S, E);
    }
    GSYNC();
    { HALF_CTX phase3(p, hsm, vtid, vb, nvb); }
    GSYNC();
    phase4_small(p, lds);
    {
        bf16_t* q = (bf16_t*)((unsigned char*)p.out + U_);
        pg8::Gemm g{(const bf16_t*)(ws + 1 * U_), (const bf16_t*)(ws + OFF_WQK), 1024, 256, 256, 512};
        S.init(T_, 1024, gridDim.x, blockIdx.x);
        EpiQK E{q, q + (size_t)16 * 8192 * 128, (bf16_t*)(ws + 7 * U_ + U_ / 2)};
        pg8::gemm_phase(glds, g, S, E);
    }
    GSYNC();
    { HALF_CTX phase5(p, hsm, vtid, vb, nvb); }
    GSYNC();
    phase6_scan(p);
    {
        pg8::Gemm g{(const bf16_t*)p.out, (const bf16_t*)(ws + OFF_WGL), 512, 512, 512, 0};
        S.init(T_, 2048, gridDim.x, blockIdx.x);
        EpiGlu E{(bf16_t*)(ws + 7 * U_)};
        pg8::gemm_phase(glds, g, S, E);
    }
    GSYNC();
    { HALF_CTX for (int u = vb; u < 2048; u += nvb) mlstm_out_unit(p, hsm, vtid, u); }
    GSYNC();
    {
        pg8::Gemm g{(const bf16_t*)p.out, (const bf16_t*)(ws + OFF_WDN), 1024, 1024, 1024, 0};
        S.init(T_, 1024, gridDim.x, blockIdx.x);
        EpiDown E{(const unsigned char*)(ws + 5 * U_), (const unsigned char*)(ws + 6 * U_), (const bf16_t*)(ws + 7 * U_), (bf16_t*)(ws + 1 * U_)};
        pg8::gemm_phase(glds, g, S, E);
    }
    GSYNC();
    {
        pg8::Gemm g{(const bf16_t*)(ws + 1 * U_), (const bf16_t*)(ws + OFF_WMX), 1024, 1024, 1024, 0};
        S.init(T_, 1024, gridDim.x, blockIdx.x);
        EpiRes E{p.in[0], (const float*)(ws + OFF_MOD) + 2048, (bf16_t*)(ws + 2 * U_)};
        pg8::gemm_phase(glds, g, S, E);
    }
    GSYNC();
    phase10(p);
    GSYNC();
    {
        pg8::Gemm g{(const bf16_t*)(ws + 1 * U_), (const bf16_t*)(ws + OFF_WUP), 1024, 1024, 1024, 0};
        S.init(T_, 5632, gridDim.x, blockIdx.x);
        EpiUpF E{(bf16_t*)(ws + 4 * U_), p.in[25], p.in[26], p.out, p.out + HALO_ELEMS, p.out + 2 * HALO_ELEMS};
        pg8::gemm_phase(glds, g, S, E);
    }
    GSYNC();
    phase12(p);
    GSYNC();
    {
        pg8::Gemm g{(const bf16_t*)(ws + 4 * U_), (const bf16_t*)(ws + OFF_WFD), FH, FH, FH, 0};
        S.init(T_, 1024, gridDim.x, blockIdx.x);
        EpiRes2 E{(const bf16_t*)(ws + 2 * U_), (const float2*)(ws + OFF_STATS), p.in[22], p.in[23], (const float*)(ws + OFF_MOD) + 5120, (bf16_t*)(ws + 1 * U_)};
        pg8::gemm_phase(glds, g, S, E);
    }
    GSYNC();
    phase14(p);
}

extern "C" void kernel_launch(void* const* d_in, const int* in_sizes, int n_in, void* d_out, int out_size, void* d_ws, size_t ws_size, hipStream_t stream) {
    static int grid_blocks = 0;
    if (grid_blocks == 0) {
        if (n_in != 30 || out_size != T_ * 1024 || ws_size < 8 * U_) { fprintf(stderr, "kernel_launch: unexpected shapes (n_in %d out %d ws %zu)\n", n_in, out_size, ws_size); grid_blocks = -1; return; }
        int dev = 0, cus = 0, per_cu = 0;
        (void)hipGetDevice(&dev);
        (void)hipDeviceGetAttribute(&cus, hipDeviceAttributeMultiprocessorCount, dev);
        if (hipFuncSetAttribute((const void*)fwd_megakernel, hipFuncAttributeMaxDynamicSharedMemorySize, LDS_BYTES) != hipSuccess) { fprintf(stderr, "hipFuncSetAttribute failed\n"); grid_blocks = -1; return; }
        (void)hipOccupancyMaxActiveBlocksPerMultiprocessor(&per_cu, fwd_megakernel, 512, LDS_BYTES);
        if (per_cu < 1) { fprintf(stderr, "occupancy query says 0 blocks/CU\n"); per_cu = 1; }
        grid_blocks = cus;
    }
    if (grid_blocks < 0) return;
    Params p{};
    for (int i = 0; i < 30; ++i) p.in[i] = (const float*)d_in[i];
    p.out = (float*)d_out;
    p.ws = (unsigned char*)d_ws;
    if (hipMemsetAsync((unsigned char*)d_ws + OFF_BAR, 0, 16384, stream) != hipSuccess) { fprintf(stderr, "memset failed\n"); return; }
    void* args[] = {&p};
    hipError_t e = hipLaunchCooperativeKernel((const void*)fwd_megakernel, dim3(grid_blocks), dim3(512), args, LDS_BYTES, stream);
    if (e != hipSuccess) fprintf(stderr, "cooperative launch failed: %s (grid %d)\n", hipGetErrorString(e), grid_blocks);
}
```
